# Optimizing an MI355X kernel written in HIP

```python
import math
import jax, jax.numpy as jnp
from jax import lax
import numpy as np

D_MODEL = 2048
BATCH = 2
SEQ = 16384
DEPTH = 2

HEAD_DIM = 64
ATTN_WIDTH = D_MODEL // 2
RWKV_WIDTH = D_MODEL // 4
SSM_WIDTH = D_MODEL - ATTN_WIDTH - RWKV_WIDTH

ATTN_HEADS = ATTN_WIDTH // HEAD_DIM
ATTN_KV_HEADS = ATTN_HEADS // 4
ATTN_GROUP = ATTN_HEADS // ATTN_KV_HEADS
KV_WIDTH = ATTN_KV_HEADS * HEAD_DIM
WINDOW = 128
BLOCK = 128
REL_BUCKETS = 32
REL_MAX_DISTANCE = 128

RWKV_HEADS = RWKV_WIDTH // HEAD_DIM
RWKV_DECAY_LORA = 64
RWKV_A_LORA = 64
RWKV_GATE_LORA = 128
RWKV_COLS = 3 * RWKV_WIDTH + RWKV_DECAY_LORA + RWKV_A_LORA + RWKV_GATE_LORA
RWKV_SPLITS = [RWKV_WIDTH, RWKV_WIDTH + RWKV_DECAY_LORA,
               2 * RWKV_WIDTH + RWKV_DECAY_LORA, 3 * RWKV_WIDTH + RWKV_DECAY_LORA,
               3 * RWKV_WIDTH + RWKV_DECAY_LORA + RWKV_A_LORA]
RWKV_DECAY_SCALE = math.exp(-0.5)
RWKV_LN_EPS = HEAD_DIM * 1e-5

SSM_GROUP_CH = 16
SSM_GROUPS = SSM_WIDTH // SSM_GROUP_CH
SSM_STATE = 64
DT_MIN = 1e-3
DT_MAX = 1e-1

Q_END = ATTN_WIDTH
K_END = Q_END + KV_WIDTH
V_END = K_END + KV_WIDTH
RWKV_END = V_END + RWKV_COLS
IN_COLS = RWKV_END + SSM_WIDTH

D_FF = ((8 * D_MODEL // 3 + 255) // 256) * 256
N_EXPERTS = 8
TOP_K = 2
D_FF_EXPERT = 7 * D_MODEL // 2
N_DENSE = (DEPTH + 1) // 2
N_MOE = DEPTH // 2
NORM_EPS = 1e-6

kernel_name = 'hybrid_swa_rwkv7_s5_moe_block'


def rmsnorm(x, g, eps=NORM_EPS):
    xf = x.astype(jnp.float32)
    y = xf * lax.rsqrt(jnp.mean(xf * xf, -1, keepdims=True) + eps)
    return (y * g.astype(jnp.float32)).astype(x.dtype)


def t5_causal_bucket(dist):
    max_exact = REL_BUCKETS // 2
    d = jnp.maximum(dist, 0)
    large = max_exact + (jnp.log(jnp.maximum(d, 1).astype(jnp.float32) / max_exact)
                         / math.log(REL_MAX_DISTANCE / max_exact)
                         * (REL_BUCKETS - max_exact)).astype(jnp.int32)
    large = jnp.minimum(large, REL_BUCKETS - 1)
    return jnp.where(d < max_exact, d, large)


def sliding_window_attention(q, k, v, q_g, k_g, sinks, rel_bias):
    B, L = q.shape[0], q.shape[1]
    nb = L // BLOCK
    q = rmsnorm(q, q_g).astype(jnp.float32)
    k = rmsnorm(k, k_g).astype(jnp.float32)
    v = v.astype(jnp.float32)
    qb = q.reshape(B, nb, BLOCK, ATTN_KV_HEADS, ATTN_GROUP, HEAD_DIM)

    def band(t):
        tb = t.reshape(B, nb, BLOCK, ATTN_KV_HEADS, HEAD_DIM)
        prev = jnp.concatenate([jnp.zeros_like(tb[:, :1]), tb[:, :-1]], axis=1)
        return jnp.concatenate([prev, tb], axis=2)

    kb, vb = band(k), band(v)
    s = jnp.einsum('bnqhgd,bnkhd->bnhgqk', qb, kb) * (HEAD_DIM ** -0.5)
    qi = jnp.arange(BLOCK, dtype=jnp.int32)[:, None]
    kj = jnp.arange(2 * BLOCK, dtype=jnp.int32)[None, :]
    dist = BLOCK + qi - kj
    bias = rel_bias.astype(jnp.float32)[t5_causal_bucket(dist)]
    bias = jnp.transpose(bias, (2, 0, 1)).reshape(ATTN_KV_HEADS, ATTN_GROUP, BLOCK, 2 * BLOCK)
    s = s + bias
    blk = jnp.arange(nb, dtype=jnp.int32)[:, None, None]
    valid = (dist >= 0) & (dist < WINDOW) & (blk * BLOCK - BLOCK + kj >= 0)
    s = jnp.where(valid[None, :, None, None], s, -jnp.inf)
    sink = sinks.astype(jnp.float32).reshape(1, 1, ATTN_KV_HEADS, ATTN_GROUP, 1, 1)
    m = jnp.maximum(jnp.max(s, -1, keepdims=True), sink)
    p = jnp.exp(s - m)
    denom = jnp.sum(p, -1, keepdims=True) + jnp.exp(sink - m)
    o = jnp.einsum('bnhgqk,bnkhd->bnqhgd', p / denom, vb)
    return o.reshape(B, L, ATTN_WIDTH)


def token_shift(z, mu):
    prev = jnp.pad(z, ((0, 0), (1, 0), (0, 0)))[:, :-1]
    return z + mu * (prev - z)


def rwkv7_time_mix(z, mu, w0, w2, a0, a2, g2, k_k, k_a, r_k, ln_w, ln_b):
    B, L = z.shape[0], z.shape[1]
    H, N = RWKV_HEADS, HEAD_DIM
    f = lambda p: p.astype(jnp.float32)
    z = token_shift(f(z), f(mu))
    r, xw, k, v, xa, xg = jnp.split(z, RWKV_SPLITS, axis=-1)
    decay = jnp.exp(-RWKV_DECAY_SCALE * jax.nn.sigmoid(f(w0) + jnp.tanh(xw) @ f(w2)))
    iclr = jax.nn.sigmoid(f(a0) + xa @ f(a2))
    gate = jax.nn.sigmoid(xg) @ f(g2)
    heads = lambda t: t.reshape(B, L, H, N)
    kk = heads(k * f(k_k))
    kk = kk * lax.rsqrt(jnp.maximum(jnp.sum(kk * kk, -1, keepdims=True), 1e-12))
    k = k * (1.0 + (iclr - 1.0) * f(k_a))
    r_h, k_h, v_h = heads(r), heads(k), heads(v)
    tm = lambda t: jnp.moveaxis(t, 1, 0)
    xs = (tm(r_h), tm(heads(decay)), tm(k_h), tm(v_h), tm(-kk), tm(kk * heads(iclr)))

    def step(S, inp):
        r_t, w_t, k_t, v_t, a_t, b_t = inp
        sa = jnp.einsum('bhij,bhj->bhi', S, a_t)
        S = S * w_t[:, :, None, :] + sa[..., None] * b_t[:, :, None, :] + v_t[..., None] * k_t[:, :, None, :]
        return S, jnp.einsum('bhij,bhj->bhi', S, r_t)

    S0 = jnp.zeros((B, H, N, N), jnp.float32)
    _, y = lax.scan(step, S0, xs)
    y = jnp.moveaxis(y, 0, 1)
    mean = jnp.mean(y, -1, keepdims=True)
    var = jnp.mean(jnp.square(y - mean), -1, keepdims=True)
    y = ((y - mean) * lax.rsqrt(var + RWKV_LN_EPS)).reshape(B, L, RWKV_WIDTH) * f(ln_w) + f(ln_b)
    bonus = jnp.sum(r_h * k_h * f(r_k).reshape(H, N), -1, keepdims=True) * v_h
    y = y + bonus.reshape(B, L, RWKV_WIDTH)
    return y * gate


def s5_ssm(u, lam_re, lam_im, b_re, b_im, c_re, c_im, d, log_dt, glu_w, glu_b):
    B, L = u.shape[0], u.shape[1]
    f = lambda p: p.astype(jnp.float32)
    uf = f(u).reshape(B, L, SSM_GROUPS, SSM_GROUP_CH)
    lr, li = f(lam_re), f(lam_im)
    dt = jnp.exp(f(log_dt))[:, None]
    mag = jnp.exp(lr * dt)
    ab_re = mag * jnp.cos(li * dt)
    ab_im = mag * jnp.sin(li * dt)
    den = lr * lr + li * li
    fr = ((ab_re - 1.0) * lr + ab_im * li) / den
    fi = (ab_im * lr - (ab_re - 1.0) * li) / den
    bb_re = fr[..., None] * f(b_re) - fi[..., None] * f(b_im)
    bb_im = fr[..., None] * f(b_im) + fi[..., None] * f(b_re)
    bu_re = jnp.einsum('blgm,gpm->lbgp', uf, bb_re)
    bu_im = jnp.einsum('blgm,gpm->lbgp', uf, bb_im)
    a_re = jnp.broadcast_to(ab_re, (L, SSM_GROUPS, SSM_STATE))
    a_im = jnp.broadcast_to(ab_im, (L, SSM_GROUPS, SSM_STATE))

    def combine(e1, e2):
        a1r, a1i, b1r, b1i = e1
        a2r, a2i, b2r, b2i = e2
        ar = a2r * a1r - a2i * a1i
        ai = a2r * a1i + a2i * a1r
        br = a2r[:, None] * b1r - a2i[:, None] * b1i + b2r
        bi = a2r[:, None] * b1i + a2i[:, None] * b1r + b2i
        return (ar, ai, br, bi)

    _, _, x_re, x_im = lax.associative_scan(combine, (a_re, a_im, bu_re, bu_im), axis=0)
    y = (jnp.einsum('lbgp,gmp->blgm', x_re, f(c_re))
         - jnp.einsum('lbgp,gmp->blgm', x_im, f(c_im)))
    y = y + f(d).reshape(SSM_GROUPS, SSM_GROUP_CH) * uf
    y = y.reshape(B, L, SSM_WIDTH)
    zg = jax.nn.gelu(y)
    return zg * jax.nn.sigmoid(zg @ f(glu_w) + f(glu_b))


def hybrid_mixer(hn, w_in, q_g, k_g, sinks, rel_bias,
                 r_mu, r_w0, r_w2, r_a0, r_a2, r_g2, r_kk, r_ka, r_rk, r_lnw, r_lnb,
                 s_lre, s_lim, s_bre, s_bim, s_cre, s_cim, s_d, s_dt, s_gw, s_gb,
                 attn_out_g, ssm_out_g, w_out):
    B, L = hn.shape[0], hn.shape[1]
    z = hn @ w_in
    q = z[..., :Q_END].reshape(B, L, ATTN_HEADS, HEAD_DIM)
    k = z[..., Q_END:K_END].reshape(B, L, ATTN_KV_HEADS, HEAD_DIM)
    v = z[..., K_END:V_END].reshape(B, L, ATTN_KV_HEADS, HEAD_DIM)
    attn = sliding_window_attention(q, k, v, q_g, k_g, sinks, rel_bias)
    rw = rwkv7_time_mix(z[..., V_END:RWKV_END], r_mu, r_w0, r_w2, r_a0, r_a2, r_g2,
                        r_kk, r_ka, r_rk, r_lnw, r_lnb)
    ss = s5_ssm(z[..., RWKV_END:], s_lre, s_lim, s_bre, s_bim, s_cre, s_cim, s_d, s_dt, s_gw, s_gb)
    mixed = jnp.concatenate([rmsnorm(attn, attn_out_g).astype(hn.dtype),
                             rw.astype(hn.dtype),
                             rmsnorm(ss, ssm_out_g).astype(hn.dtype)], axis=-1)
    return mixed @ w_out


def swiglu(h, w1, w3, w2):
    return (jax.nn.silu(h @ w1) * (h @ w3)) @ w2


def moe_swiglu(h, router, w1, w3, w2):
    B, L, Dm = h.shape
    t = h.reshape(B * L, Dm)
    logits = t.astype(jnp.float32) @ router.astype(jnp.float32)
    top_v, top_i = lax.top_k(logits, TOP_K)
    gates = jax.nn.softmax(top_v, axis=-1)
    weights = jnp.sum(gates[..., None] * jax.nn.one_hot(top_i, N_EXPERTS, dtype=jnp.float32), axis=1)
    y = jnp.zeros((B * L, Dm), jnp.float32)
    for e in range(N_EXPERTS):
        y = y + weights[:, e:e + 1] * swiglu(t, w1[e], w3[e], w2[e]).astype(jnp.float32)
    return y.reshape(B, L, Dm).astype(h.dtype)


def setup_inputs(seed: int = 0) -> dict:
    key = jax.random.key(seed)
    ks = iter(jax.random.split(key, 64))
    f32 = jnp.float32
    nrm = lambda shape, scale: scale * jax.random.normal(next(ks), shape, f32)
    uni = lambda shape, lo, hi: jax.random.uniform(next(ks), shape, f32, lo, hi)
    n_idx = jnp.arange(SSM_STATE, dtype=f32)
    inp = {}
    inp['x'] = nrm((BATCH, SEQ, D_MODEL), 1.0)
    inp['norm1_g'] = 1.0 + nrm((DEPTH, D_MODEL), 0.05)
    inp['w_in'] = nrm((DEPTH, D_MODEL, IN_COLS), D_MODEL ** -0.5)
    inp['q_norm_g'] = 1.0 + nrm((DEPTH, HEAD_DIM), 0.05)
    inp['k_norm_g'] = 1.0 + nrm((DEPTH, HEAD_DIM), 0.05)
    inp['attn_sinks'] = nrm((DEPTH, ATTN_HEADS), 0.5)
    inp['rel_bias'] = nrm((REL_BUCKETS, ATTN_HEADS), 0.5)
    inp['rwkv_mu'] = uni((DEPTH, RWKV_COLS), 0.0, 1.0)
    inp['rwkv_w0'] = nrm((DEPTH, RWKV_WIDTH), 1.0)
    inp['rwkv_w2'] = nrm((DEPTH, RWKV_DECAY_LORA, RWKV_WIDTH), 0.1 * RWKV_DECAY_LORA ** -0.5)
    inp['rwkv_a0'] = nrm((DEPTH, RWKV_WIDTH), 0.1)
    inp['rwkv_a2'] = nrm((DEPTH, RWKV_A_LORA, RWKV_WIDTH), 0.1 * RWKV_A_LORA ** -0.5)
    inp['rwkv_g2'] = nrm((DEPTH, RWKV_GATE_LORA, RWKV_WIDTH), RWKV_GATE_LORA ** -0.5)
    inp['rwkv_k_k'] = 0.85 + nrm((DEPTH, RWKV_WIDTH), 0.05)
    inp['rwkv_k_a'] = 1.0 + nrm((DEPTH, RWKV_WIDTH), 0.05)
    inp['rwkv_r_k'] = nrm((DEPTH, RWKV_WIDTH), 0.1)
    inp['rwkv_ln_w'] = 1.0 + nrm((DEPTH, RWKV_WIDTH), 0.05)
    inp['rwkv_ln_b'] = nrm((DEPTH, RWKV_WIDTH), 0.01)
    inp['ssm_lambda_re'] = -0.5 + nrm((DEPTH, SSM_GROUPS, SSM_STATE), 0.01)
    inp['ssm_lambda_im'] = jnp.pi * n_idx + nrm((DEPTH, SSM_GROUPS, SSM_STATE), 0.01)
    inp['ssm_b_re'] = nrm((DEPTH, SSM_GROUPS, SSM_STATE, SSM_GROUP_CH), (2 * SSM_GROUP_CH) ** -0.5)
    inp['ssm_b_im'] = nrm((DEPTH, SSM_GROUPS, SSM_STATE, SSM_GROUP_CH), (2 * SSM_GROUP_CH) ** -0.5)
    inp['ssm_c_re'] = nrm((DEPTH, SSM_GROUPS, SSM_GROUP_CH, SSM_STATE), (2 * SSM_STATE) ** -0.5)
    inp['ssm_c_im'] = nrm((DEPTH, SSM_GROUPS, SSM_GROUP_CH, SSM_STATE), (2 * SSM_STATE) ** -0.5)
    inp['ssm_d'] = nrm((DEPTH, SSM_WIDTH), 1.0)
    inp['ssm_log_dt'] = uni((DEPTH, SSM_GROUPS), math.log(DT_MIN), math.log(DT_MAX))
    inp['ssm_glu_w'] = nrm((DEPTH, SSM_WIDTH, SSM_WIDTH), SSM_WIDTH ** -0.5)
    inp['ssm_glu_b'] = nrm((DEPTH, SSM_WIDTH), 0.01)
    inp['attn_out_g'] = 1.0 + nrm((DEPTH, ATTN_WIDTH), 0.05)
    inp['ssm_out_g'] = 1.0 + nrm((DEPTH, SSM_WIDTH), 0.05)
    inp['w_out'] = nrm((DEPTH, D_MODEL, D_MODEL), D_MODEL ** -0.5)
    inp['norm2_g'] = 1.0 + nrm((DEPTH, D_MODEL), 0.05)
    inp['ffn_w1'] = nrm((N_DENSE, D_MODEL, D_FF), D_MODEL ** -0.5)
    inp['ffn_w3'] = nrm((N_DENSE, D_MODEL, D_FF), D_MODEL ** -0.5)
    inp['ffn_w2'] = nrm((N_DENSE, D_FF, D_MODEL), D_FF ** -0.5)
    inp['moe_router'] = nrm((N_MOE, D_MODEL, N_EXPERTS), D_MODEL ** -0.5)
    inp['moe_w1'] = nrm((N_MOE, N_EXPERTS, D_MODEL, D_FF_EXPERT), D_MODEL ** -0.5)
    inp['moe_w3'] = nrm((N_MOE, N_EXPERTS, D_MODEL, D_FF_EXPERT), D_MODEL ** -0.5)
    inp['moe_w2'] = nrm((N_MOE, N_EXPERTS, D_FF_EXPERT, D_MODEL), D_FF_EXPERT ** -0.5)
    return inp


def reference(x, norm1_g, w_in, q_norm_g, k_norm_g, attn_sinks, rel_bias,
              rwkv_mu, rwkv_w0, rwkv_w2, rwkv_a0, rwkv_a2, rwkv_g2, rwkv_k_k, rwkv_k_a,
              rwkv_r_k, rwkv_ln_w, rwkv_ln_b,
              ssm_lambda_re, ssm_lambda_im, ssm_b_re, ssm_b_im, ssm_c_re, ssm_c_im,
              ssm_d, ssm_log_dt, ssm_glu_w, ssm_glu_b,
              attn_out_g, ssm_out_g, w_out, norm2_g,
              ffn_w1, ffn_w3, ffn_w2, moe_router, moe_w1, moe_w3, moe_w2):
    h = x
    for i in range(DEPTH):
        hn = rmsnorm(h, norm1_g[i])
        mix = hybrid_mixer(hn, w_in[i], q_norm_g[i], k_norm_g[i], attn_sinks[i], rel_bias,
                           rwkv_mu[i], rwkv_w0[i], rwkv_w2[i], rwkv_a0[i], rwkv_a2[i], rwkv_g2[i],
                           rwkv_k_k[i], rwkv_k_a[i], rwkv_r_k[i], rwkv_ln_w[i], rwkv_ln_b[i],
                           ssm_lambda_re[i], ssm_lambda_im[i], ssm_b_re[i], ssm_b_im[i],
                           ssm_c_re[i], ssm_c_im[i], ssm_d[i], ssm_log_dt[i],
                           ssm_glu_w[i], ssm_glu_b[i], attn_out_g[i], ssm_out_g[i], w_out[i])
        h = h + mix.astype(h.dtype)
        hn = rmsnorm(h, norm2_g[i])
        j = i // 2
        if i % 2 == 0:
            ff = swiglu(hn, ffn_w1[j], ffn_w3[j], ffn_w2[j])
        else:
            ff = moe_swiglu(hn, moe_router[j], moe_w1[j], moe_w3[j], moe_w2[j])
        h = h + ff.astype(h.dtype)
    return h
```

```cpp
#include <hip/hip_runtime.h>
#include <cstdint>
#include <cstdio>

#define LAS __attribute__((address_space(3)))
#define GAS __attribute__((address_space(1)))
#define CAS __attribute__((address_space(4)))
typedef unsigned short bf16_t;
typedef short bf16x8 __attribute__((ext_vector_type(8)));
typedef short s16x4 __attribute__((ext_vector_type(4)));
typedef float f32x4 __attribute__((ext_vector_type(4)));
typedef float f32x2 __attribute__((ext_vector_type(2)));
typedef unsigned u32x4 __attribute__((ext_vector_type(4)));
typedef unsigned u32x2 __attribute__((ext_vector_type(2)));
typedef int i32x4 __attribute__((ext_vector_type(4)));
typedef int i32x8 __attribute__((ext_vector_type(8)));

constexpr int BATCH = 2, SEQ = 16384, T = BATCH * SEQ, D = 2048;
constexpr int IN_COLS = 3840, ATT_W = 1024, KV_W = 256, RW_W = 512, SS_W = 512, RW_COLS = 1792;
constexpr int ZATT_W = ATT_W + 2 * KV_W;
constexpr int DFF = 5632, DFFE = 7168, NEXP = 8;
constexpr float NORM_EPS = 1e-6f;
constexpr int NWAVES = 8, NTHREADS = 512;
#ifndef MK_ONE_LAUNCH
#define MK_ONE_LAUNCH 1
#define S5_BUILD_TAIL 1
#define S5_SCAN_IN_G2 1
#define MK_SPLIT_COMBINE 1
#endif
#ifndef FFN_FP8
#define FFN_FP8 3
#endif
#ifndef DBG_PROBE_MOE13
#define DBG_PROBE_MOE13 0
#endif
#ifndef DBG_REP_MASK
#define DBG_REP_MASK 0ull
#endif
#ifndef DBG_REP_N
#define DBG_REP_N 2
#endif
#ifndef DBG_LAST_PHASE
#define DBG_LAST_PHASE 1000
#endif
constexpr int S5C = 64;
constexpr int S5K = 1152;
constexpr int RWC = 128, RWNC = SEQ / RWC;
constexpr int MAXSLOTS = 2 * T + NEXP * 256;

constexpr size_t MiB = 1u << 20;
constexpr size_t OFF_CTL = 0;
constexpr size_t CTL_ZERO_BYTES = 1 * MiB;
constexpr size_t OFF_SS = 1 * MiB;
constexpr size_t OFF_TOKE = OFF_SS + 8 * (size_t)T * 8;
constexpr size_t OFF_TOKG = OFF_TOKE + 2 * (size_t)T * 4;
constexpr size_t OFF_SLOT = OFF_TOKG + 2 * (size_t)T * 4;
constexpr size_t OFF_TOKOF = OFF_SLOT + 2 * (size_t)T * 4;
constexpr size_t OFF_WGCNT = OFF_TOKOF + (size_t)MAXSLOTS * 4;
constexpr size_t OFF_TILES = OFF_WGCNT + 256 * 8 * 4;
constexpr size_t OFF_RSSLOT = OFF_TILES + 256;
static_assert(OFF_RSSLOT + (size_t)MAXSLOTS * 4 <= 6 * MiB, "ctl region");
constexpr size_t OFF_XB = 6 * MiB;
constexpr size_t SZ_XB = (size_t)T * D * 2;
constexpr size_t OFF_WIN = OFF_XB + SZ_XB;
constexpr size_t SZ_WIN = (size_t)IN_COLS * D * 2;
constexpr size_t OFF_WOUT = OFF_WIN + 2 * SZ_WIN;
constexpr size_t SZ_WOUT = (size_t)D * D * 2;
constexpr size_t OFF_W13 = OFF_WOUT + 2 * SZ_WOUT;
constexpr size_t OFF_W2 = OFF_W13 + (size_t)2 * DFF * D * 2;
constexpr size_t OFF_BCAT = OFF_W2 + (size_t)D * DFF * 2;
constexpr size_t SZ_BCAT = (size_t)1536 * 256 * 2;
constexpr size_t OFF_WGLU = OFF_BCAT + 2 * SZ_BCAT;
constexpr size_t SZ_WGLU = (size_t)512 * 512 * 2;
constexpr size_t OFF_S5B2 = OFF_WGLU + 2 * SZ_WGLU;
constexpr size_t SZ_S5B2 = (size_t)32 * 1024 * S5K * 2;
constexpr size_t OFF_S5E = OFF_S5B2 + SZ_S5B2;
constexpr size_t SZ_S5E = (size_t)32 * 256 * 1024 * 2;
constexpr size_t OFF_MIX = OFF_S5E + SZ_S5E;
enum MixBuf { B_ZATT = 0, B_ZRW, B_UEXT, B_XLOC, B_ZG, B_ALORA, B_DEC, B_ICLR, B_GATE, B_STREAM, B_BONUS, B_YLOC, B_PVEC, B_PMAT, B_QMAT, B_SST, B_ATTRAW, B_SSRAW, B_MIXED, B_N };
constexpr size_t mb_size(int b) {
    switch (b) {
        case B_ZATT: return (size_t)T * ZATT_W * 2;
        case B_ZRW: return (size_t)T * RW_COLS * 2;
        case B_UEXT: return (size_t)32 * 512 * S5K * 2;
        case B_XLOC: return (size_t)32 * 512 * 128 * 4;
        case B_ZG: return (size_t)T * 512 * 2;
        case B_ALORA: return (size_t)T * 256 * 2;
        case B_DEC: return (size_t)T * 512 * 4;
        case B_ICLR: return (size_t)T * 512 * 4;
        case B_GATE: return (size_t)T * 512 * 2;
        case B_STREAM: return 0;
        case B_BONUS: return (size_t)2 * T * 8 * 4;
        case B_YLOC: return (size_t)T * 512 * 4;
        case B_PVEC: return (size_t)T * 512 * 4;
        case B_PMAT: return (size_t)2048 * 4096 * 4;
        case B_QMAT: return (size_t)2048 * 4096 * 4;
        case B_SST: return (size_t)2048 * 4096 * 4;
        case B_ATTRAW: return (size_t)T * 1024 * 2;
        case B_SSRAW: return (size_t)T * 512 * 2;
        case B_MIXED: return (size_t)T * D * 2;
    }
    return 0;
}
constexpr int mb_order(int L, int i) {
    constexpr int o0[B_N] = {B_ZATT, B_ZRW, B_UEXT, B_XLOC, B_ZG, B_ALORA, B_DEC, B_ICLR, B_GATE, B_STREAM, B_BONUS, B_YLOC, B_PVEC, B_PMAT, B_QMAT, B_SST, B_ATTRAW, B_SSRAW, B_MIXED};
    constexpr int o1[B_N] = {B_STREAM, B_PVEC, B_ZATT, B_ZRW, B_UEXT, B_XLOC, B_ZG, B_ALORA, B_DEC, B_ICLR, B_GATE, B_BONUS, B_YLOC, B_PMAT, B_QMAT, B_SST, B_ATTRAW, B_SSRAW, B_MIXED};
    return L ? o1[i] : o0[i];
}
constexpr size_t moff(int L, int b) { size_t o = OFF_MIX; for (int i = 0; i < B_N; ++i) { if (mb_order(L, i) == b) return o; o += mb_size(mb_order(L, i)); } return o; }
constexpr size_t OFF_MIX_END = moff(0, B_MIXED) + mb_size(B_MIXED);
static_assert(moff(1, B_MIXED) + mb_size(B_MIXED) == OFF_MIX_END, "both layouts fill the same range");
#define MO(b) (layer ? moff(1, b) : moff(0, b))
constexpr size_t OFF_ACT = OFF_MIX;
static_assert(OFF_ACT + (size_t)T * DFF * 2 <= OFF_MIX_END, "dense act");
constexpr size_t OFF_MACT = OFF_XB;
constexpr size_t OFF_ASORT = OFF_MACT + (size_t)MAXSLOTS * DFFE;
constexpr size_t OFF_WM13 = OFF_MIX_END;
constexpr size_t OFF_WM2 = OFF_WM13 + (size_t)NEXP * 2 * DFFE * D;
constexpr size_t OFF_HB = OFF_WM2 + (size_t)NEXP * DFFE * D;
constexpr size_t OFF_X8 = OFF_HB + (size_t)T * D * 2;
constexpr size_t WS_NEED = OFF_X8 + (size_t)T * D;
static_assert((FFN_FP8 & 1) != 0, "OFF_X8 holds an fp8 copy");
static_assert(WS_NEED <= 1879048192ull && OFF_MIX_END <= 1879048192ull && OFF_ASORT + (size_t)MAXSLOTS * D * 2 <= OFF_WM13, "d_ws budget (4 x largest tensor)");

constexpr int RING_BYTES = 131072;
constexpr int MISC_OFF = RING_BYTES;
constexpr int LDS_BYTES = 147456;

__device__ __forceinline__ int lane_id() { int l; asm volatile("v_mbcnt_lo_u32_b32 %0, -1, 0\n\tv_mbcnt_hi_u32_b32 %0, -1, %0" : "=v"(l)); return l; }
#define RFL(x) __builtin_amdgcn_readfirstlane(x)
#define LDS_WAIT() asm volatile("s_waitcnt lgkmcnt(0)" ::: "memory")
#define VM_WAIT() asm volatile("s_waitcnt vmcnt(0)" ::: "memory")
__device__ __forceinline__ unsigned f2bf(float f) { unsigned u = __builtin_bit_cast(unsigned, f); return (u + 0x7fffu + ((u >> 16) & 1u)) >> 16; }
__device__ __forceinline__ unsigned pk2(float lo, float hi) { return f2bf(lo) | (f2bf(hi) << 16); }
__device__ __forceinline__ float bflo(unsigned w) { return __builtin_bit_cast(float, w << 16); }
__device__ __forceinline__ float bfhi(unsigned w) { return __builtin_bit_cast(float, w & 0xffff0000u); }
__device__ __forceinline__ float bf2f(bf16_t b) { return __builtin_bit_cast(float, (unsigned)b << 16); }
__device__ __forceinline__ unsigned cvt_pk_bf16(float lo, float hi) { unsigned r; asm volatile("v_cvt_pk_bf16_f32 %0, %1, %2" : "=v"(r) : "v"(lo), "v"(hi)); return r; }
__device__ __forceinline__ float clamp8(float v) { return __builtin_amdgcn_fmed3f(v, -448.0f, 448.0f); }
__device__ __forceinline__ unsigned pk8(float a, float b, float c, float d) { int w = 0; w = __builtin_amdgcn_cvt_pk_fp8_f32(a, b, w, false); w = __builtin_amdgcn_cvt_pk_fp8_f32(c, d, w, true); return (unsigned)w; }
__device__ __forceinline__ bf16x8 as_bf16(i32x4 v) { return __builtin_bit_cast(bf16x8, v); }
__device__ __forceinline__ i32x8 cat8(bf16x8 lo, bf16x8 hi) { return __builtin_shufflevector(__builtin_bit_cast(i32x4, lo), __builtin_bit_cast(i32x4, hi), 0, 1, 2, 3, 4, 5, 6, 7); }
constexpr float SC_H = 16.0f, SC_ACT = 8.0f, SC_W13 = 1024.0f, SC_W2 = 2048.0f;
__device__ __forceinline__ float wave_sum(float v) {
#pragma unroll
    for (int o = 1; o < 64; o <<= 1) v += __shfl_xor(v, o);
    return v;
}
__device__ __forceinline__ float frcp(float x) { return __builtin_amdgcn_rcpf(x); }
__device__ __forceinline__ float sigmoidf_(float x) { return frcp(1.0f + __builtin_amdgcn_exp2f(-1.4426950408889634f * x)); }
__device__ __forceinline__ unsigned long long ss_fix(float s) { return (unsigned long long)(s * 1048576.0f); }
__device__ __forceinline__ float ss_mean(unsigned long long v, float inv_n) { return (float)v * (1.0f / 1048576.0f) * inv_n + 1e-6f; }
__device__ __forceinline__ float ss_rs(unsigned long long v) { return rsqrtf((float)v * (1.0f / (1048576.0f * 2048.0f)) + 1e-6f); }

#define XB_TMO      128
#define XB_XCNT(j)  (256  + 64 * (j))
#define XB_XSUB(j)  (1280 + 64 * (j))
#define XB_XGEN(j)  (2304 + 64 * (j))
#define XB_TOP      3328
#define XB_TOPGEN   3392
#define XCD_BAR_WORDS 3456
#define XB_SPIN_CAP (1u << 18)
__device__ __forceinline__ unsigned xb_ld(unsigned* p)              { return __hip_atomic_load(p, __ATOMIC_RELAXED, __HIP_MEMORY_SCOPE_AGENT); }
__device__ __forceinline__ unsigned xb_add(unsigned* p, unsigned v) { return __hip_atomic_fetch_add(p, v, __ATOMIC_RELAXED, __HIP_MEMORY_SCOPE_AGENT); }
__device__ __forceinline__ unsigned xb_xcc_id() { return (unsigned)__builtin_amdgcn_s_getreg((3 << 11) | 20) & 0xFu; }
#define XB_SPIN(cond, bar) do { unsigned _sp = 0; while (cond) { __builtin_amdgcn_s_sleep(1); \
    if ((++_sp & 255u) == 0u) { if (xb_ld(&(bar)[XB_TMO])) break; if (_sp > XB_SPIN_CAP) { atomicAdd(&(bar)[XB_TMO], 1u); break; } } } } while (0)
struct XcdBarrier { unsigned* bar; unsigned x; volatile LAS unsigned* st; int wave; };
__device__ __forceinline__ XcdBarrier xcd_barrier_post(unsigned* bar, volatile LAS unsigned* st, int wave) {
    XcdBarrier b; b.bar = bar; b.x = xb_xcc_id(); b.st = st; b.wave = wave;
    if (wave == 0 && lane_id() == 0) (void)xb_add(&bar[XB_XCNT(b.x)], 1u);
    return b;
}
__device__ __forceinline__ void xcd_barrier_complete(unsigned* bar, unsigned x, unsigned& nloc, unsigned& nx) {
    const unsigned G = gridDim.x * gridDim.y * gridDim.z;
    unsigned sum, cnt, mine, sp = 0u;
    for (;;) {
        sum = 0u; cnt = 0u; mine = 0u;
#pragma unroll
        for (unsigned j = 0; j < 16; ++j) { const unsigned c = xb_ld(&bar[XB_XCNT(j)]); sum += c; cnt += (c > 0u) ? 1u : 0u; mine = (j == x) ? c : mine; }
        if (sum == G) break;
        __builtin_amdgcn_s_sleep(1);
        if ((++sp & 255u) == 0u) { if (xb_ld(&bar[XB_TMO])) break; if (sp > XB_SPIN_CAP) { atomicAdd(&bar[XB_TMO], 1u); break; } }
    }
    nloc = mine > 0u ? mine : 1u; nx = cnt > 0u ? cnt : 1u;
}
__device__ __forceinline__ void xcd_barrier(const XcdBarrier& b) {
    asm volatile("s_waitcnt vmcnt(0)" ::: "memory");
    __syncthreads();
    if (b.wave == 0 && lane_id() == 0) {
        unsigned* bar = b.bar;
        __builtin_amdgcn_s_waitcnt(0);
        unsigned nloc = b.st[0], nx = b.st[1];
        if (nloc == 0u) { xcd_barrier_complete(bar, b.x, nloc, nx); b.st[0] = nloc; b.st[1] = nx; }
        const unsigned old = xb_add(&bar[XB_XSUB(b.x)], 1u);
        const unsigned gen = old / nloc;
        if (old + 1u == (gen + 1u) * nloc) {
            __builtin_amdgcn_fence(__ATOMIC_RELEASE, "agent");
            asm volatile("s_waitcnt vmcnt(0)" ::: "memory");
            const unsigned og = xb_add(&bar[XB_TOP], 1u);
            const unsigned tg = og / nx;
            if (og + 1u == (tg + 1u) * nx) xb_add(&bar[XB_TOPGEN], 1u);
            else XB_SPIN(xb_ld(&bar[XB_TOPGEN]) == tg, bar);
            __builtin_amdgcn_fence(__ATOMIC_ACQUIRE, "agent");
            xb_add(&bar[XB_XGEN(b.x)], 1u);
            asm volatile("s_waitcnt vmcnt(0)" ::: "memory");
        } else {
            XB_SPIN(xb_ld(&bar[XB_XGEN(b.x)]) == gen, bar);
            __builtin_amdgcn_fence(__ATOMIC_ACQUIRE, "agent");
            asm volatile("s_waitcnt vmcnt(0)" ::: "memory");
        }
    }
    __syncthreads();
}

#define XS_SUB(j)  (8192 + 64 * (j))
#define XS_TOP     (8192 + 64 * 16)
#define XS_S5FLAG(l) (8192 + 64 * (17 + (l)))
__device__ __forceinline__ void split_arrive(const XcdBarrier& b) {
    asm volatile("s_waitcnt vmcnt(0)" ::: "memory");
    __syncthreads();
    if (b.wave == 0 && lane_id() == 0) {
        unsigned* bar = b.bar;
        __builtin_amdgcn_s_waitcnt(0);
        unsigned nloc = b.st[0], nx = b.st[1];
        if (nloc == 0u) { xcd_barrier_complete(bar, b.x, nloc, nx); b.st[0] = nloc; b.st[1] = nx; }
        const unsigned old = xb_add(&bar[XS_SUB(b.x)], 1u);
        if (old + 1u == nloc) { __builtin_amdgcn_fence(__ATOMIC_RELEASE, "agent"); asm volatile("s_waitcnt vmcnt(0)" ::: "memory"); xb_add(&bar[XS_TOP], 1u); }
    }
}
__device__ __forceinline__ void split_wait(const XcdBarrier& b) {
    if (b.wave == 0 && lane_id() == 0) {
        unsigned* bar = b.bar; const unsigned nx = b.st[1];
        XB_SPIN(xb_ld(&bar[XS_TOP]) != nx, bar);
        __builtin_amdgcn_fence(__ATOMIC_ACQUIRE, "agent");
        asm volatile("s_waitcnt vmcnt(0)" ::: "memory");
    }
    __syncthreads();
}

namespace pg8 {
constexpr int BM = 256, BK = 64, HALF = 128, HTB = HALF * BK * 2, STAGE_BYTES = 8 * HTB, NXCD = 8, WGM = 4;
__host__ __device__ __forceinline__ int lds_byte(int r, int c) { const int st = (r >> 4) * 2 + (c >> 5), rr = r & 15, cc = c & 31, ob = rr * 64 + cc * 2; return st * 1024 + (ob ^ (((ob >> 9) & 1) << 5)); }
__host__ __device__ __forceinline__ void stage_rc(int b, int& R, int& C) { const int st = b / 1024, sb = b % 1024, swz = sb ^ (((sb >> 9) & 1) << 5); R = (st >> 1) * 16 + swz / 64; C = (st & 1) * 32 + (swz % 64) / 2; }
__host__ __device__ __forceinline__ int perm32(int rho) { const int n = rho >> 4, i = rho & 15; return 8 * (i >> 2) + 4 * n + (i & 3); }
struct Unit { int pm, pn; };
__device__ __forceinline__ bool static_unit(int L, int nM, int nN, Unit& u) {
    const int nwg = nM * nN; if (L < 0 || L >= nwg) return false;
    int wgid = (int)L; { const int q = nwg / NXCD, r = nwg % NXCD, xcd = wgid % NXCD, off = wgid / NXCD; wgid = (xcd < r ? xcd * (q + 1) : r * (q + 1) + (xcd - r) * q) + off; }
    const int nig = WGM * nN, gid = wgid / nig, fm = gid * WGM, gsz = (nM - fm) < WGM ? (nM - fm) : WGM;
    u.pm = fm + ((wgid % nig) % gsz); u.pn = (wgid % nig) / gsz; return true;
}

__device__ __forceinline__ void glds_s(const char* sbase, unsigned voff, unsigned ldsdst) {
    asm volatile("s_mov_b32 m0, %2\n\ts_nop 0\n\tglobal_load_lds_dwordx4 %0, %1" : : "v"(voff), "s"(sbase), "s"(ldsdst) : "memory", "m0");
}
__device__ __forceinline__ const char* uniform_ptr(const char* p) { const unsigned long v = (unsigned long)p;
    const unsigned lo = __builtin_amdgcn_readfirstlane((unsigned)v), hi = __builtin_amdgcn_readfirstlane((unsigned)(v >> 32)); return (const char*)(((unsigned long)hi << 32) | lo); }
template <class Epi, class Prob>
__device__ __forceinline__ void gemm_phase(LAS unsigned char* lds, const Prob& P, const Epi& E, int wave) {
    int lane = lane_id(); asm volatile("" : "+v"(lane));
    const int wid = wave, tid = wave * 64 + lane, wr = wid >> 2, wc = wid & 3, fr = lane & 15, fq = lane >> 4;
    constexpr int ESZ = Prob::FP8 ? 1 : 2;
    const int K = P.K, nt = K * ESZ / 128;
    unsigned voffA, voffB;
    { int R, C; stage_rc(tid * 16, R, C); const int Rb = Epi::PERM ? ((R & ~31) + perm32(R & 31)) : R;
      voffA = (unsigned)(R * P.lda * ESZ + 2 * C); voffB = (unsigned)(Rb * P.ldb * ESZ + 2 * C); }
    const size_t r64A = (size_t)64 * P.lda * ESZ, r64B = (size_t)64 * P.ldb * ESZ;
    const unsigned ldsbase = (unsigned)(unsigned long)lds;
    const size_t kstep = (size_t)(BK * 2);
    const size_t hA = (size_t)HALF * P.lda * ESZ, hB = (size_t)HALF * P.ldb * ESZ;
    const unsigned ldsw = (unsigned)wid * 1024u;
    int aoff = lds_byte(wr * 64 + fr, fq * 8), boff = lds_byte(wc * 32 + fr, fq * 8) + 4 * HTB; asm volatile("" : "+v"(aoff), "+v"(boff));
    const LAS unsigned char* la = lds + aoff; const LAS unsigned char* lb = lds + boff;
#define PG8_SA(b, h) (((b) * 2 + (h)) * HTB)
#define PG8_SB(b, h) ((4 + (b) * 2 + (h)) * HTB)
#define PG8_STAGE(bufoff, gbase, AB) do { glds_s((const char*)(gbase), voff##AB, ldsbase + (bufoff) + ldsw); glds_s((const char*)(gbase) + r64##AB, voff##AB, ldsbase + (bufoff) + ldsw + 8192u); } while (0)
#define PG8_LDA(dst, b, h) do { _Pragma("unroll") for (int m = 0; m < 4; ++m) { dst[m].lo = *(const LAS i32x4*)(la + PG8_SA(b, h) + m * 2048); dst[m].hi = *(const LAS i32x4*)(la + PG8_SA(b, h) + m * 2048 + 1024); } } while (0)
#define PG8_LDB(dst, b, h) do { _Pragma("unroll") for (int n = 0; n < 2; ++n) { dst[n].lo = *(const LAS i32x4*)(lb + (PG8_SB(b, h) - 4 * HTB) + n * 2048); dst[n].hi = *(const LAS i32x4*)(lb + (PG8_SB(b, h) - 4 * HTB) + n * 2048 + 1024); } } while (0)
#define PG8_MMA(ai, bj, At, Bt) do { __builtin_amdgcn_s_setprio(1); _Pragma("unroll") for (int m = 0; m < 4; ++m) _Pragma("unroll") for (int n = 0; n < 2; ++n) { \
        if constexpr (Prob::FP8) acc[ai][bj][m][n] = __builtin_amdgcn_mfma_scale_f32_16x16x128_f8f6f4(Bt[n], At[m], acc[ai][bj][m][n], 0, 0, 0, 0x7f7f7f7f, 0, 0x7f7f7f7f); \
        else { acc[ai][bj][m][n] = __builtin_amdgcn_mfma_f32_16x16x32_bf16(as_bf16(Bt[n].lo), as_bf16(At[m].lo), acc[ai][bj][m][n], 0, 0, 0); \
               acc[ai][bj][m][n] = __builtin_amdgcn_mfma_f32_16x16x32_bf16(as_bf16(Bt[n].hi), as_bf16(At[m].hi), acc[ai][bj][m][n], 0, 0, 0); } } \
        __builtin_amdgcn_s_setprio(0); } while (0)
#define PG8_WAIT_V(n) asm volatile("s_waitcnt vmcnt(" #n ")" ::: "memory")
#define PG8_WAIT_L(n) asm volatile("s_waitcnt lgkmcnt(" #n ")" ::: "memory")
#define PG8_BAR __builtin_amdgcn_s_barrier()
#define PG8_SCHED __builtin_amdgcn_sched_barrier(0)
    Unit cur, nxt; int ui = 0;
    if (!P.next(0, cur)) return;
    f32x4 acc[2][2][4][2];
#pragma unroll
    for (int a = 0; a < 2; ++a)
#pragma unroll
        for (int b = 0; b < 2; ++b)
#pragma unroll
            for (int m = 0; m < 4; ++m)
#pragma unroll
                for (int n = 0; n < 2; ++n) acc[a][b][m][n] = (f32x4){0.f, 0.f, 0.f, 0.f};
    i32x8 At[4], B0[2], B1[2];
    const char* cA = uniform_ptr(P.abase(cur)); const char* cB = uniform_ptr(P.bbase(cur));
    PG8_STAGE(PG8_SB(0, 0), cB, B); PG8_STAGE(PG8_SB(0, 1), cB + hB, B); PG8_STAGE(PG8_SA(0, 0), cA, A); PG8_STAGE(PG8_SA(0, 1), cA + hA, A);
    if (wr == 1) PG8_BAR;
    PG8_WAIT_V(2); PG8_BAR;
    PG8_STAGE(PG8_SB(1, 0), cB + kstep, B); PG8_STAGE(PG8_SA(1, 0), cA + kstep, A); PG8_STAGE(PG8_SB(1, 1), cB + hB + kstep, B);
    PG8_WAIT_V(6); PG8_BAR;
    for (;;) {
        const bool has_next = P.next(ui + 1, nxt);
        const char* nA = uniform_ptr(has_next ? P.abase(nxt) : cA); const char* nB = uniform_ptr(has_next ? P.bbase(nxt) : cB);
        int tb = 0;
        for (int seg = 0; seg < (Epi::MID ? 3 : 1); ++seg) {
        int te = nt; if constexpr (Epi::MID) { te = seg == 0 ? Epi::T1 : (seg == 1 ? Epi::T2 : nt); }
        for (int t = tb; t < te; t += 2) {
            const bool last = (t == nt - 2);
            const char* a1 = cA + (size_t)(t + 1) * kstep;
            const char* a2 = last ? nA : cA + (size_t)(t + 2) * kstep; const char* b2 = last ? nB : cB + (size_t)(t + 2) * kstep;
            const char* a3 = a2 + kstep; const char* b3 = b2 + kstep;
            PG8_LDB(B0, 0, 0); PG8_LDB(B1, 0, 1); PG8_SCHED; PG8_LDA(At, 0, 0); PG8_STAGE(PG8_SA(1, 1), a1 + hA, A);
            PG8_WAIT_V(8); PG8_WAIT_L(0); PG8_BAR; PG8_MMA(0, 0, At, B0); PG8_MMA(0, 1, At, B1); PG8_BAR; PG8_SCHED;
            PG8_LDA(At, 0, 1); PG8_STAGE(PG8_SB(0, 0), b2, B); PG8_STAGE(PG8_SB(0, 1), b2 + hB, B); PG8_STAGE(PG8_SA(0, 0), a2, A);
            PG8_WAIT_V(8); PG8_WAIT_L(0); PG8_BAR; PG8_MMA(1, 0, At, B0); PG8_MMA(1, 1, At, B1); PG8_BAR; PG8_SCHED;
            PG8_LDB(B0, 1, 0); PG8_LDB(B1, 1, 1); PG8_SCHED; PG8_LDA(At, 1, 0); PG8_STAGE(PG8_SA(0, 1), a2 + hA, A);
            PG8_WAIT_V(8); PG8_WAIT_L(0); PG8_BAR; PG8_MMA(0, 0, At, B0); PG8_MMA(0, 1, At, B1); PG8_BAR; PG8_SCHED;
            PG8_LDA(At, 1, 1); PG8_STAGE(PG8_SB(1, 0), b3, B); PG8_STAGE(PG8_SB(1, 1), b3 + hB, B); PG8_STAGE(PG8_SA(1, 0), a3, A);
            PG8_WAIT_V(8); PG8_WAIT_L(0); PG8_BAR; PG8_MMA(1, 0, At, B0); PG8_MMA(1, 1, At, B1); PG8_BAR; PG8_SCHED;
        }
        if constexpr (Epi::MID) { if (seg < 2) E.mid(acc, cur, wr, fr, seg); }
        tb = te;
        }
        if (wr == 0) PG8_BAR;
        { int frx = fr, fqx = fq; asm volatile("" : "+v"(frx), "+v"(fqx));
          E(acc, cur, wr, wc, frx, fqx); }
        if (!has_next) break;
#pragma unroll
        for (int a = 0; a < 2; ++a)
#pragma unroll
            for (int b = 0; b < 2; ++b)
#pragma unroll
                for (int m = 0; m < 4; ++m)
#pragma unroll
                    for (int n = 0; n < 2; ++n) acc[a][b][m][n] = (f32x4){0.f, 0.f, 0.f, 0.f};
        cur = nxt; cA = nA; cB = nB; ++ui;
        if (wr == 1) PG8_BAR;
    }
    PG8_WAIT_V(0);
    PG8_BAR;
#undef PG8_SA
#undef PG8_SB
#undef PG8_STAGE
#undef PG8_LDA
#undef PG8_LDB
#undef PG8_MMA
#undef PG8_WAIT_V
#undef PG8_WAIT_L
#undef PG8_BAR
#undef PG8_SCHED
}
}
using pg8::Unit; using pg8::glds_s; using pg8::uniform_ptr;

template <bool FP8_ = false> struct ProbPlainT {
    static constexpr bool FP8 = FP8_;
    const void* A; const void* Bt; int K, lda, ldb, nM, nN, G, c;
    __device__ __forceinline__ bool next(int i, Unit& u) const { return pg8::static_unit(i * G + c, nM, nN, u); }
    __device__ __forceinline__ const char* abase(const Unit& u) const { return (const char*)A + (size_t)u.pm * 256 * lda * (FP8 ? 1 : 2); }
    __device__ __forceinline__ const char* bbase(const Unit& u) const { return (const char*)Bt + (size_t)u.pn * 256 * ldb * (FP8 ? 1 : 2); }
};
typedef ProbPlainT<false> ProbPlain;
typedef ProbPlainT<true> ProbPlain8;

struct Args { const float* in[39]; float* out; unsigned char* ws; int ph_lo, ph_hi; };
static_assert(sizeof(Args) == 39 * 8 + 8 + 8 + 8, "no padding in Args");
enum In { I_X = 0, I_N1G, I_WIN, I_QG, I_KG, I_SINK, I_RELB, I_MU, I_W0, I_W2, I_A0, I_A2, I_G2, I_KK, I_KA, I_RK, I_LNW, I_LNB,
          I_LRE, I_LIM, I_BRE, I_BIM, I_CRE, I_CIM, I_SD, I_DT, I_GLUW, I_GLUB, I_AOG, I_SOG, I_WOUT, I_N2G, I_F1, I_F3, I_F2, I_ROUTER, I_M1, I_M3, I_M2 };

struct Frame {
    LAS unsigned char* lds;
    int tid, lane, wave, G, bx;
    unsigned char* ws; float* out;
};

__device__ __forceinline__ Frame fresh(const Frame& F0) { Frame F = F0; int l = lane_id(); asm volatile("" : "+v"(l)); F.lane = l; F.tid = F0.wave * 64 + l; return F; }
__device__ __forceinline__ void transpose_item(const float* W, int N, bf16_t* WT, int ldt, int k0, int n0, int drow0, const float* gk, LAS float* scr, int lane, const float* gk2 = nullptr) {
#pragma unroll 8
    for (int i = 0; i < 32; ++i) { const int kk = 2 * i + (lane >> 5), k = k0 + kk; float w = W[(size_t)k * N + n0 + (lane & 31)];
        if (gk) w *= gk2 ? (k < 1024 ? gk[k] : (k < 1536 ? 1.0f : gk2[k - 1536])) : gk[k]; scr[kk * 33 + (lane & 31)] = w; }
    LDS_WAIT(); asm volatile("" ::: "memory");
    const int c = lane & 7;
#pragma unroll
    for (int j = 0; j < 4; ++j) { const int n = (lane >> 3) + 8 * j; const LAS float* s = scr + (8 * c) * 33 + n;
        u32x4 o; o.x = pk2(s[0 * 33], s[1 * 33]); o.y = pk2(s[2 * 33], s[3 * 33]); o.z = pk2(s[4 * 33], s[5 * 33]); o.w = pk2(s[6 * 33], s[7 * 33]);
        *(u32x4*)(WT + (size_t)(drow0 + n) * ldt + k0 + 8 * c) = o; }
    LDS_WAIT(); asm volatile("" ::: "memory");
}
__device__ __forceinline__ void cvt8_load(const float* W, int N, int k0, int n0, int lane, f32x4 (&v)[8]) {
    const float* p = W + (size_t)(k0 + (lane >> 3)) * N + n0 + 4 * (lane & 7);
#pragma unroll
    for (int i = 0; i < 8; ++i) v[i] = __builtin_nontemporal_load((const f32x4*)(p + (size_t)(8 * i) * N));
}
__device__ __forceinline__ void cvt8_finish(const f32x4 (&v)[8], unsigned char* WT, int ldt, int k0, int drow0, const float* gk, float wsc, LAS float* scr, int lane) {
    const int r = lane >> 3, c4 = 4 * (lane & 7);
#pragma unroll
    for (int i = 0; i < 8; ++i) { const int kk = 8 * i + r; float sc = wsc; if (gk) sc *= gk[k0 + kk];
        LAS float* d = scr + kk * 33 + c4; d[0] = v[i].x * sc; d[1] = v[i].y * sc; d[2] = v[i].z * sc; d[3] = v[i].w * sc; }
    LDS_WAIT(); asm volatile("" ::: "memory");
    const int c = lane & 3;
#pragma unroll
    for (int j = 0; j < 2; ++j) { const int n = (lane >> 2) + 16 * j; const LAS float* s = scr + (16 * c) * 33 + n;
        u32x4 o; o.x = pk8(s[0 * 33], s[1 * 33], s[2 * 33], s[3 * 33]); o.y = pk8(s[4 * 33], s[5 * 33], s[6 * 33], s[7 * 33]); o.z = pk8(s[8 * 33], s[9 * 33], s[10 * 33], s[11 * 33]); o.w = pk8(s[12 * 33], s[13 * 33], s[14 * 33], s[15 * 33]);
        *(u32x4*)(WT + (size_t)(drow0 + n) * ldt + k0 + 16 * c) = o; }
    LDS_WAIT(); asm volatile("" ::: "memory");
}
__device__ __forceinline__ void transpose_item8(const float* W, int N, unsigned char* WT, int ldt, int k0, int n0, int drow0, const float* gk, float wsc, LAS float* scr, int lane) {
    f32x4 v[8]; cvt8_load(W, N, k0, n0, lane, v); cvt8_finish(v, WT, ldt, k0, drow0, gk, wsc, scr, lane);
}
__device__ __forceinline__ void transpose_matrix8(const Frame& F, const float* W, int K, int N, unsigned char* WT, int ldt, const float* gk, float wsc, int mode) {
    LAS float* scr = (LAS float*)(F.lds + F.wave * 16384);
    const int gw = F.bx * NWAVES + F.wave, NGW = F.G * NWAVES, nblk = N / 32, nitems = (K / 64) * nblk;
    for (int it = gw; it < nitems; it += NGW) {
        const int kb = it / nblk, nb = it % nblk, n0 = 32 * nb;
        const int drow0 = mode == 0 ? n0 : (n0 >> 7) * 256 + (n0 & 127) + (mode == 2 ? 128 : 0);
        transpose_item8(W, N, WT, ldt, 64 * kb, n0, drow0, gk, wsc, scr, F.lane);
    }
}
__device__ __forceinline__ void transpose_matrix(const Frame& F, const float* W, int K, int N, bf16_t* WT, int ldt, const float* gk, int mode, const float* gk2 = nullptr) {
    LAS float* scr = (LAS float*)(F.lds + F.wave * 16384);
    const int gw = F.bx * NWAVES + F.wave, NGW = F.G * NWAVES, nblk = N / 32, nitems = (K / 64) * nblk;
    for (int it = gw; it < nitems; it += NGW) {
        const int kb = it / nblk, nb = it % nblk, n0 = 32 * nb;
        const int drow0 = mode == 0 ? n0 : (n0 >> 7) * 256 + (n0 & 127) + (mode == 2 ? 128 : 0);
        transpose_item(W, N, WT, ldt, 64 * kb, n0, drow0, gk, scr, F.lane, gk2);
    }
}

constexpr int MOE_ITEMS = NEXP * 3 * 7168;
struct MoeItem { const float* W; unsigned char* WT; const float* gk; float wsc; int N, ldt, k0, n0, drow0; };
__device__ __forceinline__ MoeItem moe_item(const CAS Args& a, unsigned char* ws, int I) {
    MoeItem m; const int e = I / 21504, r = I - e * 21504, mat = r / 7168, it = r - mat * 7168;
    if (mat < 2) { const int nblk = DFFE / 32, kb = it / nblk, n0 = 32 * (it % nblk);
        m.W = (mat == 0 ? a.in[I_M1] : a.in[I_M3]) + (size_t)e * D * DFFE; m.N = DFFE; m.WT = ws + OFF_WM13 + (size_t)e * 2 * DFFE * D; m.ldt = D; m.k0 = 64 * kb; m.n0 = n0;
        m.drow0 = (n0 >> 7) * 256 + (n0 & 127) + (mat == 1 ? 128 : 0); m.gk = a.in[I_N2G] + D; m.wsc = SC_W13; }
    else { const int nblk = D / 32, kb = it / nblk, n0 = 32 * (it % nblk);
        m.W = a.in[I_M2] + (size_t)e * DFFE * D; m.N = D; m.WT = ws + OFF_WM2 + (size_t)e * D * DFFE; m.ldt = DFFE; m.k0 = 64 * kb; m.n0 = n0; m.drow0 = n0; m.gk = nullptr; m.wsc = SC_W2; }
    return m;
}
__device__ __forceinline__ void moe_convert_range(const Frame& F, const CAS Args& a, int i0, int i1, int wg0, int nwg) {
    if (F.bx < wg0 || F.bx >= wg0 + nwg) return;
    LAS float* scr = (LAS float*)(F.lds + F.wave * 16384);
    const int step = nwg * NWAVES;
    int I = i0 + (F.bx - wg0) * NWAVES + F.wave;
    if (I >= i1) return;
    MoeItem cur = moe_item(a, F.ws, I); f32x4 v[8]; cvt8_load(cur.W, cur.N, cur.k0, cur.n0, F.lane, v);
    for (;;) {
        const int In = I + step; const bool more = In < i1;
        MoeItem nxt = cur; f32x4 w[8];
        if (more) { nxt = moe_item(a, F.ws, In); cvt8_load(nxt.W, nxt.N, nxt.k0, nxt.n0, F.lane, w); }
        cvt8_finish(v, cur.WT, cur.ldt, cur.k0, cur.drow0, cur.gk, cur.wsc, scr, F.lane);
        if (!more) break;
        cur = nxt; I = In;
#pragma unroll
        for (int i = 0; i < 8; ++i) v[i] = w[i];
    }
}
constexpr int MOE_EARLY = 42000;
__device__ __forceinline__ void phase_prologue(const Frame& F, const CAS Args& a) {
    unsigned char* ws = F.ws;
    { unsigned long long* ss = (unsigned long long*)(ws + OFF_SS); for (size_t i = (size_t)F.bx * NTHREADS + F.tid; i < 8 * (size_t)T; i += (size_t)F.G * NTHREADS) if (i >= (size_t)T) ss[i] = 0ull; }
    for (int l = 0; l < 2; ++l) {
        transpose_matrix(F, a.in[I_WIN] + (size_t)l * D * IN_COLS, D, IN_COLS, (bf16_t*)(ws + OFF_WIN + l * SZ_WIN), D, a.in[I_N1G] + l * D, 0);
        transpose_matrix(F, a.in[I_WOUT] + (size_t)l * D * D, D, D, (bf16_t*)(ws + OFF_WOUT + l * SZ_WOUT), D, a.in[I_AOG] + l * ATT_W, 0, a.in[I_SOG] + l * SS_W);
        transpose_matrix(F, a.in[I_GLUW] + (size_t)l * 512 * 512, 512, 512, (bf16_t*)(ws + OFF_WGLU + l * SZ_WGLU), 512, nullptr, 0);
    }
    if constexpr (FFN_FP8 & 1) { transpose_matrix8(F, a.in[I_F1], D, DFF, ws + OFF_W13, D, a.in[I_N2G], SC_W13, 1); transpose_matrix8(F, a.in[I_F3], D, DFF, ws + OFF_W13, D, a.in[I_N2G], SC_W13, 2); }
    else { transpose_matrix(F, a.in[I_F1], D, DFF, (bf16_t*)(ws + OFF_W13), D, a.in[I_N2G], 1); transpose_matrix(F, a.in[I_F3], D, DFF, (bf16_t*)(ws + OFF_W13), D, a.in[I_N2G], 2); }
    if constexpr (FFN_FP8 & 2) transpose_matrix8(F, a.in[I_F2], DFF, D, ws + OFF_W2, DFF, nullptr, SC_W2, 0);
    else transpose_matrix(F, a.in[I_F2], DFF, D, (bf16_t*)(ws + OFF_W2), DFF, nullptr, 0);
    for (int l = 0; l < 2; ++l) {
        bf16_t* bc = (bf16_t*)(ws + OFF_BCAT + l * SZ_BCAT);
        const float* w2 = a.in[I_W2] + (size_t)l * 64 * 512; const float* a2 = a.in[I_A2] + (size_t)l * 64 * 512; const float* g2 = a.in[I_G2] + (size_t)l * 128 * 512;
        for (int i = F.bx * NTHREADS + F.tid; i < 1536 * 256; i += F.G * NTHREADS) {
            const int n = i >> 8, k = i & 255, blk = n >> 9, nn = n & 511; float v = 0.f;
            if (blk == 0 && k < 64) v = w2[k * 512 + nn];
            else if (blk == 1 && k >= 64 && k < 128) v = a2[(k - 64) * 512 + nn];
            else if (blk == 2 && k >= 128) v = g2[(k - 128) * 512 + nn];
            bc[i] = (bf16_t)f2bf(v);
        }
    }
    { const float* x = a.in[I_X]; bf16_t* xb = (bf16_t*)(ws + OFF_XB); unsigned long long* ss0 = (unsigned long long*)(ws + OFF_SS);
      const int gw = F.bx * NWAVES + F.wave, NGW = F.G * NWAVES;
      for (int m = gw; m < T; m += NGW) {
          const f32x4* xr = (const f32x4*)(x + (size_t)m * D) + F.lane; u32x2* o8 = (u32x2*)(xb + (size_t)m * D) + F.lane; float s = 0.f;
#pragma unroll
          for (int j = 0; j < 8; ++j) { const f32x4 v = __builtin_nontemporal_load(xr + 64 * j); s += (v.x * v.x + v.y * v.y) + (v.z * v.z + v.w * v.w); u32x2 w; w.x = pk2(v.x, v.y); w.y = pk2(v.z, v.w); o8[64 * j] = w; }
          s = wave_sum(s); if (F.lane == 0) ss0[m] = ss_fix(s);
      } }
}

struct EpiInProj {
    static constexpr bool PERM = true, MID = false;
    const unsigned long long* ssq; bf16_t* zatt; bf16_t* zrw; bf16_t* uext;
    __device__ __forceinline__ void operator()(const f32x4 (&acc)[2][2][4][2], const Unit& u, int wr, int wc, int fr, int fq) const {
        const int row0 = u.pm * 256 + wr * 64 + fr, colt = wc * 32 + 8 * fq;
        float rsv[2][4];
#pragma unroll
        for (int ai = 0; ai < 2; ++ai)
#pragma unroll
            for (int m = 0; m < 4; ++m) rsv[ai][m] = ss_rs(ssq[row0 + ai * 128 + m * 16]);
#pragma unroll
        for (int ai = 0; ai < 2; ++ai)
#pragma unroll
            for (int m = 0; m < 4; ++m) {
                const int row = row0 + ai * 128 + m * 16; const float rs = rsv[ai][m];
#pragma unroll
                for (int bj = 0; bj < 2; ++bj) {
                    const f32x4 v0 = acc[ai][bj][m][0] * rs, v1 = acc[ai][bj][m][1] * rs;
                    u32x4 w; w.x = cvt_pk_bf16(v0[0], v0[1]); w.y = cvt_pk_bf16(v0[2], v0[3]); w.z = cvt_pk_bf16(v1[0], v1[1]); w.w = cvt_pk_bf16(v1[2], v1[3]);
                    const int ct = bj * 128 + colt;
                    if (u.pn < 6) *(u32x4*)(zatt + (size_t)row * ZATT_W + u.pn * 256 + ct) = w;
                    else if (u.pn < 13) *(u32x4*)(zrw + (size_t)row * RW_COLS + (u.pn - 6) * 256 + ct) = w;
                    else { const int ch = (u.pn - 13) * 256 + ct, g = ch >> 4, half = (ch >> 3) & 1;
                           *(u32x4*)(uext + ((size_t)(g * 512 + (row >> 6)) * S5K + (row & 63) * 16 + half * 8)) = w; }
                }
            }
    }
};

template <bool OUT8, bool MIX = false, bool H16IN = true, bool COPY = true> struct EpiResid {
    static constexpr bool PERM = true, MID = MIX; static constexpr int T1 = 16, T2 = 24;
    const void* hold; bf16_t* hnew; void* xb; unsigned long long* ssq; float asc; const unsigned long long* ssA; const unsigned long long* ssS;
    __device__ __forceinline__ void mid(f32x4 (&acc)[2][2][4][2], const Unit& u, int wr, int fr, int which) const {
        const int row0 = u.pm * 256 + wr * 64 + fr; float f[2][4];
#pragma unroll
        for (int ai = 0; ai < 2; ++ai)
#pragma unroll
            for (int m = 0; m < 4; ++m) { const int row = row0 + ai * 128 + m * 16; f[ai][m] = which == 0 ? rsqrtf(ss_mean(ssA[row], 1.0f / ATT_W)) : sqrtf(ss_mean(ssS[row], 1.0f / SS_W)); }
#pragma unroll
        for (int ai = 0; ai < 2; ++ai)
#pragma unroll
            for (int bj = 0; bj < 2; ++bj)
#pragma unroll
                for (int m = 0; m < 4; ++m)
#pragma unroll
                    for (int n = 0; n < 2; ++n) acc[ai][bj][m][n] *= f[ai][m];
    }
    __device__ __forceinline__ void operator()(const f32x4 (&acc)[2][2][4][2], const Unit& u, int wr, int wc, int fr, int fq) const {
        const int row0 = u.pm * 256 + wr * 64 + fr, col0 = u.pn * 256 + wc * 32 + 8 * fq;
#pragma unroll
        for (int ai = 0; ai < 2; ++ai) {
            f32x4 hv[4][2][2];
#pragma unroll
            for (int m = 0; m < 4; ++m)
#pragma unroll
                for (int bj = 0; bj < 2; ++bj) { const size_t off = (size_t)(row0 + ai * 128 + m * 16) * D + col0 + bj * 128;
                    if constexpr (H16IN) { const u32x4 hb = *(const u32x4*)((const bf16_t*)hold + off);
                        hv[m][bj][0] = (f32x4){bflo(hb.x), bfhi(hb.x), bflo(hb.y), bfhi(hb.y)}; hv[m][bj][1] = (f32x4){bflo(hb.z), bfhi(hb.z), bflo(hb.w), bfhi(hb.w)}; }
                    else { hv[m][bj][0] = *(const f32x4*)((const float*)hold + off); hv[m][bj][1] = *(const f32x4*)((const float*)hold + off + 4); } }
#pragma unroll
            for (int m = 0; m < 4; ++m) {
                const int row = row0 + ai * 128 + m * 16; float s = 0.f; const float sc = MIX ? asc * rsqrtf(ss_mean(ssS[row], 1.0f / SS_W)) : asc;
#pragma unroll
                for (int bj = 0; bj < 2; ++bj) {
                    const size_t off = (size_t)row * D + col0 + bj * 128;
                    const f32x4 v0 = acc[ai][bj][m][0] * sc + hv[m][bj][0], v1 = acc[ai][bj][m][1] * sc + hv[m][bj][1];
                    { u32x4 w; w.x = cvt_pk_bf16(v0[0], v0[1]); w.y = cvt_pk_bf16(v0[2], v0[3]); w.z = cvt_pk_bf16(v1[0], v1[1]); w.w = cvt_pk_bf16(v1[2], v1[3]);
                      *(u32x4*)(hnew + off) = w; }
                    if constexpr (COPY && OUT8) { u32x2 w; w.x = pk8(clamp8(v0[0] * SC_H), clamp8(v0[1] * SC_H), clamp8(v0[2] * SC_H), clamp8(v0[3] * SC_H)); w.y = pk8(clamp8(v1[0] * SC_H), clamp8(v1[1] * SC_H), clamp8(v1[2] * SC_H), clamp8(v1[3] * SC_H));
                        *(u32x2*)((unsigned char*)xb + off) = w; }
                    else if constexpr (COPY) { u32x4 w; w.x = cvt_pk_bf16(v0[0], v0[1]); w.y = cvt_pk_bf16(v0[2], v0[3]); w.z = cvt_pk_bf16(v1[0], v1[1]); w.w = cvt_pk_bf16(v1[2], v1[3]);
                        *(u32x4*)((bf16_t*)xb + off) = w; }
                    s += (v0[0] * v0[0] + v0[1] * v0[1]) + (v0[2] * v0[2] + v0[3] * v0[3]) + (v1[0] * v1[0] + v1[1] * v1[1]) + (v1[2] * v1[2] + v1[3] * v1[3]);
                }
                s += __shfl_xor(s, 16); s += __shfl_xor(s, 32);
                if (fq == 0) atomicAdd(ssq + row, ss_fix(s));
            }
            asm volatile("" ::: "memory");
        }
    }
};

constexpr int AT_KN = 0, AT_KROW = 72;
constexpr int AT_VT = 256 * AT_KROW * 2, AT_VROW = 264;
constexpr int AT_TB = AT_VT + 64 * AT_VROW * 2;
__device__ __forceinline__ int t5_bucket(int d) {
    if (d < 16) return d;
    int lg = 16 + (int)(logf((float)d / 16.0f) / 2.0794415416798357f * 16.0f);
    return lg < 31 ? lg : 31;
}
__device__ __forceinline__ void phase_attention(const Frame& F, const CAS Args& a, int layer) {
    const bf16_t* zatt = (const bf16_t*)(F.ws + MO(B_ZATT)); bf16_t* mixed = (bf16_t*)(F.ws + MO(B_MIXED));
    unsigned long long* ssA = (unsigned long long*)(F.ws + OFF_SS) + (size_t)(4 + 2 * layer) * T;
    const float* qg = a.in[I_QG] + layer * 64; const float* kg = a.in[I_KG] + layer * 64; const float* sinks = a.in[I_SINK] + layer * 16; const float* relb = a.in[I_RELB];
    LAS bf16_t* Kn = (LAS bf16_t*)(F.lds + AT_KN); LAS bf16_t* Vt = (LAS bf16_t*)(F.lds + AT_VT); LAS float* tb = (LAS float*)(F.lds + AT_TB);
    const int lane = F.lane, qi = lane & 15, q4 = lane >> 4;
    for (int unit = F.bx; unit < 1024; unit += F.G) {
        const int kvh = unit & 3, n = (unit >> 2) & 127, b = unit >> 9;
        __syncthreads();
        {
            const int key = F.tid >> 1, half = F.tid & 1, tk = (n - 1) * 128 + key; const bool valid = tk >= 0;
            const size_t row = (size_t)b * SEQ + (valid ? tk : 0);
            const u32x4* kp = (const u32x4*)(zatt + row * ZATT_W + ATT_W + kvh * 64 + half * 32);
            const u32x4* vp = (const u32x4*)(zatt + row * ZATT_W + ATT_W + KV_W + kvh * 64 + half * 32);
            u32x4 kr[4], vr[4];
#pragma unroll
            for (int i = 0; i < 4; ++i) { kr[i] = kp[i]; vr[i] = vp[i]; }
            float kf[32]; float ss = 0.f;
#pragma unroll
            for (int i = 0; i < 4; ++i) { const unsigned w[4] = {kr[i].x, kr[i].y, kr[i].z, kr[i].w};
#pragma unroll
                for (int j = 0; j < 4; ++j) { const float lo = bflo(w[j]), hi = bfhi(w[j]); kf[i * 8 + 2 * j] = lo; kf[i * 8 + 2 * j + 1] = hi; ss += lo * lo + hi * hi; } }
            ss += __shfl_xor(ss, 1);
            const float rs = valid ? rsqrtf(ss * (1.0f / 64.0f) + NORM_EPS) : 0.f;
#pragma unroll
            for (int i = 0; i < 4; ++i) { u32x4 o;
                o.x = pk2(kf[i * 8 + 0] * rs * kg[half * 32 + i * 8 + 0], kf[i * 8 + 1] * rs * kg[half * 32 + i * 8 + 1]);
                o.y = pk2(kf[i * 8 + 2] * rs * kg[half * 32 + i * 8 + 2], kf[i * 8 + 3] * rs * kg[half * 32 + i * 8 + 3]);
                o.z = pk2(kf[i * 8 + 4] * rs * kg[half * 32 + i * 8 + 4], kf[i * 8 + 5] * rs * kg[half * 32 + i * 8 + 5]);
                o.w = pk2(kf[i * 8 + 6] * rs * kg[half * 32 + i * 8 + 6], kf[i * 8 + 7] * rs * kg[half * 32 + i * 8 + 7]);
                *(LAS u32x4*)(Kn + key * AT_KROW + half * 32 + i * 8) = o; }
#pragma unroll
            for (int i = 0; i < 4; ++i) { const unsigned w[4] = {vr[i].x, vr[i].y, vr[i].z, vr[i].w};
#pragma unroll
                for (int j = 0; j < 4; ++j) { const int d = half * 32 + i * 8 + 2 * j;
                    Vt[d * AT_VROW + key] = valid ? (bf16_t)(w[j] & 0xffffu) : (bf16_t)0; Vt[(d + 1) * AT_VROW + key] = valid ? (bf16_t)(w[j] >> 16) : (bf16_t)0; } }
            const int g = F.tid >> 7, dist = F.tid & 127;
            tb[g * 128 + dist] = relb[t5_bucket(dist) * 16 + kvh * 4 + g];
        }
        __syncthreads();
        for (int grp = F.wave; grp < 32; grp += NWAVES) {
            const int g = grp >> 3, qb = grp & 7, h = kvh * 4 + g, i0 = qb * 16;
            const size_t rowq = (size_t)b * SEQ + n * 128 + i0 + qi;
            bf16x8 qf[2];
            {   const u32x4 q0 = *(const u32x4*)(zatt + rowq * ZATT_W + h * 64 + q4 * 8), q1 = *(const u32x4*)(zatt + rowq * ZATT_W + h * 64 + 32 + q4 * 8);
                const unsigned w[8] = {q0.x, q0.y, q0.z, q0.w, q1.x, q1.y, q1.z, q1.w}; float qv[16]; float ss = 0.f;
#pragma unroll
                for (int j = 0; j < 8; ++j) { qv[2 * j] = bflo(w[j]); qv[2 * j + 1] = bfhi(w[j]); ss += qv[2 * j] * qv[2 * j] + qv[2 * j + 1] * qv[2 * j + 1]; }
                ss += __shfl_xor(ss, 16); ss += __shfl_xor(ss, 32);
                const float rs = rsqrtf(ss * (1.0f / 64.0f) + NORM_EPS) * 0.125f;
#pragma unroll
                for (int ks = 0; ks < 2; ++ks) { u32x4 o;
                    const float* gq = qg + ks * 32 + q4 * 8; const float* qq = qv + ks * 8;
                    o.x = pk2(qq[0] * rs * gq[0], qq[1] * rs * gq[1]); o.y = pk2(qq[2] * rs * gq[2], qq[3] * rs * gq[3]);
                    o.z = pk2(qq[4] * rs * gq[4], qq[5] * rs * gq[5]); o.w = pk2(qq[6] * rs * gq[6], qq[7] * rs * gq[7]);
                    qf[ks] = __builtin_bit_cast(bf16x8, o); }
            }
            f32x4 s[9];
#pragma unroll
            for (int kbi = 0; kbi < 9; ++kbi) {
                f32x4 c = (f32x4){0.f, 0.f, 0.f, 0.f};
#pragma unroll
                for (int ks = 0; ks < 2; ++ks) {
                    const bf16x8 kfr = *(const LAS bf16x8*)(Kn + (16 * (qb + kbi) + qi) * AT_KROW + ks * 32 + q4 * 8);
                    c = __builtin_amdgcn_mfma_f32_16x16x32_bf16(kfr, qf[ks], c, 0, 0, 0);
                }
                s[kbi] = c;
            }
            const float sink = sinks[h]; float mx = sink;
#pragma unroll
            for (int kbi = 0; kbi < 9; ++kbi)
#pragma unroll
                for (int r = 0; r < 4; ++r) {
                    const int j = 16 * (qb + kbi) + 4 * q4 + r, dist = 128 + i0 + qi - j;
                    const bool valid = dist >= 0 && dist < 128 && (n > 0 || j >= 128);
                    const float v = valid ? s[kbi][r] + tb[g * 128 + (dist & 127)] : -INFINITY;
                    s[kbi][r] = v; mx = fmaxf(mx, v);
                }
            mx = fmaxf(mx, __shfl_xor(mx, 16)); mx = fmaxf(mx, __shfl_xor(mx, 32));
            float sum = 0.f;
#pragma unroll
            for (int kbi = 0; kbi < 9; ++kbi)
#pragma unroll
                for (int r = 0; r < 4; ++r) { const float p = __expf(s[kbi][r] - mx); s[kbi][r] = p; sum += p; }
            sum += __shfl_xor(sum, 16); sum += __shfl_xor(sum, 32);
            const float inv = frcp(sum + __expf(sink - mx));
            bf16x8 pf[5];
#pragma unroll
            for (int pp = 0; pp < 5; ++pp) { u32x4 o; o.x = pk2(s[2 * pp][0], s[2 * pp][1]); o.y = pk2(s[2 * pp][2], s[2 * pp][3]);
                if (pp < 4) { o.z = pk2(s[2 * pp + 1][0], s[2 * pp + 1][1]); o.w = pk2(s[2 * pp + 1][2], s[2 * pp + 1][3]); } else { o.z = 0u; o.w = 0u; }
                pf[pp] = __builtin_bit_cast(bf16x8, o); }
            float osq = 0.f;
#pragma unroll
            for (int db = 0; db < 4; ++db) {
                f32x4 o = (f32x4){0.f, 0.f, 0.f, 0.f};
#pragma unroll
                for (int pp = 0; pp < 5; ++pp) {
                    const LAS bf16_t* vrow = Vt + (16 * db + qi) * AT_VROW + 4 * q4;
                    const u32x2 va = *(const LAS u32x2*)(vrow + 16 * (qb + 2 * pp));
                    const u32x2 vb = *(const LAS u32x2*)(vrow + 16 * (qb + (pp < 4 ? 2 * pp + 1 : 2 * pp)));
                    u32x4 vv; vv.x = va.x; vv.y = va.y; vv.z = vb.x; vv.w = vb.y;
                    o = __builtin_amdgcn_mfma_f32_16x16x32_bf16(__builtin_bit_cast(bf16x8, vv), pf[pp], o, 0, 0, 0);
                }
                o = o * inv; osq += (o[0] * o[0] + o[1] * o[1]) + (o[2] * o[2] + o[3] * o[3]);
                u32x2 w; w.x = pk2(o[0], o[1]); w.y = pk2(o[2], o[3]);
                *(u32x2*)(mixed + rowq * D + h * 64 + 16 * db + 4 * q4) = w;
            }
            osq += __shfl_xor(osq, 16); osq += __shfl_xor(osq, 32);
            if (q4 == 0) atomicAdd(ssA + rowq, ss_fix(osq));
        }
    }
}

__device__ __forceinline__ void phase_finalize_mixed(const Frame& F, const CAS Args& a, int layer, int dbg_zero) {
    const bf16_t* attraw = (const bf16_t*)(F.ws + MO(B_ATTRAW)); const bf16_t* ssraw = (const bf16_t*)(F.ws + MO(B_SSRAW)); bf16_t* mixed = (bf16_t*)(F.ws + MO(B_MIXED));
    const float* aog = a.in[I_AOG] + layer * ATT_W; const float* sog = a.in[I_SOG] + layer * SS_W;
    const int gw = F.bx * NWAVES + F.wave, NGW = F.G * NWAVES, lane = F.lane;
    for (int m = gw; m < T; m += NGW) {
        {   const u32x4* p = (const u32x4*)(attraw + (size_t)m * ATT_W) + lane * 2; const u32x4 v0 = p[0], v1 = p[1];
            const unsigned w[8] = {v0.x, v0.y, v0.z, v0.w, v1.x, v1.y, v1.z, v1.w}; float f[16]; float ss = 0.f;
#pragma unroll
            for (int j = 0; j < 8; ++j) { f[2 * j] = bflo(w[j]); f[2 * j + 1] = bfhi(w[j]); ss += f[2 * j] * f[2 * j] + f[2 * j + 1] * f[2 * j + 1]; }
            ss = wave_sum(ss); const float rs = rsqrtf(ss * (1.0f / ATT_W) + NORM_EPS); const float* g = aog + lane * 16;
            u32x4 o0, o1;
            o0.x = pk2(f[0] * rs * g[0], f[1] * rs * g[1]); o0.y = pk2(f[2] * rs * g[2], f[3] * rs * g[3]); o0.z = pk2(f[4] * rs * g[4], f[5] * rs * g[5]); o0.w = pk2(f[6] * rs * g[6], f[7] * rs * g[7]);
            o1.x = pk2(f[8] * rs * g[8], f[9] * rs * g[9]); o1.y = pk2(f[10] * rs * g[10], f[11] * rs * g[11]); o1.z = pk2(f[12] * rs * g[12], f[13] * rs * g[13]); o1.w = pk2(f[14] * rs * g[14], f[15] * rs * g[15]);
            u32x4* q = (u32x4*)(mixed + (size_t)m * D) + lane * 2; q[0] = o0; q[1] = o1; }
        {   const u32x4 v0 = *((const u32x4*)(ssraw + (size_t)m * SS_W) + lane);
            const unsigned w[4] = {v0.x, v0.y, v0.z, v0.w}; float f[8]; float ss = 0.f;
#pragma unroll
            for (int j = 0; j < 4; ++j) { f[2 * j] = bflo(w[j]); f[2 * j + 1] = bfhi(w[j]); ss += f[2 * j] * f[2 * j] + f[2 * j + 1] * f[2 * j + 1]; }
            ss = wave_sum(ss); const float rs = rsqrtf(ss * (1.0f / SS_W) + NORM_EPS); const float* g = sog + lane * 8;
            u32x4 o0; o0.x = pk2(f[0] * rs * g[0], f[1] * rs * g[1]); o0.y = pk2(f[2] * rs * g[2], f[3] * rs * g[3]); o0.z = pk2(f[4] * rs * g[4], f[5] * rs * g[5]); o0.w = pk2(f[6] * rs * g[6], f[7] * rs * g[7]);
            if (dbg_zero & 2) o0 = (u32x4){0u, 0u, 0u, 0u};
            *((u32x4*)(mixed + (size_t)m * D + 1536) + lane) = o0; }
        if (dbg_zero & 1) *((u32x4*)(mixed + (size_t)m * D + 1024) + lane) = (u32x4){0u, 0u, 0u, 0u};
    }
}

constexpr int S5L_PWR = 0, S5L_PWI = 65 * 64 * 4, S5L_BBR = 2 * 65 * 64 * 4, S5L_BBI = S5L_BBR + 4096, S5L_CR = S5L_BBI + 4096, S5L_CI = S5L_CR + 4096, S5L_KT = S5L_CI + 4096;
static_assert(S5L_KT + 64 * 256 * 4 <= RING_BYTES, "S5 build LDS");
__device__ __forceinline__ void phase_s5_build(const Frame& F, const CAS Args& a, int layer, int wg0, int nwg) {
    LAS float* pwr = (LAS float*)(F.lds + S5L_PWR); LAS float* pwi = (LAS float*)(F.lds + S5L_PWI);
    LAS float* bbr = (LAS float*)(F.lds + S5L_BBR); LAS float* bbi = (LAS float*)(F.lds + S5L_BBI);
    LAS float* cr = (LAS float*)(F.lds + S5L_CR); LAS float* ci = (LAS float*)(F.lds + S5L_CI); LAS float* kt = (LAS float*)(F.lds + S5L_KT);
    const int tid = F.tid;
    if (F.bx < wg0 || F.bx >= wg0 + nwg) return;
    for (int wi = F.bx - wg0; wi < 256; wi += nwg) {
        const int g = wi >> 3, part = wi & 7;
        __syncthreads();
        const int lg = layer * 32 + g;
        const float dt = expf(a.in[I_DT][lg]);
        {   const int p = tid & 63; const float lr = a.in[I_LRE][lg * 64 + p], li = a.in[I_LIM][lg * 64 + p];
            for (int tau = tid >> 6; tau <= 64; tau += 8) { const float mag = expf(lr * dt * (float)tau); float sn, cs; sincosf(li * dt * (float)tau, &sn, &cs); pwr[tau * 64 + p] = mag * cs; pwi[tau * 64 + p] = mag * sn; } }
        __syncthreads();
        for (int i = tid; i < 1024; i += NTHREADS) {
            const int p = i >> 4;
            const float lr = a.in[I_LRE][lg * 64 + p], li = a.in[I_LIM][lg * 64 + p], den = lr * lr + li * li;
            const float are = pwr[64 + p] - 1.0f, aim = pwi[64 + p];
            const float fr = (are * lr + aim * li) / den, fi = (aim * lr - are * li) / den;
            const float br = a.in[I_BRE][(size_t)lg * 1024 + i], bi = a.in[I_BIM][(size_t)lg * 1024 + i];
            bbr[i] = fr * br - fi * bi; bbi[i] = fr * bi + fi * br;
            cr[i] = a.in[I_CRE][(size_t)lg * 1024 + i]; ci[i] = a.in[I_CIM][(size_t)lg * 1024 + i];
        }
        __syncthreads();
        {
            const int mp = tid & 15, ml = (tid >> 4) & 1, m = 2 * part + ml, th = tid >> 5;
            float acc[4] = {0.f, 0.f, 0.f, 0.f};
            for (int p = 0; p < 64; ++p) {
                const float c_r = cr[m * 64 + p], c_i = ci[m * 64 + p], b_r = bbr[p * 16 + mp], b_i = bbi[p * 16 + mp];
                const float cbr = c_r * b_r - c_i * b_i, cbi = c_r * b_i + c_i * b_r;
#pragma unroll
                for (int j = 0; j < 4; ++j) { const int tau = 4 * th + j; acc[j] += pwr[tau * 64 + p] * cbr - pwi[tau * 64 + p] * cbi; }
            }
            if (th == 0 && m == mp) acc[0] += a.in[I_SD][layer * 512 + g * 16 + m];
#pragma unroll
            for (int j = 0; j < 4; ++j) kt[(4 * th + j) * 32 + ml * 16 + mp] = acc[j];
        }
        __syncthreads();
        bf16_t* B2 = (bf16_t*)(F.ws + OFF_S5B2) + (size_t)g * 1024 * S5K;
        for (int ch = tid; ch < 128 * 144; ch += NTHREADS) {
            const int nl = ch / 144, kc = ch % 144, t = nl >> 1, ml = nl & 1, m = 2 * part + ml, n = t * 16 + m; float v[8];
            if (kc < 128) { const int s = kc >> 1, m0 = (kc & 1) * 8;
#pragma unroll
                for (int j = 0; j < 8; ++j) v[j] = (s <= t) ? kt[(t - s) * 32 + ml * 16 + m0 + j] : 0.f; }
            else { const int p0 = (kc - 128) * 4;
#pragma unroll
                for (int j = 0; j < 4; ++j) { const int p = p0 + j; const float c_r = cr[m * 64 + p], c_i = ci[m * 64 + p], w_r = pwr[(t + 1) * 64 + p], w_i = pwi[(t + 1) * 64 + p];
                    v[2 * j] = c_r * w_r - c_i * w_i; v[2 * j + 1] = -(c_r * w_i + c_i * w_r); } }
            u32x4 o; o.x = pk2(v[0], v[1]); o.y = pk2(v[2], v[3]); o.z = pk2(v[4], v[5]); o.w = pk2(v[6], v[7]);
            *(u32x4*)(B2 + (size_t)n * S5K + kc * 8) = o;
        }
        bf16_t* E = (bf16_t*)(F.ws + OFF_S5E) + (size_t)g * 256 * 1024;
        for (int ch = part * 32 * 128 + tid; ch < (part + 1) * 32 * 128; ch += NTHREADS) {
            const int n = ch >> 7, kc = ch & 127, s = kc >> 1, m0 = (kc & 1) * 8; float v[8];
            if (n < 128) { const int p = n >> 1, ri = n & 1; const float w_r = pwr[(63 - s) * 64 + p], w_i = pwi[(63 - s) * 64 + p];
#pragma unroll
                for (int j = 0; j < 8; ++j) { const float b_r = bbr[p * 16 + m0 + j], b_i = bbi[p * 16 + m0 + j]; v[j] = ri == 0 ? (w_r * b_r - w_i * b_i) : (w_r * b_i + w_i * b_r); } }
            else {
#pragma unroll
                for (int j = 0; j < 8; ++j) v[j] = 0.f; }
            u32x4 o; o.x = pk2(v[0], v[1]); o.y = pk2(v[2], v[3]); o.z = pk2(v[4], v[5]); o.w = pk2(v[6], v[7]);
            *(u32x4*)(E + (size_t)n * 1024 + kc * 8) = o;
        }
    }
}
struct ProbS5a {
    static constexpr bool FP8 = false;
    const bf16_t* A; const bf16_t* Bt; int K, lda, ldb, G, c;
    __device__ __forceinline__ bool next(int i, Unit& u) const { const int L = i * G + c; if (L >= 64) return false; u.pm = L; u.pn = L >> 1; return true; }
    __device__ __forceinline__ const char* abase(const Unit& u) const { return (const char*)(A + (size_t)u.pm * 256 * lda); }
    __device__ __forceinline__ const char* bbase(const Unit& u) const { return (const char*)(Bt + (size_t)u.pn * 256 * ldb); }
};
struct EpiS5a {
    static constexpr bool PERM = false, MID = false;
    float* xloc;
    __device__ __forceinline__ void operator()(const f32x4 (&acc)[2][2][4][2], const Unit& u, int wr, int wc, int fr, int fq) const {
        const int row0 = u.pm * 256 + wr * 64 + fr, col0 = wc * 32 + 4 * fq;
#pragma unroll
        for (int ai = 0; ai < 2; ++ai)
#pragma unroll
            for (int m = 0; m < 4; ++m) { float* rp = xloc + (size_t)(row0 + ai * 128 + m * 16) * 128 + col0;
#pragma unroll
                for (int n = 0; n < 2; ++n) *(f32x4*)(rp + n * 16) = acc[ai][0][m][n]; }
    }
};
__device__ __forceinline__ void phase_s5_scan(const Frame& F, const CAS Args& a, int layer) {
    const int gt = F.bx * NTHREADS + F.tid; if (gt >= 4096) return;
    const int p = gt & 63, b = (gt >> 6) & 1, g = gt >> 7, lg = layer * 32 + g;
    const float dt = expf(a.in[I_DT][lg]), lr = a.in[I_LRE][lg * 64 + p], li = a.in[I_LIM][lg * 64 + p];
    const float mag = expf(lr * dt * 64.0f); float sn, cs; sincosf(li * dt * 64.0f, &sn, &cs); const float ar = mag * cs, ai = mag * sn;
    const float* xl = (const float*)(F.ws + MO(B_XLOC)) + (size_t)(g * 512 + b * 256) * 128 + 2 * p;
    unsigned* ux = (unsigned*)((bf16_t*)(F.ws + MO(B_UEXT)) + (size_t)(g * 512 + b * 256) * S5K + 1024 + 2 * p);
    float xr = 0.f, xi = 0.f;
    for (int cb = 0; cb < 256; cb += 32) {
        f32x2 l[32];
#pragma unroll
        for (int j = 0; j < 32; ++j) l[j] = *(const f32x2*)(xl + (size_t)(cb + j) * 128);
#pragma unroll
        for (int j = 0; j < 32; ++j) {
            ux[(size_t)(cb + j) * (S5K / 2)] = pk2(xr, xi);
            const float nr = ar * xr - ai * xi + l[j].x, ni = ar * xi + ai * xr + l[j].y; xr = nr; xi = ni;
        }
    }
}
struct ProbS5b {
    static constexpr bool FP8 = false;
    const bf16_t* A; const bf16_t* Bt; int K, lda, ldb, G, c;
    __device__ __forceinline__ bool next(int i, Unit& u) const { const int L = i * G + c; if (L < 0 || L >= 256) return false; u.pm = L >> 2; u.pn = (L >> 3) * 4 + (L & 3); return true; }
    __device__ __forceinline__ const char* abase(const Unit& u) const { return (const char*)(A + (size_t)u.pm * 256 * lda); }
    __device__ __forceinline__ const char* bbase(const Unit& u) const { return (const char*)(Bt + (size_t)u.pn * 256 * ldb); }
};
__device__ __forceinline__ float gelu_tanh(float x) { return x * frcp(1.0f + __builtin_amdgcn_exp2f(-2.3022082594043835f * (x + 0.044715f * x * x * x))); }
struct EpiS5b {
    static constexpr bool PERM = true, MID = false;
    bf16_t* zg;
    __device__ __forceinline__ void operator()(const f32x4 (&acc)[2][2][4][2], const Unit& u, int wr, int wc, int fr, int fq) const {
        const int row0 = u.pm * 256 + wr * 64 + fr, colt = (u.pn & 3) * 256 + wc * 32 + 8 * fq;
#pragma unroll
        for (int ai = 0; ai < 2; ++ai)
#pragma unroll
            for (int m = 0; m < 4; ++m) {
                const int rg = row0 + ai * 128 + m * 16, g = rg >> 9, bc = rg & 511;
#pragma unroll
                for (int bj = 0; bj < 2; ++bj) {
                    const int n = colt + bj * 128, t = n >> 4, m0 = n & 15; const size_t tok = (size_t)(bc >> 8) * SEQ + (bc & 255) * 64 + t;
                    const f32x4 v0 = acc[ai][bj][m][0], v1 = acc[ai][bj][m][1];
                    u32x4 w; w.x = pk2(gelu_tanh(v0[0]), gelu_tanh(v0[1])); w.y = pk2(gelu_tanh(v0[2]), gelu_tanh(v0[3])); w.z = pk2(gelu_tanh(v1[0]), gelu_tanh(v1[1])); w.w = pk2(gelu_tanh(v1[2]), gelu_tanh(v1[3]));
                    *(u32x4*)(zg + tok * 512 + g * 16 + m0) = w;
                }
            }
    }
};
struct EpiGlu {
    static constexpr bool PERM = true, MID = false;
    const bf16_t* zg; const float* glub; bf16_t* mixed; unsigned long long* ssS;
    __device__ __forceinline__ void operator()(const f32x4 (&acc)[2][2][4][2], const Unit& u, int wr, int wc, int fr, int fq) const {
        const int row0 = u.pm * 256 + wr * 64 + fr, col0 = u.pn * 256 + wc * 32 + 8 * fq;
#pragma unroll
        for (int ai = 0; ai < 2; ++ai)
#pragma unroll
            for (int m = 0; m < 4; ++m) {
                const size_t row = (size_t)(row0 + ai * 128 + m * 16); float sq = 0.f;
#pragma unroll
                for (int bj = 0; bj < 2; ++bj) {
                    const int n = col0 + bj * 128; const u32x4 z = *(const u32x4*)(zg + row * 512 + n);
                    const f32x4 b0 = *(const f32x4*)(glub + n), b1 = *(const f32x4*)(glub + n + 4);
                    const f32x4 v0 = acc[ai][bj][m][0] + b0, v1 = acc[ai][bj][m][1] + b1;
                    const float e0 = bflo(z.x) * sigmoidf_(v0[0]), e1 = bfhi(z.x) * sigmoidf_(v0[1]), e2 = bflo(z.y) * sigmoidf_(v0[2]), e3 = bfhi(z.y) * sigmoidf_(v0[3]);
                    const float e4 = bflo(z.z) * sigmoidf_(v1[0]), e5 = bfhi(z.z) * sigmoidf_(v1[1]), e6 = bflo(z.w) * sigmoidf_(v1[2]), e7 = bfhi(z.w) * sigmoidf_(v1[3]);
                    sq += (e0 * e0 + e1 * e1) + (e2 * e2 + e3 * e3) + (e4 * e4 + e5 * e5) + (e6 * e6 + e7 * e7);
                    u32x4 w; w.x = pk2(e0, e1); w.y = pk2(e2, e3); w.z = pk2(e4, e5); w.w = pk2(e6, e7);
                    *(u32x4*)(mixed + row * D + 1536 + n) = w;
                }
                sq += __shfl_xor(sq, 16); sq += __shfl_xor(sq, 32);
                if (fq == 0) atomicAdd(ssS + row, ss_fix(sq));
            }
    }
};

__device__ __forceinline__ void phase_rw_prep1(const Frame& F, const CAS Args& a, int layer) {
    const bf16_t* zrw = (const bf16_t*)(F.ws + MO(B_ZRW)); bf16_t* al = (bf16_t*)(F.ws + MO(B_ALORA)); const float* mu = a.in[I_MU] + layer * RW_COLS;
    const int lane = F.lane, gw = F.bx * NWAVES + F.wave, NGW = F.G * NWAVES;
    const int sc = lane < 16 ? 512 + 4 * lane : (lane < 32 ? 1600 + 4 * (lane - 16) : 1664 + 4 * (lane - 32));
    const f32x4 m4 = *(const f32x4*)(mu + sc);
    for (int row0 = gw; row0 < T; row0 += 4 * NGW) {
        u32x2 zc[4], zp[4];
#pragma unroll
        for (int u = 0; u < 4; ++u) { const int row = min(row0 + u * NGW, T - 1);
            zc[u] = *(const u32x2*)(zrw + (size_t)row * RW_COLS + sc);
            zp[u] = (u32x2){0u, 0u}; if ((row & (SEQ - 1)) != 0) zp[u] = *(const u32x2*)(zrw + (size_t)(row - 1) * RW_COLS + sc); }
#pragma unroll
        for (int u = 0; u < 4; ++u) { const int row = row0 + u * NGW; if (row >= T) break;
            float z[4] = {bflo(zc[u].x), bfhi(zc[u].x), bflo(zc[u].y), bfhi(zc[u].y)}; const float p[4] = {bflo(zp[u].x), bfhi(zp[u].x), bflo(zp[u].y), bfhi(zp[u].y)};
#pragma unroll
            for (int j = 0; j < 4; ++j) { float v = z[j] + m4[j] * (p[j] - z[j]); v = lane < 16 ? tanhf(v) : (lane < 32 ? v : sigmoidf_(v)); z[j] = v; }
            u32x2 o; o.x = pk2(z[0], z[1]); o.y = pk2(z[2], z[3]);
            *(u32x2*)(al + (size_t)row * 256 + 4 * lane) = o; }
    }
}
struct ProbLora {
    static constexpr bool FP8 = false;
    const bf16_t* A; const bf16_t* Bt; int K, lda, ldb, nM, nN, G, c;
    __device__ __forceinline__ bool next(int i, Unit& u) const { return pg8::static_unit(i * G + c, nM, nN, u); }
    __device__ __forceinline__ const char* abase(const Unit& u) const { return (const char*)(A + (size_t)u.pm * 256 * lda + (u.pn >= 4 ? 128 : 0)); }
    __device__ __forceinline__ const char* bbase(const Unit& u) const { return (const char*)(Bt + (size_t)u.pn * 256 * ldb + (u.pn >= 4 ? 128 : 0)); }
};
struct EpiLora {
    static constexpr bool PERM = true, MID = false;
    bf16_t* dec; bf16_t* iclr; bf16_t* gate;
    __device__ __forceinline__ void operator()(const f32x4 (&acc)[2][2][4][2], const Unit& u, int wr, int wc, int fr, int fq) const {
        const int row0 = u.pm * 256 + wr * 64 + fr, blk = u.pn >> 1, nn0 = (u.pn & 1) * 256 + wc * 32 + 8 * fq;
        if (blk == 0) store(acc, dec, row0, nn0); else if (blk == 1) store(acc, iclr, row0, nn0); else store(acc, gate, row0, nn0);
    }
    static __device__ __forceinline__ void store(const f32x4 (&acc)[2][2][4][2], bf16_t* dst, int row0, int nn0) {
#pragma unroll
        for (int ai = 0; ai < 2; ++ai)
#pragma unroll
            for (int m = 0; m < 4; ++m) {
                const size_t row = (size_t)(row0 + ai * 128 + m * 16);
#pragma unroll
                for (int bj = 0; bj < 2; ++bj) {
                    const int nn = nn0 + bj * 128; const f32x4 v0 = acc[ai][bj][m][0], v1 = acc[ai][bj][m][1];
                    u32x4 w; w.x = cvt_pk_bf16(v0[0], v0[1]); w.y = cvt_pk_bf16(v0[2], v0[3]); w.z = cvt_pk_bf16(v1[0], v1[1]); w.w = cvt_pk_bf16(v1[2], v1[3]);
                    *(u32x4*)(dst + row * 512 + nn) = w;
                }
            }
    }
};
constexpr int P1_RAW = 1280, P1_RAWRING = 8 * P1_RAW, P1_REC = 1536, P1_WAVE = P1_RAWRING + 2 * P1_REC, P1_LA = 5;
static_assert(NWAVES * P1_WAVE <= RING_BYTES, "pass-1 LDS");
__device__ __forceinline__ void glds4_s(const char* sbase, unsigned voff, unsigned ldsdst) {
    asm volatile("s_mov_b32 m0, %2\n\ts_nop 0\n\tglobal_load_lds_dword %0, %1" : : "v"(voff), "s"(sbase), "s"(ldsdst) : "memory", "m0");
}
__device__ __forceinline__ void phase_rw_pass1(const Frame& F, const CAS Args& a, int layer) {
    const bf16_t* zrw = (const bf16_t*)(F.ws + MO(B_ZRW)); const bf16_t* dec = (const bf16_t*)(F.ws + MO(B_DEC)); const bf16_t* icl = (const bf16_t*)(F.ws + MO(B_ICLR));
    float* yloc = (float*)(F.ws + MO(B_YLOC)); float* pvec = (float*)(F.ws + MO(B_PVEC)); float* bonus = (float*)(F.ws + MO(B_BONUS));
    float* pmat = (float*)(F.ws + MO(B_PMAT)); float* qmat = (float*)(F.ws + MO(B_QMAT));
    const int lane = F.lane, gw = F.bx * NWAVES + F.wave, NGW = F.G * NWAVES;
    const LAS unsigned char* wl = F.lds + F.wave * P1_WAVE; const unsigned rawbase = (unsigned)(unsigned long)wl, lane4 = (unsigned)lane * 4u;
    LAS float* recs = (LAS float*)(wl + P1_RAWRING);
#define P1_ISSUE(u) do { const size_t _row = row0 + (u); const unsigned _d = rawbase + (unsigned)(((u) & 7) * P1_RAW); \
        const char* _z = uniform_ptr((const char*)(zrw + _row * RW_COLS + h * 64)); \
        glds4_s(_z, lane4, _d); glds4_s(_z + 576 * 2, lane4, _d + 256u); glds4_s(_z + 1088 * 2, lane4, _d + 512u); \
        glds4_s(uniform_ptr((const char*)(dec + _row * 512 + h * 64)), lane4, _d + 768u); glds4_s(uniform_ptr((const char*)(icl + _row * 512 + h * 64)), lane4, _d + 1024u); } while (0)
    for (int item = gw; item < 2048; item += NGW) {
        const int bh = item >> 7, ch = item & 127, b = bh >> 3, h = bh & 7, c = h * 64 + lane;
        const size_t row0 = (size_t)b * SEQ + ch * RWC; const bool first = ch == 0;
        asm volatile("s_waitcnt vmcnt(0)" ::: "memory");
        if (!first) P1_ISSUE(-1);
#pragma unroll
        for (int u = 0; u <= P1_LA; ++u) P1_ISSUE(u);
        const float* mu = a.in[I_MU] + layer * RW_COLS;
        const float mur = mu[c], muk = mu[576 + c], muv = mu[1088 + c];
        const float cst0 = a.in[I_W0][layer * 512 + c], cst1 = a.in[I_A0][layer * 512 + c], cst2 = a.in[I_KK][layer * 512 + c], cst3 = a.in[I_KA][layer * 512 + c], cst4 = a.in[I_RK][layer * 512 + c];
#define P1_CST(i) cst##i
        f32x2 sq[32], sp[32];
        int li = lane; asm volatile("" : "+v"(li));
#pragma unroll
        for (int j = 0; j < 32; ++j) { sq[j] = (f32x2){0.f, 0.f}; sp[j] = (f32x2){li == 2 * j ? 1.f : 0.f, li == 2 * j + 1 ? 1.f : 0.f}; }
        float pzr = 0.f, pzk = 0.f, pzv = 0.f;
#define P1_BUILD(u, aout) do { const LAS unsigned char* _rs = wl + ((u) & 7) * P1_RAW; \
        const float _zr = bf2f(*(const LAS bf16_t*)(_rs + 2 * lane)), _zk = bf2f(*(const LAS bf16_t*)(_rs + 256 + 2 * lane)), _zv = bf2f(*(const LAS bf16_t*)(_rs + 512 + 2 * lane)); \
        const float _w = __expf(-0.6065306597126334f * sigmoidf_(P1_CST(0) + bf2f(*(const LAS bf16_t*)(_rs + 768 + 2 * lane)))), _ic = sigmoidf_(P1_CST(1) + bf2f(*(const LAS bf16_t*)(_rs + 1024 + 2 * lane))); \
        const float _r = _zr + mur * (pzr - _zr), _k = _zk + muk * (pzk - _zk), _v = _zv + muv * (pzv - _zv); pzr = _zr; pzk = _zk; pzv = _zv; \
        float _kk = _k * P1_CST(2); const float _n2 = wave_sum(_kk * _kk); _kk *= rsqrtf(fmaxf(_n2, 1e-12f)); \
        const float _k2 = _k * (1.0f + (_ic - 1.0f) * P1_CST(3)); const float _bs = wave_sum(_r * _k2 * P1_CST(4)); \
        LAS float* _rc = recs + ((u) & 1) * 384 + (lane >> 4) * 80 + (lane & 15); \
        _rc[0] = _w; _rc[16] = _kk * _ic; _rc[32] = _k2; _rc[48] = _r; recs[((u) & 1) * 384 + 320 + lane] = _v; \
        recs[(((u) + 1) & 1) * 384 + (lane >> 4) * 80 + 64 + (lane & 15)] = -_kk; \
        if (lane == 0) bonus[(row0 + (u)) * 8 + h] = _bs; \
        aout = -_kk; } while (0)
        float a0;
        if (!first) { asm volatile("s_waitcnt vmcnt(30)" ::: "memory");
            const LAS unsigned char* rs = wl + 7 * P1_RAW; pzr = bf2f(*(const LAS bf16_t*)(rs + 2 * lane)); pzk = bf2f(*(const LAS bf16_t*)(rs + 256 + 2 * lane)); pzv = bf2f(*(const LAS bf16_t*)(rs + 512 + 2 * lane)); }
        asm volatile("s_waitcnt vmcnt(25)" ::: "memory");
        P1_BUILD(0, a0);
        float saq = 0.f, sap = a0;
        for (int t = 0; t < RWC; ++t) {
            const size_t row = row0 + t;
            if (t + 1 + P1_LA < RWC) { P1_ISSUE(t + 1 + P1_LA); if (t >= P1_LA) asm volatile("s_waitcnt vmcnt(40)" ::: "memory"); else asm volatile("s_waitcnt vmcnt(25)" ::: "memory"); }
            else asm volatile("s_waitcnt vmcnt(15)" ::: "memory");
            if (t + 1 < RWC) { float an; P1_BUILD(t + 1, an); (void)an; }
            asm volatile("s_waitcnt lgkmcnt(0)" ::: "memory");
            const LAS f32x4* rec = (const LAS f32x4*)(recs + (t & 1) * 384);
            const float vi = ((const LAS float*)rec)[320 + lane];
            const f32x2 saq2 = (f32x2){saq, saq}, sap2 = (f32x2){sap, sap}, vi2 = (f32x2){vi, vi};
            f32x2 yq0 = (f32x2){0.f, 0.f}, yq1 = yq0, yp0 = yq0, yp1 = yq0, dq0 = yq0, dq1 = yq0, dp0 = yq0, dp1 = yq0;
            f32x4 cw, cb, ck, cr, cn, nw, nb, nk, nr, nn;
            cw = rec[0]; cb = rec[4]; ck = rec[8]; cr = rec[12]; cn = rec[16];
#pragma unroll
            for (int bt = 0; bt < 16; ++bt) {
                if (bt < 15) { const int i = ((bt + 1) >> 2) * 20 + ((bt + 1) & 3); nw = rec[i]; nb = rec[i + 4]; nk = rec[i + 8]; nr = rec[i + 12]; nn = rec[i + 16]; }
                __builtin_amdgcn_sched_barrier(0);
                {   const int j = bt * 2;
                    const f32x2 w0 = (f32x2){cw.x, cw.y}, w1 = (f32x2){cw.z, cw.w}, b0 = (f32x2){cb.x, cb.y}, b1 = (f32x2){cb.z, cb.w}, k0 = (f32x2){ck.x, ck.y}, k1 = (f32x2){ck.z, ck.w};
                    const f32x2 r0 = (f32x2){cr.x, cr.y}, r1 = (f32x2){cr.z, cr.w}, n0 = (f32x2){cn.x, cn.y}, n1 = (f32x2){cn.z, cn.w};
                    sq[j] = sq[j] * w0 + saq2 * b0 + vi2 * k0; sp[j] = sp[j] * w0 + sap2 * b0;
                    sq[j + 1] = sq[j + 1] * w1 + saq2 * b1 + vi2 * k1; sp[j + 1] = sp[j + 1] * w1 + sap2 * b1;
                    yq0 += sq[j] * r0; yp0 += sp[j] * r0; yq1 += sq[j + 1] * r1; yp1 += sp[j + 1] * r1;
                    dq0 += sq[j] * n0; dp0 += sp[j] * n0; dq1 += sq[j + 1] * n1; dp1 += sp[j + 1] * n1; }
                __builtin_amdgcn_sched_barrier(0);
                cw = nw; cb = nb; ck = nk; cr = nr; cn = nn;
            }
            ((bf16_t*)yloc)[row * 512 + h * 64 + lane] = (bf16_t)f2bf((yq0.x + yq0.y) + (yq1.x + yq1.y));
            ((bf16_t*)pvec)[row * 512 + h * 64 + lane] = (bf16_t)f2bf((yp0.x + yp0.y) + (yp1.x + yp1.y));
            saq = (dq0.x + dq0.y) + (dq1.x + dq1.y); sap = (dp0.x + dp0.y) + (dp1.x + dp1.y);
        }
        int l2 = lane; asm volatile("" : "+v"(l2));
        float* po = pmat + (size_t)item * 4096 + (l2 >> 4) * 256 + (l2 & 3) * 64 + ((l2 >> 2) & 3);
        float* qo = qmat + (size_t)item * 4096 + (l2 >> 4) * 1024 + ((l2 >> 2) & 3) * 64 + (l2 & 3);
#pragma unroll
        for (int j = 0; j < 32; ++j) {
            const int c0 = 2 * j, c1 = 2 * j + 1;
            po[(c0 >> 4) * 1024 + (c0 & 15) * 4] = sp[j].x; po[(c1 >> 4) * 1024 + (c1 & 15) * 4] = sp[j].y;
            qo[(c0 >> 4) * 256 + (c0 & 15) * 4] = sq[j].x; qo[(c1 >> 4) * 256 + (c1 & 15) * 4] = sq[j].y;
        }
    }
#undef P1_ISSUE
#undef P1_BUILD
#undef P1_CST
}
__device__ __forceinline__ void phase_rw_scan(const Frame& F, int layer) {
    const float* pmat = (const float*)(F.ws + MO(B_PMAT)); const float* qmat = (const float*)(F.ws + MO(B_QMAT)); float* sst = (float*)(F.ws + MO(B_SST));
    LAS float* Sb = (LAS float*)F.lds;
    const int lane = F.lane, jt = F.wave, n = lane & 15, kq = lane >> 4;
    for (int w = F.bx; w < 64; w += F.G) {
        const int bh = w >> 2, qr = w & 3; const size_t it0 = (size_t)bh * RWNC;
        __syncthreads();
        if (jt < 4) {
            f32x4 s = (f32x4){0.f, 0.f, 0.f, 0.f};
            float pA[16], pB[16], pC[16]; f32x4 qA, qB, qC;
#define SC_LOAD(pb, qc, c) do { const int _c = (c) < RWNC ? (c) : RWNC - 1; const float* pp = pmat + (it0 + _c) * 4096 + jt * 1024 + lane * 4; \
                        _Pragma("unroll") for (int g = 0; g < 4; ++g) { const f32x4 _v = *(const f32x4*)(pp + g * 256); pb[4 * g] = _v.x; pb[4 * g + 1] = _v.y; pb[4 * g + 2] = _v.z; pb[4 * g + 3] = _v.w; } \
                        qc = *(const f32x4*)(qmat + (it0 + _c) * 4096 + qr * 1024 + jt * 256 + lane * 4); } while (0)
#define SC_STEP(pb, qc, c) do { \
                _Pragma("unroll") for (int r = 0; r < 4; ++r) Sb[(4 * kq + r) * 68 + 16 * jt + n] = s[r]; \
                asm volatile("s_waitcnt lgkmcnt(0)" ::: "memory"); __builtin_amdgcn_s_barrier(); asm volatile("" ::: "memory"); \
                *(f32x4*)(sst + (it0 + (c)) * 4096 + (size_t)(qr * 16 + 4 * jt + kq) * 64 + 4 * n) = *(const LAS f32x4*)(Sb + (4 * jt + kq) * 68 + 4 * n);        \
                f32x4 a0 = qc, a1 = (f32x4){0.f, 0.f, 0.f, 0.f}, a2 = a1, a3 = a1; \
                _Pragma("unroll") for (int kk = 0; kk < 16; kk += 4) { \
                    a0 = __builtin_amdgcn_mfma_f32_16x16x4f32(Sb[n * 68 + 4 * kk + kq], pb[kk], a0, 0, 0, 0); \
                    a1 = __builtin_amdgcn_mfma_f32_16x16x4f32(Sb[n * 68 + 4 * (kk + 1) + kq], pb[kk + 1], a1, 0, 0, 0); \
                    a2 = __builtin_amdgcn_mfma_f32_16x16x4f32(Sb[n * 68 + 4 * (kk + 2) + kq], pb[kk + 2], a2, 0, 0, 0); \
                    a3 = __builtin_amdgcn_mfma_f32_16x16x4f32(Sb[n * 68 + 4 * (kk + 3) + kq], pb[kk + 3], a3, 0, 0, 0); } \
                s = (a0 + a1) + (a2 + a3); \
                SC_LOAD(pb, qc, (c) + 3); \
                asm volatile("s_waitcnt lgkmcnt(0)" ::: "memory"); __builtin_amdgcn_s_barrier(); asm volatile("" ::: "memory"); } while (0)
            SC_LOAD(pA, qA, 0); SC_LOAD(pB, qB, 1); SC_LOAD(pC, qC, 2);
            static_assert(RWNC % 3 == 2, "scan loop tail");
            for (int c = 0; c + 2 < RWNC; c += 3) { SC_STEP(pA, qA, c); SC_STEP(pB, qB, c + 1); SC_STEP(pC, qC, c + 2); }
            SC_STEP(pA, qA, RWNC - 2); SC_STEP(pB, qB, RWNC - 1);
#undef SC_LOAD
#undef SC_STEP
        } else {
            for (int c = 0; c < RWNC; ++c) { __builtin_amdgcn_s_barrier(); __builtin_amdgcn_s_barrier(); }
        }
    }
}
__device__ __forceinline__ bf16x8 cvt8(f32x4 lo, f32x4 hi) { u32x4 o; o.x = cvt_pk_bf16(lo[0], lo[1]); o.y = cvt_pk_bf16(lo[2], lo[3]); o.z = cvt_pk_bf16(hi[0], hi[1]); o.w = cvt_pk_bf16(hi[2], hi[3]); return __builtin_bit_cast(bf16x8, o); }
__device__ __forceinline__ void phase_rw_fix(const Frame& F, const CAS Args& a, int layer) {
    const bf16_t* zrw = (const bf16_t*)(F.ws + MO(B_ZRW)); const float* muv = a.in[I_MU] + layer * RW_COLS + 1088; const float* yloc = (const float*)(F.ws + MO(B_YLOC)); const float* pvec = (const float*)(F.ws + MO(B_PVEC));
    const float* sst = (const float*)(F.ws + MO(B_SST)); const float* bonus = (const float*)(F.ws + MO(B_BONUS)); const bf16_t* gate = (const bf16_t*)(F.ws + MO(B_GATE));
    bf16_t* mixed = (bf16_t*)(F.ws + MO(B_MIXED));
    const float* lnw = a.in[I_LNW] + layer * 512; const float* lnb = a.in[I_LNB] + layer * 512;
    const int lane = F.lane, gw = F.bx * NWAVES + F.wave, NGW = F.G * NWAVES, tl = lane & 15, q4 = lane >> 4;
    for (int item = gw; item < 2048; item += NGW) {
        const int bh = item >> 7, ch = item & 127, b = bh >> 3, h = bh & 7;
        bf16x8 sa[4][2];
#pragma unroll
        for (int ib = 0; ib < 4; ++ib)
#pragma unroll
            for (int ks = 0; ks < 2; ++ks) { const float* p = sst + (size_t)item * 4096 + (16 * ib + tl) * 64 + 32 * ks + 8 * q4; sa[ib][ks] = cvt8(*(const f32x4*)p, *(const f32x4*)(p + 4)); }
        f32x4 lw[4], lb[4];
#pragma unroll
        for (int ib = 0; ib < 4; ++ib) { lw[ib] = *(const f32x4*)(lnw + h * 64 + 16 * ib + 4 * q4); lb[ib] = *(const f32x4*)(lnb + h * 64 + 16 * ib + 4 * q4); }
        for (int tb = 0; tb < RWC / 16; ++tb) {
            const size_t row = (size_t)b * SEQ + ch * RWC + tb * 16 + tl;
            bf16x8 pb[2];
#pragma unroll
            for (int ks = 0; ks < 2; ++ks) pb[ks] = *(const bf16x8*)((const bf16_t*)pvec + row * 512 + h * 64 + 32 * ks + 8 * q4);
            f32x4 y[4]; float s = 0.f;
#pragma unroll
            for (int ib = 0; ib < 4; ++ib) {
                const u32x2 yb = *(const u32x2*)((const bf16_t*)yloc + row * 512 + h * 64 + 16 * ib + 4 * q4); f32x4 d = (f32x4){bflo(yb.x), bfhi(yb.x), bflo(yb.y), bfhi(yb.y)};
                d = __builtin_amdgcn_mfma_f32_16x16x32_bf16(sa[ib][0], pb[0], d, 0, 0, 0);
                d = __builtin_amdgcn_mfma_f32_16x16x32_bf16(sa[ib][1], pb[1], d, 0, 0, 0);
                y[ib] = d; s += (d[0] + d[1]) + (d[2] + d[3]);
            }
            s += __shfl_xor(s, 16); s += __shfl_xor(s, 32);
            const float mean = s * (1.0f / 64.0f); float q = 0.f;
#pragma unroll
            for (int ib = 0; ib < 4; ++ib) { y[ib] = y[ib] - mean; q += (y[ib][0] * y[ib][0] + y[ib][1] * y[ib][1]) + (y[ib][2] * y[ib][2] + y[ib][3] * y[ib][3]); }
            q += __shfl_xor(q, 16); q += __shfl_xor(q, 32);
            const float rstd = rsqrtf(q * (1.0f / 64.0f) + 64e-5f), bon = bonus[row * 8 + h];
#pragma unroll
            for (int ib = 0; ib < 4; ++ib) {
                const int c = h * 64 + 16 * ib + 4 * q4;
                const u32x2 zc = *(const u32x2*)(zrw + row * RW_COLS + 1088 + c); u32x2 zp = (u32x2){0u, 0u}; if ((row & (SEQ - 1)) != 0) zp = *(const u32x2*)(zrw + (row - 1) * RW_COLS + 1088 + c);
                const f32x4 mv = *(const f32x4*)(muv + c), zcf = (f32x4){bflo(zc.x), bfhi(zc.x), bflo(zc.y), bfhi(zc.y)}, zpf = (f32x4){bflo(zp.x), bfhi(zp.x), bflo(zp.y), bfhi(zp.y)};
                const f32x4 vv = zcf + mv * (zpf - zcf); const u32x2 gg = *(const u32x2*)(gate + row * 512 + c);
                const f32x4 o = (y[ib] * rstd * lw[ib] + lb[ib] + vv * bon) * (f32x4){bflo(gg.x), bfhi(gg.x), bflo(gg.y), bfhi(gg.y)};
                u32x2 w; w.x = cvt_pk_bf16(o[0], o[1]); w.y = cvt_pk_bf16(o[2], o[3]);
                *(u32x2*)(mixed + row * D + 1024 + c) = w;
            }
        }
    }
}

template <bool F8, bool O8 = F8> struct EpiSwiglu {
    static constexpr bool PERM = true, MID = false;
    const unsigned long long* ssq; const float* rsslot; void* act; int ldact;
    __device__ __forceinline__ void operator()(const f32x4 (&acc)[2][2][4][2], const Unit& u, int wr, int wc, int fr, int fq) const {
        const int row0 = u.pm * 256 + wr * 64 + fr, col0 = u.pn * 128 + wc * 32 + 8 * fq;
        float rsv[2][4];
#pragma unroll
        for (int ai = 0; ai < 2; ++ai)
#pragma unroll
            for (int m = 0; m < 4; ++m) { const int row = row0 + ai * 128 + m * 16; rsv[ai][m] = (rsslot ? rsslot[row] : ss_rs(ssq[row])) * (F8 ? 1.0f / (SC_H * SC_W13) : 1.0f); }
#pragma unroll
        for (int ai = 0; ai < 2; ++ai)
#pragma unroll
            for (int m = 0; m < 4; ++m) {
                const int row = row0 + ai * 128 + m * 16; const float rs = rsv[ai][m];
                float o[8];
#pragma unroll
                for (int n = 0; n < 2; ++n)
#pragma unroll
                    for (int j = 0; j < 4; ++j) { const float g = acc[ai][0][m][n][j] * rs, up = acc[ai][1][m][n][j] * rs; o[n * 4 + j] = g * sigmoidf_(g) * up; }
                if constexpr (O8) { u32x2 w; w.x = pk8(clamp8(o[0] * SC_ACT), clamp8(o[1] * SC_ACT), clamp8(o[2] * SC_ACT), clamp8(o[3] * SC_ACT)); w.y = pk8(clamp8(o[4] * SC_ACT), clamp8(o[5] * SC_ACT), clamp8(o[6] * SC_ACT), clamp8(o[7] * SC_ACT));
                    *(u32x2*)((unsigned char*)act + (size_t)row * ldact + col0) = w; }
                else { u32x4 w; w.x = cvt_pk_bf16(o[0], o[1]); w.y = cvt_pk_bf16(o[2], o[3]); w.z = cvt_pk_bf16(o[4], o[5]); w.w = cvt_pk_bf16(o[6], o[7]);
                    *(u32x4*)((bf16_t*)act + (size_t)row * ldact + col0) = w; }
            }
    }
};
struct EpiBf16Out {
    static constexpr bool PERM = true, MID = false;
    bf16_t* o; int ld; float asc;
    __device__ __forceinline__ void operator()(const f32x4 (&acc)[2][2][4][2], const Unit& u, int wr, int wc, int fr, int fq) const {
        const int row0 = u.pm * 256 + wr * 64 + fr, col0 = u.pn * 256 + wc * 32 + 8 * fq;
#pragma unroll
        for (int ai = 0; ai < 2; ++ai)
#pragma unroll
            for (int m = 0; m < 4; ++m)
#pragma unroll
                for (int bj = 0; bj < 2; ++bj) { const f32x4 v0 = acc[ai][bj][m][0] * asc, v1 = acc[ai][bj][m][1] * asc;
                    u32x4 w; w.x = cvt_pk_bf16(v0[0], v0[1]); w.y = cvt_pk_bf16(v0[2], v0[3]); w.z = cvt_pk_bf16(v1[0], v1[1]); w.w = cvt_pk_bf16(v1[2], v1[3]);
                    *(u32x4*)(o + (size_t)(row0 + ai * 128 + m * 16) * ld + col0 + bj * 128) = w; }
    }
};
struct EpiProbe {
    static constexpr bool PERM = true, MID = false;
    float* dummy;
    __device__ __forceinline__ void operator()(const f32x4 (&acc)[2][2][4][2], const Unit& u, int wr, int wc, int fr, int fq) const {
        float s = 0.f;
#pragma unroll
        for (int ai = 0; ai < 2; ++ai)
#pragma unroll
            for (int bj = 0; bj < 2; ++bj)
#pragma unroll
                for (int m = 0; m < 4; ++m)
#pragma unroll
                    for (int n = 0; n < 2; ++n) s += (acc[ai][bj][m][n][0] + acc[ai][bj][m][n][1]) + (acc[ai][bj][m][n][2] + acc[ai][bj][m][n][3]);
        dummy[(wr * 4 + wc) * 64 + fq * 16 + fr] = s;
    }
};
template <int K_, int NN_> struct ProbMoe {
    static constexpr bool FP8 = true;
    static constexpr int K = K_, lda = K_, ldb = K_, nN = NN_; static constexpr size_t estride = (size_t)NN_ * 256 * K_;
    const unsigned char* A; const unsigned char* Bt; int tp[9]; int G, c, i0, ilim;
    __device__ __forceinline__ bool next(int i, Unit& u) const { const int ii = i + i0; if (ii >= ilim) return false; return pg8::static_unit(ii * G + c, tp[8], nN, u); }
    __device__ __forceinline__ const char* abase(const Unit& u) const { return (const char*)(A + (size_t)u.pm * 256 * lda); }
    __device__ __forceinline__ const char* bbase(const Unit& u) const { int e = 0;
#pragma unroll
        for (int j = 1; j < 8; ++j) e += (u.pm >= tp[j]) ? 1 : 0;
        return (const char*)(Bt + (size_t)e * estride + (size_t)u.pn * 256 * ldb); }
};
__device__ __forceinline__ int moe_pos(int c, int G) { return (G & 7) ? c : (c & 7) * (G >> 3) + (c >> 3); }
__device__ __forceinline__ void moe_ord_unit(int w, int nM, int nN, Unit& u) {
    const int nig = pg8::WGM * nN, gid = w / nig, fm = gid * pg8::WGM, gsz = (nM - fm) < pg8::WGM ? (nM - fm) : pg8::WGM, r = w - gid * nig;
    u.pm = fm + r % gsz; u.pn = r / gsz;
}
template <int K_, int NN_> struct ProbMoeOrd {
    static constexpr bool FP8 = true;
    static constexpr int K = K_, lda = K_, ldb = K_, nN = NN_; static constexpr size_t estride = (size_t)NN_ * 256 * K_;
    const unsigned char* A; const unsigned char* Bt; int tp[9]; int G, pos, base, lim;
    __device__ __forceinline__ bool next(int i, Unit& u) const { const int w = base + i * G + pos; if (w >= lim) return false; moe_ord_unit(w, tp[8], nN, u); return true; }
    __device__ __forceinline__ const char* abase(const Unit& u) const { return (const char*)(A + (size_t)u.pm * 256 * lda); }
    __device__ __forceinline__ const char* bbase(const Unit& u) const { int e = 0;
#pragma unroll
        for (int j = 1; j < 8; ++j) e += (u.pm >= tp[j]) ? 1 : 0;
        return (const char*)(Bt + (size_t)e * estride + (size_t)u.pn * 256 * ldb); }
};
__device__ __forceinline__ void phase_router(const Frame& F, const CAS Args& a) {
    LAS float* rt = (LAS float*)F.lds;
    LAS int* cnt = (LAS int*)(F.lds + 65536);
    const float* rw = a.in[I_ROUTER]; const float* g2 = a.in[I_N2G] + D; const unsigned long long* ssq = (const unsigned long long*)(F.ws + OFF_SS) + 3 * (size_t)T; const bf16_t* h = (const bf16_t*)(F.ws + OFF_HB);
    int* toke = (int*)(F.ws + OFF_TOKE); float* tokg = (float*)(F.ws + OFF_TOKG); int* wgcnt = (int*)(F.ws + OFF_WGCNT);
    for (int i = F.tid; i < 2048 * 8; i += NTHREADS) rt[(i & 7) * 2048 + (i >> 3)] = rw[i];
    const int lane = F.lane;
    for (int tg = F.bx; tg < 256; tg += F.G) {
        if (F.tid < 8) cnt[F.tid] = 0;
        __syncthreads();
        for (int k = 0; k < 16; ++k) {
            const int tok = tg * 128 + F.wave * 16 + k;
            const float rs = ss_rs(ssq[tok]);
            float lg[8];
#pragma unroll
            for (int e = 0; e < 8; ++e) lg[e] = 0.f;
#pragma unroll
            for (int j = 0; j < 4; ++j) {
                const int c = lane * 8 + 512 * j; const u32x4 hb = *(const u32x4*)(h + (size_t)tok * D + c); const f32x4 gv0 = *(const f32x4*)(g2 + c), gv1 = *(const f32x4*)(g2 + c + 4);
                const f32x4 hn0 = (f32x4){bflo(hb.x), bfhi(hb.x), bflo(hb.y), bfhi(hb.y)} * rs * gv0, hn1 = (f32x4){bflo(hb.z), bfhi(hb.z), bflo(hb.w), bfhi(hb.w)} * rs * gv1;
#pragma unroll
                for (int e = 0; e < 8; ++e) { const f32x4 r0 = *(const LAS f32x4*)(rt + e * 2048 + c), r1 = *(const LAS f32x4*)(rt + e * 2048 + c + 4);
                    lg[e] += ((hn0.x * r0.x + hn0.y * r0.y) + (hn0.z * r0.z + hn0.w * r0.w)) + ((hn1.x * r1.x + hn1.y * r1.y) + (hn1.z * r1.z + hn1.w * r1.w)); }
            }
#pragma unroll
            for (int e = 0; e < 8; ++e) lg[e] = wave_sum(lg[e]);
            int i0 = 0; float v0 = lg[0];
#pragma unroll
            for (int e = 1; e < 8; ++e) if (lg[e] > v0) { v0 = lg[e]; i0 = e; }
            int i1 = -1; float v1 = -INFINITY;
#pragma unroll
            for (int e = 0; e < 8; ++e) if (e != i0 && lg[e] > v1) { v1 = lg[e]; i1 = e; }
            if (lane == 0) { const float g0 = 1.0f / (1.0f + expf(v1 - v0)); toke[tok] = i0; toke[T + tok] = i1; tokg[tok] = g0; tokg[T + tok] = 1.0f - g0; __hip_atomic_fetch_add((int*)(cnt + i0), 1, __ATOMIC_RELAXED, __HIP_MEMORY_SCOPE_WORKGROUP); __hip_atomic_fetch_add((int*)(cnt + i1), 1, __ATOMIC_RELAXED, __HIP_MEMORY_SCOPE_WORKGROUP); }
        }
        __syncthreads();
        if (F.tid < 8) wgcnt[tg * 8 + F.tid] = cnt[F.tid];
        __syncthreads();
    }
}
__device__ __forceinline__ void phase_assign(const Frame& F) {
    LAS int* wc = (LAS int*)F.lds;
    LAS int* base = wc + 2048;
    LAS int* seg = base + 8;
    LAS int* le = seg + 16;
    LAS int* ls = le + 256;
    const int* wgcnt = (const int*)(F.ws + OFF_WGCNT); const int* toke = (const int*)(F.ws + OFF_TOKE);
    int* slotof = (int*)(F.ws + OFF_SLOT); int* tokof = (int*)(F.ws + OFF_TOKOF); int* tiles = (int*)(F.ws + OFF_TILES);
    float* rsslot = (float*)(F.ws + OFF_RSSLOT); const unsigned long long* ssq3 = (const unsigned long long*)(F.ws + OFF_SS) + 3 * (size_t)T;
    const unsigned char* xb = F.ws + OFF_XB; unsigned char* asort = F.ws + OFF_ASORT;
    for (int tg = F.bx; tg < 256; tg += F.G) {
        __syncthreads();
        for (int i = F.tid; i < 2048; i += NTHREADS) wc[i] = wgcnt[i];
        if (F.tid < 256) le[F.tid] = toke[(F.tid & 1) * T + tg * 128 + (F.tid >> 1)];
        __syncthreads();
        if (F.tid < 8) { const int e = F.tid; int tot = 0, bef = 0; for (int w = 0; w < 256; ++w) { const int v = wc[w * 8 + e]; tot += v; bef += (w < tg) ? v : 0; }
            seg[8 + e] = tot; base[e] = bef; }
        __syncthreads();
        if (F.tid == 0) {
            int pre = 0;
            for (int e = 0; e < 8; ++e) { const int tot = seg[8 + e]; seg[e] = pre * 256; base[e] = pre * 256 + base[e]; if (tg == 0) tiles[e] = pre; pre += (tot + 255) >> 8; }
            if (tg == 0) tiles[8] = pre;
        }
        __syncthreads();
        if (F.tid < 8) { const int e = F.tid; int bs = base[e]; for (int i = 0; i < 256; ++i) if (le[i] == e) { ls[i] = bs; ++bs; } }
        __syncthreads();
        if (F.tid < 256) { const int tok = tg * 128 + (F.tid >> 1), s = F.tid & 1; slotof[s * T + tok] = ls[F.tid]; tokof[ls[F.tid]] = tok; rsslot[ls[F.tid]] = ss_rs(ssq3[tok]); }
        for (int i0 = F.wave * 32; i0 < F.wave * 32 + 32; i0 += 8) {
            u32x4 r[8][2];
#pragma unroll
            for (int u = 0; u < 8; ++u) { const int tok = tg * 128 + ((i0 + u) >> 1); const u32x4* srcp = (const u32x4*)(xb + (size_t)tok * D) + F.lane; r[u][0] = srcp[0]; r[u][1] = srcp[64]; }
#pragma unroll
            for (int u = 0; u < 8; ++u) { u32x4* dst = (u32x4*)(asort + (size_t)ls[i0 + u] * D) + F.lane; dst[0] = r[u][0]; dst[64] = r[u][1]; }
        }
        if (tg < 8) {
            const int p0 = seg[tg] + seg[8 + tg], p1 = seg[tg] + (((seg[8 + tg] + 255) >> 8) << 8);
            for (int s = p0 + F.wave; s < p1; s += NWAVES) { if (F.lane == 0) { tokof[s] = -1; rsslot[s] = 0.f; } u32x4* dst = (u32x4*)(asort + (size_t)s * D) + F.lane;
#pragma unroll
                for (int j = 0; j < 2; ++j) dst[64 * j] = (u32x4){0u, 0u, 0u, 0u}; }
        }
    }
}
__device__ __forceinline__ void phase_combine(const Frame& F, int sel, int fr, int extra) {
    const int* slotof = (const int*)(F.ws + OFF_SLOT); const float* tokg = (const float*)(F.ws + OFF_TOKG); const bf16_t* y = (const bf16_t*)(F.ws + OFF_ASORT); const bf16_t* hb16 = (const bf16_t*)(F.ws + OFF_HB); float* out = F.out;
    LAS int* late = (LAS int*)F.lds;
    if (sel) { const int R = ((const int*)(F.ws + OFF_TILES))[8];
        __syncthreads();
        for (int i = F.tid; i < 512; i += NTHREADS) late[i] = 0;
        __syncthreads();
        if (F.tid < extra) { pg8::Unit u; moe_ord_unit(fr * F.G + F.tid, R, D / 256, u); late[u.pm] = 1; }
        __syncthreads(); }
    const int w0 = sel == 1 ? extra : 0;
    const int gw = (F.bx - w0) * NWAVES + F.wave, NGW = (F.G - w0) * NWAVES, lane = F.lane;
    for (int tok = gw; tok < T; tok += NGW) {
        const int s0 = slotof[tok], s1 = slotof[T + tok];
        if (sel) { const int lt = late[s0 >> 8] | late[s1 >> 8]; if ((sel == 1) == (lt != 0)) continue; }
        const float g0 = tokg[tok], g1 = tokg[T + tok];
#pragma unroll
        for (int j = 0; j < 4; ++j) {
            const int c = lane * 8 + 512 * j; float* op = out + (size_t)tok * D + c;
            const u32x4 a0 = __builtin_nontemporal_load((const u32x4*)(y + (size_t)s0 * D + c)), a1 = __builtin_nontemporal_load((const u32x4*)(y + (size_t)s1 * D + c));
            const u32x4 hb = __builtin_nontemporal_load((const u32x4*)(hb16 + (size_t)tok * D + c));
            f32x4 h0 = (f32x4){bflo(hb.x), bfhi(hb.x), bflo(hb.y), bfhi(hb.y)}, h1 = (f32x4){bflo(hb.z), bfhi(hb.z), bflo(hb.w), bfhi(hb.w)};
            h0.x += g0 * bflo(a0.x) + g1 * bflo(a1.x); h0.y += g0 * bfhi(a0.x) + g1 * bfhi(a1.x); h0.z += g0 * bflo(a0.y) + g1 * bflo(a1.y); h0.w += g0 * bfhi(a0.y) + g1 * bfhi(a1.y);
            h1.x += g0 * bflo(a0.z) + g1 * bflo(a1.z); h1.y += g0 * bfhi(a0.z) + g1 * bfhi(a1.z); h1.z += g0 * bflo(a0.w) + g1 * bflo(a1.w); h1.w += g0 * bfhi(a0.w) + g1 * bfhi(a1.w);
            __builtin_nontemporal_store(h0, (f32x4*)op); __builtin_nontemporal_store(h1, (f32x4*)(op + 4));
        }
    }
}

enum LPhase { LP_INPROJ = 0, LP_G1, LP_G2, LP_G3, LP_G4, LP_G5, LP_OUTPROJ, LP_F0, LP_F1, LP_F2, LP_F3, LP_F4, LP_F5, LP_N };
constexpr int PH_TOTAL = 1 + 2 * LP_N;

template <int L> __device__ __forceinline__ void layer_mixer(const Frame& F, const CAS Args& args, int lo, int hi, const XcdBarrier& bar) {
    unsigned char* ws = F.ws;
#define IN(k) (lo <= (k) && (k) < hi)
#define SEAM(k) do { if ((k) + 1 < hi) xcd_barrier(bar); } while (0)
    {
        constexpr int l = L; constexpr int layer = L; const int pb = 1 + LP_N * l;
        unsigned long long* ssq = (unsigned long long*)(ws + OFF_SS);
        if (IN(pb + LP_INPROJ)) {
            ProbPlain P{(const bf16_t*)(ws + (l == 0 ? OFF_XB : OFF_HB)), (const bf16_t*)(ws + OFF_WIN + l * SZ_WIN), D, D, D, T / 256, IN_COLS / 256, F.G, F.bx};
            EpiInProj E{ssq + (size_t)(2 * l) * T, (bf16_t*)(ws + MO(B_ZATT)), (bf16_t*)(ws + MO(B_ZRW)), (bf16_t*)(ws + MO(B_UEXT))};
            pg8::gemm_phase(F.lds, P, E, F.wave);
            if (S5_BUILD_TAIL && F.G == 256) { __syncthreads(); phase_s5_build(fresh(F), args, l, 128, 128); }
            SEAM(pb + LP_INPROJ);
        }
        if (IN(pb + LP_G1)) {
            if (!(S5_BUILD_TAIL && F.G == 256 && IN(pb + LP_INPROJ))) { phase_s5_build(fresh(F), args, l, 0, F.G); __syncthreads(); }
            phase_attention(fresh(F), args, l); __syncthreads();
            phase_rw_prep1(fresh(F), args, l);
            SEAM(pb + LP_G1);
        }
        if (IN(pb + LP_G2)) {
            const bool scan_here = S5_SCAN_IN_G2 && F.G == 256;
            unsigned* s5flag = (unsigned*)(ws + OFF_CTL) + XS_S5FLAG(l);
            { ProbS5a P{(const bf16_t*)(ws + MO(B_UEXT)), (const bf16_t*)(ws + OFF_S5E), 1024, S5K, 1024, F.G, F.bx};
              EpiS5a E{(float*)(ws + MO(B_XLOC))};
              pg8::gemm_phase(F.lds, P, E, F.wave); }
            if (scan_here && F.bx < 64) {
                asm volatile("s_waitcnt vmcnt(0)" ::: "memory"); __syncthreads();
                if (F.tid == 0) { __builtin_amdgcn_fence(__ATOMIC_RELEASE, "agent"); asm volatile("s_waitcnt vmcnt(0)" ::: "memory"); (void)xb_add(s5flag, 1u); }
            }
            { ProbLora P{(const bf16_t*)(ws + MO(B_ALORA)), (const bf16_t*)(ws + OFF_BCAT + l * SZ_BCAT), 128, 256, 256, T / 256, 6, F.G, F.bx};
              EpiLora E{(bf16_t*)(ws + MO(B_DEC)), (bf16_t*)(ws + MO(B_ICLR)), (bf16_t*)(ws + MO(B_GATE))};
              pg8::gemm_phase(F.lds, P, E, F.wave); }
            if (scan_here && F.bx >= F.G - 8) {
                if (F.tid == 0) { XB_SPIN(xb_ld(s5flag) != 64u, (unsigned*)(ws + OFF_CTL)); __builtin_amdgcn_fence(__ATOMIC_ACQUIRE, "agent"); asm volatile("s_waitcnt vmcnt(0)" ::: "memory"); }
                __syncthreads();
                Frame Fs = fresh(F); Fs.bx = F.bx - (F.G - 8); phase_s5_scan(Fs, args, l);
            }
            SEAM(pb + LP_G2);
        }
        if (IN(pb + LP_G3)) {
            if (!(S5_SCAN_IN_G2 && F.G == 256)) phase_s5_scan(fresh(F), args, l);
            phase_rw_pass1(fresh(F), args, l);
            SEAM(pb + LP_G3);
        }
        if (IN(pb + LP_G4)) {
            phase_rw_scan(fresh(F), l);
            { const bool sub = F.G > 64;
              ProbS5b P{(const bf16_t*)(ws + MO(B_UEXT)), (const bf16_t*)(ws + OFF_S5B2), S5K, S5K, S5K, sub ? F.G - 64 : F.G, sub ? F.bx - 64 : F.bx};
              EpiS5b E{(bf16_t*)(ws + MO(B_ZG))};
              pg8::gemm_phase(F.lds, P, E, F.wave);
              if (sub) moe_convert_range(fresh(F), args, l * MOE_EARLY, (l + 1) * MOE_EARLY, 64, F.G - 64); }
            SEAM(pb + LP_G4);
        }
        if (IN(pb + LP_G5)) {
            { ProbPlain P{(const bf16_t*)(ws + MO(B_ZG)), (const bf16_t*)(ws + OFF_WGLU + l * SZ_WGLU), 512, 512, 512, T / 256, 2, F.G, F.bx};
              EpiGlu E{(const bf16_t*)(ws + MO(B_ZG)), args.in[I_GLUB] + l * 512, (bf16_t*)(ws + MO(B_MIXED)), ssq + (size_t)(5 + 2 * l) * T};
              pg8::gemm_phase(F.lds, P, E, F.wave); }
            phase_rw_fix(fresh(F), args, l);
            SEAM(pb + LP_G5);
        }
        if (IN(pb + LP_OUTPROJ)) {
            ProbPlain P{(const bf16_t*)(ws + MO(B_MIXED)), (const bf16_t*)(ws + OFF_WOUT + l * SZ_WOUT), D, D, D, T / 256, D / 256, F.G, F.bx};
            EpiResid<(L == 1 || (FFN_FP8 & 1)), true, true> E{l == 0 ? (const void*)(ws + OFF_XB) : (const void*)(ws + OFF_HB), (bf16_t*)(ws + OFF_HB), ws + (l == 0 ? OFF_X8 : OFF_XB), ssq + (size_t)(2 * l + 1) * T, 1.0f, ssq + (size_t)(4 + 2 * l) * T, ssq + (size_t)(5 + 2 * l) * T};
            pg8::gemm_phase(F.lds, P, E, F.wave); SEAM(pb + LP_OUTPROJ);
        }
    }
#undef IN
#undef SEAM
}

__global__ void __launch_bounds__(NTHREADS, 2) mk_fwd(Args args_) {
    const CAS Args& args = *(const CAS Args*)__builtin_amdgcn_kernarg_segment_ptr();
    extern __shared__ __attribute__((aligned(16))) unsigned char lds_raw[];
    Frame F; F.lds = (LAS unsigned char*)lds_raw; F.wave = __builtin_amdgcn_readfirstlane((int)threadIdx.x >> 6); F.lane = lane_id(); F.tid = F.wave * 64 + F.lane; F.G = gridDim.x; F.bx = blockIdx.x;
    F.ws = args.ws; F.out = args.out;
    unsigned char* ws = args.ws;
    const int lo = args.ph_lo, hi = args.ph_hi;
    LAS unsigned* misc = (LAS unsigned*)(F.lds + MISC_OFF);
    if (F.tid < 4) misc[F.tid] = 0u;
    __syncthreads();
    XcdBarrier bar; bar.bar = (unsigned*)(ws + OFF_CTL); bar.x = 0; bar.st = (volatile LAS unsigned*)misc; bar.wave = F.wave;
    if (hi - lo > 1) bar = xcd_barrier_post((unsigned*)(ws + OFF_CTL), (volatile LAS unsigned*)misc, F.wave);
#define IN(k) (lo <= (k) && (k) < hi)
#define SEAM(k) do { if ((k) + 1 < hi) xcd_barrier(bar); } while (0)
    if (IN(0)) { phase_prologue(fresh(F), args); SEAM(0); }
    layer_mixer<0>(F, args, lo, hi, bar);
    {
        const int pb = 1; unsigned long long* ssq = (unsigned long long*)(ws + OFF_SS);
        if (IN(pb + LP_F0)) {
            ProbPlainT<(FFN_FP8 & 1) != 0> P{ws + OFF_X8, ws + OFF_W13, D, D, D, T / 256, 2 * DFF / 256, F.G, F.bx};
            EpiSwiglu<(FFN_FP8 & 1) != 0, (FFN_FP8 & 2) != 0> E{ssq + T, nullptr, ws + OFF_ACT, DFF};
            pg8::gemm_phase(F.lds, P, E, F.wave); SEAM(pb + LP_F0);
        }
        if (IN(pb + LP_F1)) {
            ProbPlainT<(FFN_FP8 & 2) != 0> P{ws + OFF_ACT, ws + OFF_W2, DFF, DFF, DFF, T / 256, D / 256, F.G, F.bx};
            EpiResid<false, false, true, false> E{ws + OFF_HB, (bf16_t*)(ws + OFF_HB), nullptr, ssq + 2 * (size_t)T, (FFN_FP8 & 2) ? 1.0f / (SC_ACT * SC_W2) : 1.0f};
            pg8::gemm_phase(F.lds, P, E, F.wave); SEAM(pb + LP_F1);
        }
    }
    layer_mixer<1>(F, args, lo, hi, bar);
    {
        const int pb = 1 + LP_N; unsigned long long* ssq = (unsigned long long*)(ws + OFF_SS);
        if (IN(pb + LP_F0)) { phase_router(fresh(F), args); SEAM(pb + LP_F0); }
        if (IN(pb + LP_F1)) {
            phase_assign(fresh(F));
            __syncthreads();
            moe_convert_range(fresh(F), args, F.G > 64 ? 2 * MOE_EARLY : 0, MOE_ITEMS, 0, F.G);
            SEAM(pb + LP_F1);
        }
        if (IN(pb + LP_F2) || IN(pb + LP_F4)) {
            const int* tl = (const int*)(ws + OFF_TILES);
            if (IN(pb + LP_F2)) {
                constexpr int NN = 2 * DFFE / 256;
                ProbMoeOrd<D, NN> P{ws + OFF_ASORT, ws + OFF_WM13, {RFL(tl[0]), RFL(tl[1]), RFL(tl[2]), RFL(tl[3]), RFL(tl[4]), RFL(tl[5]), RFL(tl[6]), RFL(tl[7]), RFL(tl[8])}, F.G, moe_pos(F.bx, F.G), 0, RFL(tl[8]) * NN};
                EpiSwiglu<true> E{ssq + 3 * (size_t)T, (const float*)(ws + OFF_RSSLOT), ws + OFF_MACT, DFFE};
                pg8::gemm_phase(F.lds, P, E, F.wave);
#if DBG_PROBE_MOE13
                { __syncthreads(); EpiProbe E2{(float*)(ws + OFF_CTL + 65536) + F.bx * 512}; pg8::gemm_phase(F.lds, P, E2, F.wave); }
#endif
                SEAM(pb + LP_F2);
            }
        }
        int csel = 0, cfr = 0, cextra = 0;
        if (IN(pb + LP_F4)) {
            const int* tl = (const int*)(ws + OFF_TILES);
            constexpr int NN2 = D / 256;
            ProbMoeOrd<DFFE, NN2> P{ws + OFF_MACT, ws + OFF_WM2, {RFL(tl[0]), RFL(tl[1]), RFL(tl[2]), RFL(tl[3]), RFL(tl[4]), RFL(tl[5]), RFL(tl[6]), RFL(tl[7]), RFL(tl[8])}, F.G, moe_pos(F.bx, F.G), 0, RFL(tl[8]) * NN2};
            EpiBf16Out E{(bf16_t*)(ws + OFF_ASORT), D, 1.0f / (SC_ACT * SC_W2)};
            const int ntile = RFL(tl[8]) * NN2, fr = ntile / F.G, extra = ntile - fr * F.G, pc = moe_pos(F.bx, F.G);
            const bool split = MK_SPLIT_COMBINE && IN(pb + LP_F5) && extra > 0 && fr > 0 && extra < F.G;
            if (split) { P.lim = fr * F.G; csel = 2; cfr = fr; cextra = extra; }
#pragma nounroll
            for (int part = 0; part < 2; ++part) {
                if (part == 1) {
                    if (!split) break;
                    split_arrive(bar);
                    if (pc >= extra) { split_wait(bar); Frame Fc = fresh(F); Fc.bx = pc; phase_combine(Fc, 1, fr, extra); break; }
                    P.base = fr * F.G; P.lim = ntile;
                }
                pg8::gemm_phase(F.lds, P, E, F.wave);
            }
            SEAM(pb + LP_F4);
        }
        if (IN(pb + LP_F5)) { phase_combine(fresh(F), csel, cfr, cextra); }
    }
#undef IN
#undef SEAM
}

extern "C" void kernel_launch(void* const* d_in, const int* in_sizes, int n_in, void* d_out, int out_size, void* d_ws, size_t ws_size, hipStream_t stream) {
    static int grid = 0;
    if (grid == 0) {
        int dev = 0, cus = 0;
        if (n_in != 39 || ws_size < WS_NEED || ws_size < OFF_MIX_END) { fprintf(stderr, "kernel_launch: unexpected shapes (n_in %d, ws %zu)\n", n_in, ws_size); grid = -1; return; }
        (void)hipGetDevice(&dev); (void)hipDeviceGetAttribute(&cus, hipDeviceAttributeMultiprocessorCount, dev);
        if (hipFuncSetAttribute((const void*)mk_fwd, hipFuncAttributeMaxDynamicSharedMemorySize, LDS_BYTES) != hipSuccess) { fprintf(stderr, "kernel_launch: hipFuncSetAttribute failed\n"); grid = -1; return; }
        grid = cus;
    }
    if (grid < 0) return;
    (void)hipMemsetAsync((char*)d_ws + OFF_CTL, 0, CTL_ZERO_BYTES, stream);
    Args a{};
    for (int i = 0; i < 39; ++i) a.in[i] = (const float*)d_in[i];
    a.out = (float*)d_out; a.ws = (unsigned char*)d_ws;
#if MK_ONE_LAUNCH
    a.ph_lo = 0; a.ph_hi = PH_TOTAL; hipLaunchKernelGGL(mk_fwd, dim3(grid), dim3(NTHREADS), LDS_BYTES, stream, a);
#else
    for (int ph = 0; ph < PH_TOTAL; ++ph) {
        if (ph >= 1 + LP_F2 && ph < 1 + LP_N) continue;
        if (ph > DBG_LAST_PHASE) break;
        a.ph_lo = ph; a.ph_hi = ph + 1;
        const int nrep = ((DBG_REP_MASK >> ph) & 1ull) ? DBG_REP_N : 1;
        for (int r = 0; r < nrep; ++r) hipLaunchKernelGGL(mk_fwd, dim3(grid), dim3(NTHREADS), LDS_BYTES, stream, a);
    }
#endif
}
```

```cpp
#include <hip/hip_runtime.h>
#include <cstdint>
#include <cstdio>

#define LAS __attribute__((address_space(3)))
#define GAS __attribute__((address_space(1)))
#define CAS __attribute__((address_space(4)))
typedef unsigned short bf16_t;
typedef short bf16x8 __attribute__((ext_vector_type(8)));
typedef short s16x4 __attribute__((ext_vector_type(4)));
typedef float f32x4 __attribute__((ext_vector_type(4)));
typedef float f32x2 __attribute__((ext_vector_type(2)));
typedef unsigned u32x4 __attribute__((ext_vector_type(4)));
typedef unsigned u32x2 __attribute__((ext_vector_type(2)));
typedef int i32x4 __attribute__((ext_vector_type(4)));
typedef int i32x8 __attribute__((ext_vector_type(8)));

constexpr int BATCH = 2, SEQ = 16384, T = BATCH * SEQ, D = 2048;
constexpr int IN_COLS = 3840, ATT_W = 1024, KV_W = 256, RW_W = 512, SS_W = 512, RW_COLS = 1792;
constexpr int ZATT_W = ATT_W + 2 * KV_W;
constexpr int DFF = 5632, DFFE = 7168, NEXP = 8;
constexpr float NORM_EPS = 1e-6f;
constexpr int NWAVES = 8, NTHREADS = 512;
#ifndef MK_ONE_LAUNCH
#define MK_ONE_LAUNCH 1
#define S5_BUILD_TAIL 0
#define S5_SCAN_IN_G2 1
#define MK_SPLIT_COMBINE 1
#endif
#ifndef FFN_FP8
#define FFN_FP8 3
#endif
#ifndef DBG_PROBE_MOE13
#define DBG_PROBE_MOE13 0
#endif
#ifndef DBG_REP_MASK
#define DBG_REP_MASK 0ull
#endif
#ifndef DBG_REP_N
#define DBG_REP_N 2
#endif
#ifndef DBG_LAST_PHASE
#define DBG_LAST_PHASE 1000
#endif
constexpr int S5C = 64;
constexpr int S5K = 1152;
constexpr int RWC = 128, RWNC = SEQ / RWC;
constexpr int MAXSLOTS = 2 * T + NEXP * 256;

constexpr size_t MiB = 1u << 20;
constexpr size_t OFF_CTL = 0;
constexpr size_t CTL_ZERO_BYTES = 1 * MiB;
constexpr size_t OFF_SS = 1 * MiB;
constexpr size_t OFF_TOKE = OFF_SS + 8 * (size_t)T * 8;
constexpr size_t OFF_TOKG = OFF_TOKE + 2 * (size_t)T * 4;
constexpr size_t OFF_SLOT = OFF_TOKG + 2 * (size_t)T * 4;
constexpr size_t OFF_TOKOF = OFF_SLOT + 2 * (size_t)T * 4;
constexpr size_t OFF_WGCNT = OFF_TOKOF + (size_t)MAXSLOTS * 4;
constexpr size_t OFF_TILES = OFF_WGCNT + 256 * 8 * 4;
constexpr size_t OFF_RSSLOT = OFF_TILES + 256;
static_assert(OFF_RSSLOT + (size_t)MAXSLOTS * 4 <= 6 * MiB, "ctl region");
constexpr size_t OFF_XB = 6 * MiB;
constexpr size_t SZ_XB = (size_t)T * D * 2;
constexpr size_t OFF_WIN = OFF_XB + SZ_XB;
constexpr size_t SZ_WIN = (size_t)IN_COLS * D * 2;
constexpr size_t OFF_WOUT = OFF_WIN + 2 * SZ_WIN;
constexpr size_t SZ_WOUT = (size_t)D * D * 2;
constexpr size_t OFF_W13 = OFF_WOUT + 2 * SZ_WOUT;
constexpr size_t OFF_W2 = OFF_W13 + (size_t)2 * DFF * D * 2;
constexpr size_t OFF_BCAT = OFF_W2 + (size_t)D * DFF * 2;
constexpr size_t SZ_BCAT = (size_t)1536 * 256 * 2;
constexpr size_t OFF_WGLU = OFF_BCAT + 2 * SZ_BCAT;
constexpr size_t SZ_WGLU = (size_t)512 * 512 * 2;
constexpr size_t OFF_S5B2 = OFF_WGLU + 2 * SZ_WGLU;
constexpr size_t SZ_S5B2 = (size_t)32 * 1024 * S5K * 2;
constexpr size_t OFF_S5E = OFF_S5B2 + SZ_S5B2;
constexpr size_t SZ_S5E = (size_t)32 * 256 * 1024 * 2;
constexpr size_t OFF_MIX = OFF_S5E + SZ_S5E;
enum MixBuf { B_ZATT = 0, B_ZRW, B_UEXT, B_XLOC, B_ZG, B_ALORA, B_DEC, B_ICLR, B_GATE, B_STREAM, B_BONUS, B_YLOC, B_PVEC, B_PMAT, B_QMAT, B_SST, B_ATTRAW, B_SSRAW, B_MIXED, B_N };
constexpr size_t mb_size(int b) {
    switch (b) {
        case B_ZATT: return (size_t)T * ZATT_W * 2;
        case B_ZRW: return (size_t)T * RW_COLS * 2;
        case B_UEXT: return (size_t)32 * 512 * S5K * 2;
        case B_XLOC: return (size_t)32 * 512 * 128 * 4;
        case B_ZG: return (size_t)T * 512 * 2;
        case B_ALORA: return (size_t)T * 256 * 2;
        case B_DEC: return (size_t)T * 512 * 4;
        case B_ICLR: return (size_t)T * 512 * 4;
        case B_GATE: return (size_t)T * 512 * 2;
        case B_STREAM: return 0;
        case B_BONUS: return (size_t)2 * T * 8 * 4;
        case B_YLOC: return (size_t)T * 512 * 4;
        case B_PVEC: return (size_t)T * 512 * 4;
        case B_PMAT: return (size_t)2048 * 4096 * 4;
        case B_QMAT: return (size_t)2048 * 4096 * 4;
        case B_SST: return (size_t)2048 * 4096 * 4;
        case B_ATTRAW: return (size_t)T * 1024 * 2;
        case B_SSRAW: return (size_t)T * 512 * 2;
        case B_MIXED: return (size_t)T * D * 2;
    }
    return 0;
}
constexpr int mb_order(int L, int i) {
    constexpr int o0[B_N] = {B_ZATT, B_ZRW, B_UEXT, B_XLOC, B_ZG, B_ALORA, B_DEC, B_ICLR, B_GATE, B_STREAM, B_BONUS, B_YLOC, B_PVEC, B_PMAT, B_QMAT, B_SST, B_ATTRAW, B_SSRAW, B_MIXED};
    constexpr int o1[B_N] = {B_STREAM, B_PVEC, B_ZATT, B_ZRW, B_UEXT, B_XLOC, B_ZG, B_ALORA, B_DEC, B_ICLR, B_GATE, B_BONUS, B_YLOC, B_PMAT, B_QMAT, B_SST, B_ATTRAW, B_SSRAW, B_MIXED};
    return L ? o1[i] : o0[i];
}
constexpr size_t moff(int L, int b) { size_t o = OFF_MIX; for (int i = 0; i < B_N; ++i) { if (mb_order(L, i) == b) return o; o += mb_size(mb_order(L, i)); } return o; }
constexpr size_t OFF_MIX_END = moff(0, B_MIXED) + mb_size(B_MIXED);
static_assert(moff(1, B_MIXED) + mb_size(B_MIXED) == OFF_MIX_END, "both layouts fill the same range");
#define MO(b) (layer ? moff(1, b) : moff(0, b))
constexpr size_t OFF_ACT = OFF_MIX;
static_assert(OFF_ACT + (size_t)T * DFF * 2 <= OFF_MIX_END, "dense act");
constexpr size_t OFF_MACT = OFF_XB;
constexpr size_t OFF_ASORT = OFF_MACT + (size_t)MAXSLOTS * DFFE;
constexpr size_t OFF_WM13 = OFF_MIX_END;
constexpr size_t OFF_WM2 = OFF_WM13 + (size_t)NEXP * 2 * DFFE * D;
constexpr size_t OFF_HB = OFF_WM2 + (size_t)NEXP * DFFE * D;
constexpr size_t OFF_X8 = OFF_HB + (size_t)T * D * 2;
constexpr size_t WS_NEED = OFF_X8 + (size_t)T * D;
static_assert((FFN_FP8 & 1) != 0, "OFF_X8 holds an fp8 copy");
static_assert(WS_NEED <= 1879048192ull && OFF_MIX_END <= 1879048192ull && OFF_ASORT + (size_t)MAXSLOTS * D * 2 <= OFF_WM13, "d_ws budget (4 x largest tensor)");

constexpr int RING_BYTES = 131072;
constexpr int MISC_OFF = RING_BYTES;
constexpr int LDS_BYTES = 147456;

__device__ __forceinline__ int lane_id() { int l; asm volatile("v_mbcnt_lo_u32_b32 %0, -1, 0\n\tv_mbcnt_hi_u32_b32 %0, -1, %0" : "=v"(l)); return l; }
#define RFL(x) __builtin_amdgcn_readfirstlane(x)
#define LDS_WAIT() asm volatile("s_waitcnt lgkmcnt(0)" ::: "memory")
#define VM_WAIT() asm volatile("s_waitcnt vmcnt(0)" ::: "memory")
__device__ __forceinline__ unsigned f2bf(float f) { unsigned u = __builtin_bit_cast(unsigned, f); return (u + 0x7fffu + ((u >> 16) & 1u)) >> 16; }
__device__ __forceinline__ unsigned pk2(float lo, float hi) { return f2bf(lo) | (f2bf(hi) << 16); }
__device__ __forceinline__ float bflo(unsigned w) { return __builtin_bit_cast(float, w << 16); }
__device__ __forceinline__ float bfhi(unsigned w) { return __builtin_bit_cast(float, w & 0xffff0000u); }
__device__ __forceinline__ float bf2f(bf16_t b) { return __builtin_bit_cast(float, (unsigned)b << 16); }
__device__ __forceinline__ unsigned cvt_pk_bf16(float lo, float hi) { unsigned r; asm volatile("v_cvt_pk_bf16_f32 %0, %1, %2" : "=v"(r) : "v"(lo), "v"(hi)); return r; }
__device__ __forceinline__ float clamp8(float v) { return __builtin_amdgcn_fmed3f(v, -448.0f, 448.0f); }
__device__ __forceinline__ unsigned pk8(float a, float b, float c, float d) { int w = 0; w = __builtin_amdgcn_cvt_pk_fp8_f32(a, b, w, false); w = __builtin_amdgcn_cvt_pk_fp8_f32(c, d, w, true); return (unsigned)w; }
__device__ __forceinline__ bf16x8 as_bf16(i32x4 v) { return __builtin_bit_cast(bf16x8, v); }
__device__ __forceinline__ i32x8 cat8(bf16x8 lo, bf16x8 hi) { return __builtin_shufflevector(__builtin_bit_cast(i32x4, lo), __builtin_bit_cast(i32x4, hi), 0, 1, 2, 3, 4, 5, 6, 7); }
constexpr float SC_H = 16.0f, SC_ACT = 8.0f, SC_W13 = 1024.0f, SC_W2 = 2048.0f;
__device__ __forceinline__ float wave_sum(float v) {
#pragma unroll
    for (int o = 1; o < 64; o <<= 1) v += __shfl_xor(v, o);
    return v;
}
__device__ __forceinline__ float frcp(float x) { return __builtin_amdgcn_rcpf(x); }
__device__ __forceinline__ float sigmoidf_(float x) { return frcp(1.0f + __builtin_amdgcn_exp2f(-1.4426950408889634f * x)); }
__device__ __forceinline__ unsigned long long ss_fix(float s) { return (unsigned long long)(s * 1048576.0f); }
__device__ __forceinline__ float ss_mean(unsigned long long v, float inv_n) { return (float)v * (1.0f / 1048576.0f) * inv_n + 1e-6f; }
__device__ __forceinline__ float ss_rs(unsigned long long v) { return rsqrtf((float)v * (1.0f / (1048576.0f * 2048.0f)) + 1e-6f); }

#define XB_TMO      128
#define XB_XCNT(j)  (256  + 64 * (j))
#define XB_XSUB(j)  (1280 + 64 * (j))
#define XB_XGEN(j)  (2304 + 64 * (j))
#define XB_TOP      3328
#define XB_TOPGEN   3392
#define XCD_BAR_WORDS 3456
#define XB_SPIN_CAP (1u << 18)
__device__ __forceinline__ unsigned xb_ld(unsigned* p)              { return __hip_atomic_load(p, __ATOMIC_RELAXED, __HIP_MEMORY_SCOPE_AGENT); }
__device__ __forceinline__ unsigned xb_add(unsigned* p, unsigned v) { return __hip_atomic_fetch_add(p, v, __ATOMIC_RELAXED, __HIP_MEMORY_SCOPE_AGENT); }
__device__ __forceinline__ unsigned xb_xcc_id() { return (unsigned)__builtin_amdgcn_s_getreg((3 << 11) | 20) & 0xFu; }
#define XB_SPIN(cond, bar) do { unsigned _sp = 0; while (cond) { __builtin_amdgcn_s_sleep(1); \
    if ((++_sp & 255u) == 0u) { if (xb_ld(&(bar)[XB_TMO])) break; if (_sp > XB_SPIN_CAP) { atomicAdd(&(bar)[XB_TMO], 1u); break; } } } } while (0)
struct XcdBarrier { unsigned* bar; unsigned x; volatile LAS unsigned* st; int wave; };
__device__ __forceinline__ XcdBarrier xcd_barrier_post(unsigned* bar, volatile LAS unsigned* st, int wave) {
    XcdBarrier b; b.bar = bar; b.x = xb_xcc_id(); b.st = st; b.wave = wave;
    if (wave == 0 && lane_id() == 0) (void)xb_add(&bar[XB_XCNT(b.x)], 1u);
    return b;
}
__device__ __forceinline__ void xcd_barrier_complete(unsigned* bar, unsigned x, unsigned& nloc, unsigned& nx) {
    const unsigned G = gridDim.x * gridDim.y * gridDim.z;
    unsigned sum, cnt, mine, sp = 0u;
    for (;;) {
        sum = 0u; cnt = 0u; mine = 0u;
#pragma unroll
        for (unsigned j = 0; j < 16; ++j) { const unsigned c = xb_ld(&bar[XB_XCNT(j)]); sum += c; cnt += (c > 0u) ? 1u : 0u; mine = (j == x) ? c : mine; }
        if (sum == G) break;
        __builtin_amdgcn_s_sleep(1);
        if ((++sp & 255u) == 0u) { if (xb_ld(&bar[XB_TMO])) break; if (sp > XB_SPIN_CAP) { atomicAdd(&bar[XB_TMO], 1u); break; } }
    }
    nloc = mine > 0u ? mine : 1u; nx = cnt > 0u ? cnt : 1u;
}
__device__ __forceinline__ void xcd_barrier(const XcdBarrier& b) {
    asm volatile("s_waitcnt vmcnt(0)" ::: "memory");
    __syncthreads();
    if (b.wave == 0 && lane_id() == 0) {
        unsigned* bar = b.bar;
        __builtin_amdgcn_s_waitcnt(0);
        unsigned nloc = b.st[0], nx = b.st[1];
        if (nloc == 0u) { xcd_barrier_complete(bar, b.x, nloc, nx); b.st[0] = nloc; b.st[1] = nx; }
        const unsigned old = xb_add(&bar[XB_XSUB(b.x)], 1u);
        const unsigned gen = old / nloc;
        if (old + 1u == (gen + 1u) * nloc) {
            __builtin_amdgcn_fence(__ATOMIC_RELEASE, "agent");
            asm volatile("s_waitcnt vmcnt(0)" ::: "memory");
            const unsigned og = xb_add(&bar[XB_TOP], 1u);
            const unsigned tg = og / nx;
            if (og + 1u == (tg + 1u) * nx) xb_add(&bar[XB_TOPGEN], 1u);
            else XB_SPIN(xb_ld(&bar[XB_TOPGEN]) == tg, bar);
            __builtin_amdgcn_fence(__ATOMIC_ACQUIRE, "agent");
            xb_add(&bar[XB_XGEN(b.x)], 1u);
            asm volatile("s_waitcnt vmcnt(0)" ::: "memory");
        } else {
            XB_SPIN(xb_ld(&bar[XB_XGEN(b.x)]) == gen, bar);
            __builtin_amdgcn_fence(__ATOMIC_ACQUIRE, "agent");
            asm volatile("s_waitcnt vmcnt(0)" ::: "memory");
        }
    }
    __syncthreads();
}

#define XS_SUB(j)  (8192 + 64 * (j))
#define XS_TOP     (8192 + 64 * 16)
#define XS_S5FLAG(l) (8192 + 64 * (17 + (l)))
__device__ __forceinline__ void split_arrive(const XcdBarrier& b) {
    asm volatile("s_waitcnt vmcnt(0)" ::: "memory");
    __syncthreads();
    if (b.wave == 0 && lane_id() == 0) {
        unsigned* bar = b.bar;
        __builtin_amdgcn_s_waitcnt(0);
        unsigned nloc = b.st[0], nx = b.st[1];
        if (nloc == 0u) { xcd_barrier_complete(bar, b.x, nloc, nx); b.st[0] = nloc; b.st[1] = nx; }
        const unsigned old = xb_add(&bar[XS_SUB(b.x)], 1u);
        if (old + 1u == nloc) { __builtin_amdgcn_fence(__ATOMIC_RELEASE, "agent"); asm volatile("s_waitcnt vmcnt(0)" ::: "memory"); xb_add(&bar[XS_TOP], 1u); }
    }
}
__device__ __forceinline__ void split_wait(const XcdBarrier& b) {
    if (b.wave == 0 && lane_id() == 0) {
        unsigned* bar = b.bar; const unsigned nx = b.st[1];
        XB_SPIN(xb_ld(&bar[XS_TOP]) != nx, bar);
        __builtin_amdgcn_fence(__ATOMIC_ACQUIRE, "agent");
        asm volatile("s_waitcnt vmcnt(0)" ::: "memory");
    }
    __syncthreads();
}

namespace pg8 {
constexpr int BM = 256, BK = 64, HALF = 128, HTB = HALF * BK * 2, STAGE_BYTES = 8 * HTB, NXCD = 8, WGM = 4;
__host__ __device__ __forceinline__ int lds_byte(int r, int c) { const int st = (r >> 4) * 2 + (c >> 5), rr = r & 15, cc = c & 31, ob = rr * 64 + cc * 2; return st * 1024 + (ob ^ (((ob >> 9) & 1) << 5)); }
__host__ __device__ __forceinline__ void stage_rc(int b, int& R, int& C) { const int st = b / 1024, sb = b % 1024, swz = sb ^ (((sb >> 9) & 1) << 5); R = (st >> 1) * 16 + swz / 64; C = (st & 1) * 32 + (swz % 64) / 2; }
__host__ __device__ __forceinline__ int perm32(int rho) { const int n = rho >> 4, i = rho & 15; return 8 * (i >> 2) + 4 * n + (i & 3); }
struct Unit { int pm, pn; };
__device__ __forceinline__ bool static_unit(int L, int nM, int nN, Unit& u) {
    const int nwg = nM * nN; if (L < 0 || L >= nwg) return false;
    int wgid = (int)L; { const int q = nwg / NXCD, r = nwg % NXCD, xcd = wgid % NXCD, off = wgid / NXCD; wgid = (xcd < r ? xcd * (q + 1) : r * (q + 1) + (xcd - r) * q) + off; }
    const int nig = WGM * nN, gid = wgid / nig, fm = gid * WGM, gsz = (nM - fm) < WGM ? (nM - fm) : WGM;
    u.pm = fm + ((wgid % nig) % gsz); u.pn = (wgid % nig) / gsz; return true;
}

__device__ __forceinline__ void glds_s(const char* sbase, unsigned voff, unsigned ldsdst) {
    asm volatile("s_mov_b32 m0, %2\n\ts_nop 0\n\tglobal_load_lds_dwordx4 %0, %1" : : "v"(voff), "s"(sbase), "s"(ldsdst) : "memory", "m0");
}
__device__ __forceinline__ const char* uniform_ptr(const char* p) { const unsigned long v = (unsigned long)p;
    const unsigned lo = __builtin_amdgcn_readfirstlane((unsigned)v), hi = __builtin_amdgcn_readfirstlane((unsigned)(v >> 32)); return (const char*)(((unsigned long)hi << 32) | lo); }
template <class Epi, class Prob>
__device__ __forceinline__ void gemm_phase(LAS unsigned char* lds, const Prob& P, const Epi& E, int wave) {
    int lane = lane_id(); asm volatile("" : "+v"(lane));
    const int wid = wave, tid = wave * 64 + lane, wr = wid >> 2, wc = wid & 3, fr = lane & 15, fq = lane >> 4;
    constexpr int ESZ = Prob::FP8 ? 1 : 2;
    const int K = P.K, nt = K * ESZ / 128;
    unsigned voffA, voffB;
    { int R, C; stage_rc(tid * 16, R, C); const int Rb = Epi::PERM ? ((R & ~31) + perm32(R & 31)) : R;
      voffA = (unsigned)(R * P.lda * ESZ + 2 * C); voffB = (unsigned)(Rb * P.ldb * ESZ + 2 * C); }
    const size_t r64A = (size_t)64 * P.lda * ESZ, r64B = (size_t)64 * P.ldb * ESZ;
    const unsigned ldsbase = (unsigned)(unsigned long)lds;
    const size_t kstep = (size_t)(BK * 2);
    const size_t hA = (size_t)HALF * P.lda * ESZ, hB = (size_t)HALF * P.ldb * ESZ;
    const unsigned ldsw = (unsigned)wid * 1024u;
    int aoff = lds_byte(wr * 64 + fr, fq * 8), boff = lds_byte(wc * 32 + fr, fq * 8) + 4 * HTB; asm volatile("" : "+v"(aoff), "+v"(boff));
    const LAS unsigned char* la = lds + aoff; const LAS unsigned char* lb = lds + boff;
#define PG8_SA(b, h) (((b) * 2 + (h)) * HTB)
#define PG8_SB(b, h) ((4 + (b) * 2 + (h)) * HTB)
#define PG8_STAGE(bufoff, gbase, AB) do { glds_s((const char*)(gbase), voff##AB, ldsbase + (bufoff) + ldsw); glds_s((const char*)(gbase) + r64##AB, voff##AB, ldsbase + (bufoff) + ldsw + 8192u); } while (0)
#define PG8_LDA(dst, b, h) do { _Pragma("unroll") for (int m = 0; m < 4; ++m) { dst[m].lo = *(const LAS i32x4*)(la + PG8_SA(b, h) + m * 2048); dst[m].hi = *(const LAS i32x4*)(la + PG8_SA(b, h) + m * 2048 + 1024); } } while (0)
#define PG8_LDB(dst, b, h) do { _Pragma("unroll") for (int n = 0; n < 2; ++n) { dst[n].lo = *(const LAS i32x4*)(lb + (PG8_SB(b, h) - 4 * HTB) + n * 2048); dst[n].hi = *(const LAS i32x4*)(lb + (PG8_SB(b, h) - 4 * HTB) + n * 2048 + 1024); } } while (0)
#define PG8_MMA(ai, bj, At, Bt) do { __builtin_amdgcn_s_setprio(1); _Pragma("unroll") for (int m = 0; m < 4; ++m) _Pragma("unroll") for (int n = 0; n < 2; ++n) { \
        if constexpr (Prob::FP8) acc[ai][bj][m][n] = __builtin_amdgcn_mfma_scale_f32_16x16x128_f8f6f4(Bt[n], At[m], acc[ai][bj][m][n], 0, 0, 0, 0x7f7f7f7f, 0, 0x7f7f7f7f); \
        else { acc[ai][bj][m][n] = __builtin_amdgcn_mfma_f32_16x16x32_bf16(as_bf16(Bt[n].lo), as_bf16(At[m].lo), acc[ai][bj][m][n], 0, 0, 0); \
               acc[ai][bj][m][n] = __builtin_amdgcn_mfma_f32_16x16x32_bf16(as_bf16(Bt[n].hi), as_bf16(At[m].hi), acc[ai][bj][m][n], 0, 0, 0); } } \
        __builtin_amdgcn_s_setprio(0); } while (0)
#define PG8_WAIT_V(n) asm volatile("s_waitcnt vmcnt(" #n ")" ::: "memory")
#define PG8_WAIT_L(n) asm volatile("s_waitcnt lgkmcnt(" #n ")" ::: "memory")
#define PG8_BAR __builtin_amdgcn_s_barrier()
#define PG8_SCHED __builtin_amdgcn_sched_barrier(0)
    Unit cur, nxt; int ui = 0;
    if (!P.next(0, cur)) return;
    f32x4 acc[2][2][4][2];
#pragma unroll
    for (int a = 0; a < 2; ++a)
#pragma unroll
        for (int b = 0; b < 2; ++b)
#pragma unroll
            for (int m = 0; m < 4; ++m)
#pragma unroll
                for (int n = 0; n < 2; ++n) acc[a][b][m][n] = (f32x4){0.f, 0.f, 0.f, 0.f};
    i32x8 At[4], B0[2], B1[2];
    const char* cA = uniform_ptr(P.abase(cur)); const char* cB = uniform_ptr(P.bbase(cur));
    PG8_STAGE(PG8_SB(0, 0), cB, B); PG8_STAGE(PG8_SB(0, 1), cB + hB, B); PG8_STAGE(PG8_SA(0, 0), cA, A); PG8_STAGE(PG8_SA(0, 1), cA + hA, A);
    if (wr == 1) PG8_BAR;
    PG8_WAIT_V(2); PG8_BAR;
    PG8_STAGE(PG8_SB(1, 0), cB + kstep, B); PG8_STAGE(PG8_SA(1, 0), cA + kstep, A); PG8_STAGE(PG8_SB(1, 1), cB + hB + kstep, B);
    PG8_WAIT_V(6); PG8_BAR;
    for (;;) {
        const bool has_next = P.next(ui + 1, nxt);
        const char* nA = uniform_ptr(has_next ? P.abase(nxt) : cA); const char* nB = uniform_ptr(has_next ? P.bbase(nxt) : cB);
        int tb = 0;
        for (int seg = 0; seg < (Epi::MID ? 3 : 1); ++seg) {
        int te = nt; if constexpr (Epi::MID) { te = seg == 0 ? Epi::T1 : (seg == 1 ? Epi::T2 : nt); }
        for (int t = tb; t < te; t += 2) {
            const bool last = (t == nt - 2);
            const char* a1 = cA + (size_t)(t + 1) * kstep;
            const char* a2 = last ? nA : cA + (size_t)(t + 2) * kstep; const char* b2 = last ? nB : cB + (size_t)(t + 2) * kstep;
            const char* a3 = a2 + kstep; const char* b3 = b2 + kstep;
            PG8_LDB(B0, 0, 0); PG8_LDB(B1, 0, 1); PG8_SCHED; PG8_LDA(At, 0, 0); PG8_STAGE(PG8_SA(1, 1), a1 + hA, A);
            PG8_WAIT_V(8); PG8_WAIT_L(0); PG8_BAR; PG8_MMA(0, 0, At, B0); PG8_MMA(0, 1, At, B1); PG8_BAR; PG8_SCHED;
            PG8_LDA(At, 0, 1); PG8_STAGE(PG8_SB(0, 0), b2, B); PG8_STAGE(PG8_SB(0, 1), b2 + hB, B); PG8_STAGE(PG8_SA(0, 0), a2, A);
            PG8_WAIT_V(8); PG8_WAIT_L(0); PG8_BAR; PG8_MMA(1, 0, At, B0); PG8_MMA(1, 1, At, B1); PG8_BAR; PG8_SCHED;
            PG8_LDB(B0, 1, 0); PG8_LDB(B1, 1, 1); PG8_SCHED; PG8_LDA(At, 1, 0); PG8_STAGE(PG8_SA(0, 1), a2 + hA, A);
            PG8_WAIT_V(8); PG8_WAIT_L(0); PG8_BAR; PG8_MMA(0, 0, At, B0); PG8_MMA(0, 1, At, B1); PG8_BAR; PG8_SCHED;
            PG8_LDA(At, 1, 1); PG8_STAGE(PG8_SB(1, 0), b3, B); PG8_STAGE(PG8_SB(1, 1), b3 + hB, B); PG8_STAGE(PG8_SA(1, 0), a3, A);
            PG8_WAIT_V(8); PG8_WAIT_L(0); PG8_BAR; PG8_MMA(1, 0, At, B0); PG8_MMA(1, 1, At, B1); PG8_BAR; PG8_SCHED;
        }
        if constexpr (Epi::MID) { if (seg < 2) E.mid(acc, cur, wr, fr, seg); }
        tb = te;
        }
        if (wr == 0) PG8_BAR;
        { int frx = fr, fqx = fq; asm volatile("" : "+v"(frx), "+v"(fqx));
          E(acc, cur, wr, wc, frx, fqx); }
        if (!has_next) break;
#pragma unroll
        for (int a = 0; a < 2; ++a)
#pragma unroll
            for (int b = 0; b < 2; ++b)
#pragma unroll
                for (int m = 0; m < 4; ++m)
#pragma unroll
                    for (int n = 0; n < 2; ++n) acc[a][b][m][n] = (f32x4){0.f, 0.f, 0.f, 0.f};
        cur = nxt; cA = nA; cB = nB; ++ui;
        if (wr == 1) PG8_BAR;
    }
    PG8_WAIT_V(0);
    PG8_BAR;
#undef PG8_SA
#undef PG8_SB
#undef PG8_STAGE
#undef PG8_LDA
#undef PG8_LDB
#undef PG8_MMA
#undef PG8_WAIT_V
#undef PG8_WAIT_L
#undef PG8_BAR
#undef PG8_SCHED
}
}
using pg8::Unit; using pg8::glds_s; using pg8::uniform_ptr;

template <bool FP8_ = false> struct ProbPlainT {
    static constexpr bool FP8 = FP8_;
    const void* A; const void* Bt; int K, lda, ldb, nM, nN, G, c;
    __device__ __forceinline__ bool next(int i, Unit& u) const { return pg8::static_unit(i * G + c, nM, nN, u); }
    __device__ __forceinline__ const char* abase(const Unit& u) const { return (const char*)A + (size_t)u.pm * 256 * lda * (FP8 ? 1 : 2); }
    __device__ __forceinline__ const char* bbase(const Unit& u) const { return (const char*)Bt + (size_t)u.pn * 256 * ldb * (FP8 ? 1 : 2); }
};
typedef ProbPlainT<false> ProbPlain;
typedef ProbPlainT<true> ProbPlain8;

struct Args { const float* in[39]; float* out; unsigned char* ws; int ph_lo, ph_hi; };
static_assert(sizeof(Args) == 39 * 8 + 8 + 8 + 8, "no padding in Args");
enum In { I_X = 0, I_N1G, I_WIN, I_QG, I_KG, I_SINK, I_RELB, I_MU, I_W0, I_W2, I_A0, I_A2, I_G2, I_KK, I_KA, I_RK, I_LNW, I_LNB,
          I_LRE, I_LIM, I_BRE, I_BIM, I_CRE, I_CIM, I_SD, I_DT, I_GLUW, I_GLUB, I_AOG, I_SOG, I_WOUT, I_N2G, I_F1, I_F3, I_F2, I_ROUTER, I_M1, I_M3, I_M2 };

struct Frame {
    LAS unsigned char* lds;
    int tid, lane, wave, G, bx;
    unsigned char* ws; float* out;
};

__device__ __forceinline__ Frame fresh(const Frame& F0) { Frame F = F0; int l = lane_id(); asm volatile("" : "+v"(l)); F.lane = l; F.tid = F0.wave * 64 + l; return F; }
__device__ __forceinline__ void transpose_item(const float* W, int N, bf16_t* WT, int ldt, int k0, int n0, int drow0, const float* gk, LAS float* scr, int lane, const float* gk2 = nullptr) {
#pragma unroll 8
    for (int i = 0; i < 32; ++i) { const int kk = 2 * i + (lane >> 5), k = k0 + kk; float w = W[(size_t)k * N + n0 + (lane & 31)];
        if (gk) w *= gk2 ? (k < 1024 ? gk[k] : (k < 1536 ? 1.0f : gk2[k - 1536])) : gk[k]; scr[kk * 33 + (lane & 31)] = w; }
    LDS_WAIT(); asm volatile("" ::: "memory");
    const int c = lane & 7;
#pragma unroll
    for (int j = 0; j < 4; ++j) { const int n = (lane >> 3) + 8 * j; const LAS float* s = scr + (8 * c) * 33 + n;
        u32x4 o; o.x = pk2(s[0 * 33], s[1 * 33]); o.y = pk2(s[2 * 33], s[3 * 33]); o.z = pk2(s[4 * 33], s[5 * 33]); o.w = pk2(s[6 * 33], s[7 * 33]);
        *(u32x4*)(WT + (size_t)(drow0 + n) * ldt + k0 + 8 * c) = o; }
    LDS_WAIT(); asm volatile("" ::: "memory");
}
__device__ __forceinline__ void cvt8_load(const float* W, int N, int k0, int n0, int lane, f32x4 (&v)[8]) {
    const float* p = W + (size_t)(k0 + (lane >> 3)) * N + n0 + 4 * (lane & 7);
#pragma unroll
    for (int i = 0; i < 8; ++i) v[i] = __builtin_nontemporal_load((const f32x4*)(p + (size_t)(8 * i) * N));
}
__device__ __forceinline__ void cvt8_finish(const f32x4 (&v)[8], unsigned char* WT, int ldt, int k0, int drow0, const float* gk, float wsc, LAS float* scr, int lane) {
    const int r = lane >> 3, c4 = 4 * (lane & 7);
#pragma unroll
    for (int i = 0; i < 8; ++i) { const int kk = 8 * i + r; float sc = wsc; if (gk) sc *= gk[k0 + kk];
        LAS float* d = scr + kk * 33 + c4; d[0] = v[i].x * sc; d[1] = v[i].y * sc; d[2] = v[i].z * sc; d[3] = v[i].w * sc; }
    LDS_WAIT(); asm volatile("" ::: "memory");
    const int c = lane & 3;
#pragma unroll
    for (int j = 0; j < 2; ++j) { const int n = (lane >> 2) + 16 * j; const LAS float* s = scr + (16 * c) * 33 + n;
        u32x4 o; o.x = pk8(s[0 * 33], s[1 * 33], s[2 * 33], s[3 * 33]); o.y = pk8(s[4 * 33], s[5 * 33], s[6 * 33], s[7 * 33]); o.z = pk8(s[8 * 33], s[9 * 33], s[10 * 33], s[11 * 33]); o.w = pk8(s[12 * 33], s[13 * 33], s[14 * 33], s[15 * 33]);
        *(u32x4*)(WT + (size_t)(drow0 + n) * ldt + k0 + 16 * c) = o; }
    LDS_WAIT(); asm volatile("" ::: "memory");
}
__device__ __forceinline__ void transpose_item8(const float* W, int N, unsigned char* WT, int ldt, int k0, int n0, int drow0, const float* gk, float wsc, LAS float* scr, int lane) {
    f32x4 v[8]; cvt8_load(W, N, k0, n0, lane, v); cvt8_finish(v, WT, ldt, k0, drow0, gk, wsc, scr, lane);
}
__device__ __forceinline__ void transpose_matrix8(const Frame& F, const float* W, int K, int N, unsigned char* WT, int ldt, const float* gk, float wsc, int mode) {
    LAS float* scr = (LAS float*)(F.lds + F.wave * 16384);
    const int gw = F.bx * NWAVES + F.wave, NGW = F.G * NWAVES, nblk = N / 32, nitems = (K / 64) * nblk;
    for (int it = gw; it < nitems; it += NGW) {
        const int kb = it / nblk, nb = it % nblk, n0 = 32 * nb;
        const int drow0 = mode == 0 ? n0 : (n0 >> 7) * 256 + (n0 & 127) + (mode == 2 ? 128 : 0);
        transpose_item8(W, N, WT, ldt, 64 * kb, n0, drow0, gk, wsc, scr, F.lane);
    }
}
__device__ __forceinline__ void transpose_matrix(const Frame& F, const float* W, int K, int N, bf16_t* WT, int ldt, const float* gk, int mode, const float* gk2 = nullptr) {
    LAS float* scr = (LAS float*)(F.lds + F.wave * 16384);
    const int gw = F.bx * NWAVES + F.wave, NGW = F.G * NWAVES, nblk = N / 32, nitems = (K / 64) * nblk;
    for (int it = gw; it < nitems; it += NGW) {
        const int kb = it / nblk, nb = it % nblk, n0 = 32 * nb;
        const int drow0 = mode == 0 ? n0 : (n0 >> 7) * 256 + (n0 & 127) + (mode == 2 ? 128 : 0);
        transpose_item(W, N, WT, ldt, 64 * kb, n0, drow0, gk, scr, F.lane, gk2);
    }
}

constexpr int MOE_ITEMS = NEXP * 3 * 7168;
struct MoeItem { const float* W; unsigned char* WT; const float* gk; float wsc; int N, ldt, k0, n0, drow0; };
__device__ __forceinline__ MoeItem moe_item(const CAS Args& a, unsigned char* ws, int I) {
    MoeItem m; const int e = I / 21504, r = I - e * 21504, mat = r / 7168, it = r - mat * 7168;
    if (mat < 2) { const int nblk = DFFE / 32, kb = it / nblk, n0 = 32 * (it % nblk);
        m.W = (mat == 0 ? a.in[I_M1] : a.in[I_M3]) + (size_t)e * D * DFFE; m.N = DFFE; m.WT = ws + OFF_WM13 + (size_t)e * 2 * DFFE * D; m.ldt = D; m.k0 = 64 * kb; m.n0 = n0;
        m.drow0 = (n0 >> 7) * 256 + (n0 & 127) + (mat == 1 ? 128 : 0); m.gk = a.in[I_N2G] + D; m.wsc = SC_W13; }
    else { const int nblk = D / 32, kb = it / nblk, n0 = 32 * (it % nblk);
        m.W = a.in[I_M2] + (size_t)e * DFFE * D; m.N = D; m.WT = ws + OFF_WM2 + (size_t)e * D * DFFE; m.ldt = DFFE; m.k0 = 64 * kb; m.n0 = n0; m.drow0 = n0; m.gk = nullptr; m.wsc = SC_W2; }
    return m;
}
__device__ __forceinline__ void moe_convert_range(const Frame& F, const CAS Args& a, int i0, int i1, int wg0, int nwg) {
    if (F.bx < wg0 || F.bx >= wg0 + nwg) return;
    LAS float* scr = (LAS float*)(F.lds + F.wave * 16384);
    const int step = nwg * NWAVES;
    int I = i0 + (F.bx - wg0) * NWAVES + F.wave;
    if (I >= i1) return;
    MoeItem cur = moe_item(a, F.ws, I); f32x4 v[8]; cvt8_load(cur.W, cur.N, cur.k0, cur.n0, F.lane, v);
    for (;;) {
        const int In = I + step; const bool more = In < i1;
        MoeItem nxt = cur; f32x4 w[8];
        if (more) { nxt = moe_item(a, F.ws, In); cvt8_load(nxt.W, nxt.N, nxt.k0, nxt.n0, F.lane, w); }
        cvt8_finish(v, cur.WT, cur.ldt, cur.k0, cur.drow0, cur.gk, cur.wsc, scr, F.lane);
        if (!more) break;
        cur = nxt; I = In;
#pragma unroll
        for (int i = 0; i < 8; ++i) v[i] = w[i];
    }
}
constexpr int MOE_EARLY = 42000;
constexpr int MOE_TAIL = 12288;
__device__ __forceinline__ void phase_prologue(const Frame& F, const CAS Args& a) {
    unsigned char* ws = F.ws;
    { unsigned long long* ss = (unsigned long long*)(ws + OFF_SS); for (size_t i = (size_t)F.bx * NTHREADS + F.tid; i < 8 * (size_t)T; i += (size_t)F.G * NTHREADS) if (i >= (size_t)T) ss[i] = 0ull; }
    for (int l = 0; l < 2; ++l) {
        transpose_matrix(F, a.in[I_WIN] + (size_t)l * D * IN_COLS, D, IN_COLS, (bf16_t*)(ws + OFF_WIN + l * SZ_WIN), D, a.in[I_N1G] + l * D, 0);
        transpose_matrix(F, a.in[I_WOUT] + (size_t)l * D * D, D, D, (bf16_t*)(ws + OFF_WOUT + l * SZ_WOUT), D, a.in[I_AOG] + l * ATT_W, 0, a.in[I_SOG] + l * SS_W);
        transpose_matrix(F, a.in[I_GLUW] + (size_t)l * 512 * 512, 512, 512, (bf16_t*)(ws + OFF_WGLU + l * SZ_WGLU), 512, nullptr, 0);
    }
    if constexpr (FFN_FP8 & 1) { transpose_matrix8(F, a.in[I_F1], D, DFF, ws + OFF_W13, D, a.in[I_N2G], SC_W13, 1); transpose_matrix8(F, a.in[I_F3], D, DFF, ws + OFF_W13, D, a.in[I_N2G], SC_W13, 2); }
    else { transpose_matrix(F, a.in[I_F1], D, DFF, (bf16_t*)(ws + OFF_W13), D, a.in[I_N2G], 1); transpose_matrix(F, a.in[I_F3], D, DFF, (bf16_t*)(ws + OFF_W13), D, a.in[I_N2G], 2); }
    if constexpr (FFN_FP8 & 2) transpose_matrix8(F, a.in[I_F2], DFF, D, ws + OFF_W2, DFF, nullptr, SC_W2, 0);
    else transpose_matrix(F, a.in[I_F2], DFF, D, (bf16_t*)(ws + OFF_W2), DFF, nullptr, 0);
    for (int l = 0; l < 2; ++l) {
        bf16_t* bc = (bf16_t*)(ws + OFF_BCAT + l * SZ_BCAT);
        const float* w2 = a.in[I_W2] + (size_t)l * 64 * 512; const float* a2 = a.in[I_A2] + (size_t)l * 64 * 512; const float* g2 = a.in[I_G2] + (size_t)l * 128 * 512;
        for (int i = F.bx * NTHREADS + F.tid; i < 1536 * 256; i += F.G * NTHREADS) {
            const int n = i >> 8, k = i & 255, blk = n >> 9, nn = n & 511; float v = 0.f;
            if (blk == 0 && k < 64) v = w2[k * 512 + nn];
            else if (blk == 1 && k >= 64 && k < 128) v = a2[(k - 64) * 512 + nn];
            else if (blk == 2 && k >= 128) v = g2[(k - 128) * 512 + nn];
            bc[i] = (bf16_t)f2bf(v);
        }
    }
    { const float* x = a.in[I_X]; bf16_t* xb = (bf16_t*)(ws + OFF_XB); unsigned long long* ss0 = (unsigned long long*)(ws + OFF_SS);
      const int gw = F.bx * NWAVES + F.wave, NGW = F.G * NWAVES;
      for (int m = gw; m < T; m += NGW) {
          const f32x4* xr = (const f32x4*)(x + (size_t)m * D) + F.lane; u32x2* o8 = (u32x2*)(xb + (size_t)m * D) + F.lane; float s = 0.f;
#pragma unroll
          for (int j = 0; j < 8; ++j) { const f32x4 v = __builtin_nontemporal_load(xr + 64 * j); s += (v.x * v.x + v.y * v.y) + (v.z * v.z + v.w * v.w); u32x2 w; w.x = pk2(v.x, v.y); w.y = pk2(v.z, v.w); o8[64 * j] = w; }
          s = wave_sum(s); if (F.lane == 0) ss0[m] = ss_fix(s);
      } }
}

struct EpiInProj {
    static constexpr bool PERM = true, MID = false;
    const unsigned long long* ssq; bf16_t* zatt; bf16_t* zrw; bf16_t* uext;
    __device__ __forceinline__ void operator()(const f32x4 (&acc)[2][2][4][2], const Unit& u, int wr, int wc, int fr, int fq) const {
        const int row0 = u.pm * 256 + wr * 64 + fr, colt = wc * 32 + 8 * fq;
        float rsv[2][4];
#pragma unroll
        for (int ai = 0; ai < 2; ++ai)
#pragma unroll
            for (int m = 0; m < 4; ++m) rsv[ai][m] = ss_rs(ssq[row0 + ai * 128 + m * 16]);
#pragma unroll
        for (int ai = 0; ai < 2; ++ai)
#pragma unroll
            for (int m = 0; m < 4; ++m) {
                const int row = row0 + ai * 128 + m * 16; const float rs = rsv[ai][m];
#pragma unroll
                for (int bj = 0; bj < 2; ++bj) {
                    const f32x4 v0 = acc[ai][bj][m][0] * rs, v1 = acc[ai][bj][m][1] * rs;
                    u32x4 w; w.x = cvt_pk_bf16(v0[0], v0[1]); w.y = cvt_pk_bf16(v0[2], v0[3]); w.z = cvt_pk_bf16(v1[0], v1[1]); w.w = cvt_pk_bf16(v1[2], v1[3]);
                    const int ct = bj * 128 + colt;
                    if (u.pn < 6) *(u32x4*)(zatt + (size_t)row * ZATT_W + u.pn * 256 + ct) = w;
                    else if (u.pn < 13) *(u32x4*)(zrw + (size_t)row * RW_COLS + (u.pn - 6) * 256 + ct) = w;
                    else { const int ch = (u.pn - 13) * 256 + ct, g = ch >> 4, half = (ch >> 3) & 1;
                           *(u32x4*)(uext + ((size_t)(g * 512 + (row >> 6)) * S5K + (row & 63) * 16 + half * 8)) = w; }
                }
            }
    }
};

template <bool OUT8, bool MIX = false, bool H16IN = true, bool COPY = true> struct EpiResid {
    static constexpr bool PERM = true, MID = MIX; static constexpr int T1 = 16, T2 = 24;
    const void* hold; bf16_t* hnew; void* xb; unsigned long long* ssq; float asc; const unsigned long long* ssA; const unsigned long long* ssS;
    __device__ __forceinline__ void mid(f32x4 (&acc)[2][2][4][2], const Unit& u, int wr, int fr, int which) const {
        const int row0 = u.pm * 256 + wr * 64 + fr; float f[2][4];
#pragma unroll
        for (int ai = 0; ai < 2; ++ai)
#pragma unroll
            for (int m = 0; m < 4; ++m) { const int row = row0 + ai * 128 + m * 16; f[ai][m] = which == 0 ? rsqrtf(ss_mean(ssA[row], 1.0f / ATT_W)) : sqrtf(ss_mean(ssS[row], 1.0f / SS_W)); }
#pragma unroll
        for (int ai = 0; ai < 2; ++ai)
#pragma unroll
            for (int bj = 0; bj < 2; ++bj)
#pragma unroll
                for (int m = 0; m < 4; ++m)
#pragma unroll
                    for (int n = 0; n < 2; ++n) acc[ai][bj][m][n] *= f[ai][m];
    }
    __device__ __forceinline__ void operator()(const f32x4 (&acc)[2][2][4][2], const Unit& u, int wr, int wc, int fr, int fq) const {
        const int row0 = u.pm * 256 + wr * 64 + fr, col0 = u.pn * 256 + wc * 32 + 8 * fq;
#pragma unroll
        for (int ai = 0; ai < 2; ++ai) {
            f32x4 hv[4][2][2];
#pragma unroll
            for (int m = 0; m < 4; ++m)
#pragma unroll
                for (int bj = 0; bj < 2; ++bj) { const size_t off = (size_t)(row0 + ai * 128 + m * 16) * D + col0 + bj * 128;
                    if constexpr (H16IN) { const u32x4 hb = *(const u32x4*)((const bf16_t*)hold + off);
                        hv[m][bj][0] = (f32x4){bflo(hb.x), bfhi(hb.x), bflo(hb.y), bfhi(hb.y)}; hv[m][bj][1] = (f32x4){bflo(hb.z), bfhi(hb.z), bflo(hb.w), bfhi(hb.w)}; }
                    else { hv[m][bj][0] = *(const f32x4*)((const float*)hold + off); hv[m][bj][1] = *(const f32x4*)((const float*)hold + off + 4); } }
#pragma unroll
            for (int m = 0; m < 4; ++m) {
                const int row = row0 + ai * 128 + m * 16; float s = 0.f; const float sc = MIX ? asc * rsqrtf(ss_mean(ssS[row], 1.0f / SS_W)) : asc;
#pragma unroll
                for (int bj = 0; bj < 2; ++bj) {
                    const size_t off = (size_t)row * D + col0 + bj * 128;
                    const f32x4 v0 = acc[ai][bj][m][0] * sc + hv[m][bj][0], v1 = acc[ai][bj][m][1] * sc + hv[m][bj][1];
                    { u32x4 w; w.x = cvt_pk_bf16(v0[0], v0[1]); w.y = cvt_pk_bf16(v0[2], v0[3]); w.z = cvt_pk_bf16(v1[0], v1[1]); w.w = cvt_pk_bf16(v1[2], v1[3]);
                      *(u32x4*)(hnew + off) = w; }
                    if constexpr (COPY && OUT8) { u32x2 w; w.x = pk8(clamp8(v0[0] * SC_H), clamp8(v0[1] * SC_H), clamp8(v0[2] * SC_H), clamp8(v0[3] * SC_H)); w.y = pk8(clamp8(v1[0] * SC_H), clamp8(v1[1] * SC_H), clamp8(v1[2] * SC_H), clamp8(v1[3] * SC_H));
                        *(u32x2*)((unsigned char*)xb + off) = w; }
                    else if constexpr (COPY) { u32x4 w; w.x = cvt_pk_bf16(v0[0], v0[1]); w.y = cvt_pk_bf16(v0[2], v0[3]); w.z = cvt_pk_bf16(v1[0], v1[1]); w.w = cvt_pk_bf16(v1[2], v1[3]);
                        *(u32x4*)((bf16_t*)xb + off) = w; }
                    s += (v0[0] * v0[0] + v0[1] * v0[1]) + (v0[2] * v0[2] + v0[3] * v0[3]) + (v1[0] * v1[0] + v1[1] * v1[1]) + (v1[2] * v1[2] + v1[3] * v1[3]);
                }
                s += __shfl_xor(s, 16); s += __shfl_xor(s, 32);
                if (fq == 0) atomicAdd(ssq + row, ss_fix(s));
            }
            asm volatile("" ::: "memory");
        }
    }
};

constexpr int AT_KN = 0, AT_KROW = 72;
constexpr int AT_VT = 256 * AT_KROW * 2, AT_VROW = 264;
constexpr int AT_TB = AT_VT + 64 * AT_VROW * 2;
__device__ __forceinline__ int t5_bucket(int d) {
    if (d < 16) return d;
    int lg = 16 + (int)(logf((float)d / 16.0f) / 2.0794415416798357f * 16.0f);
    return lg < 31 ? lg : 31;
}
__device__ __forceinline__ void phase_attention(const Frame& F, const CAS Args& a, int layer) {
    const bf16_t* zatt = (const bf16_t*)(F.ws + MO(B_ZATT)); bf16_t* mixed = (bf16_t*)(F.ws + MO(B_MIXED));
    unsigned long long* ssA = (unsigned long long*)(F.ws + OFF_SS) + (size_t)(4 + 2 * layer) * T;
    const float* qg = a.in[I_QG] + layer * 64; const float* kg = a.in[I_KG] + layer * 64; const float* sinks = a.in[I_SINK] + layer * 16; const float* relb = a.in[I_RELB];
    LAS bf16_t* Kn = (LAS bf16_t*)(F.lds + AT_KN); LAS bf16_t* Vt = (LAS bf16_t*)(F.lds + AT_VT); LAS float* tb = (LAS float*)(F.lds + AT_TB);
    const int lane = F.lane, qi = lane & 15, q4 = lane >> 4;
    for (int unit = F.bx; unit < 1024; unit += F.G) {
        const int kvh = unit & 3, n = (unit >> 2) & 127, b = unit >> 9;
        __syncthreads();
        {
            const int key = F.tid >> 1, half = F.tid & 1, tk = (n - 1) * 128 + key; const bool valid = tk >= 0;
            const size_t row = (size_t)b * SEQ + (valid ? tk : 0);
            const u32x4* kp = (const u32x4*)(zatt + row * ZATT_W + ATT_W + kvh * 64 + half * 32);
            const u32x4* vp = (const u32x4*)(zatt + row * ZATT_W + ATT_W + KV_W + kvh * 64 + half * 32);
            u32x4 kr[4], vr[4];
#pragma unroll
            for (int i = 0; i < 4; ++i) { kr[i] = kp[i]; vr[i] = vp[i]; }
            float kf[32]; float ss = 0.f;
#pragma unroll
            for (int i = 0; i < 4; ++i) { const unsigned w[4] = {kr[i].x, kr[i].y, kr[i].z, kr[i].w};
#pragma unroll
                for (int j = 0; j < 4; ++j) { const float lo = bflo(w[j]), hi = bfhi(w[j]); kf[i * 8 + 2 * j] = lo; kf[i * 8 + 2 * j + 1] = hi; ss += lo * lo + hi * hi; } }
            ss += __shfl_xor(ss, 1);
            const float rs = valid ? rsqrtf(ss * (1.0f / 64.0f) + NORM_EPS) : 0.f;
#pragma unroll
            for (int i = 0; i < 4; ++i) { u32x4 o;
                o.x = pk2(kf[i * 8 + 0] * rs * kg[half * 32 + i * 8 + 0], kf[i * 8 + 1] * rs * kg[half * 32 + i * 8 + 1]);
                o.y = pk2(kf[i * 8 + 2] * rs * kg[half * 32 + i * 8 + 2], kf[i * 8 + 3] * rs * kg[half * 32 + i * 8 + 3]);
                o.z = pk2(kf[i * 8 + 4] * rs * kg[half * 32 + i * 8 + 4], kf[i * 8 + 5] * rs * kg[half * 32 + i * 8 + 5]);
                o.w = pk2(kf[i * 8 + 6] * rs * kg[half * 32 + i * 8 + 6], kf[i * 8 + 7] * rs * kg[half * 32 + i * 8 + 7]);
                *(LAS u32x4*)(Kn + key * AT_KROW + half * 32 + i * 8) = o; }
#pragma unroll
            for (int i = 0; i < 4; ++i) { const unsigned w[4] = {vr[i].x, vr[i].y, vr[i].z, vr[i].w};
#pragma unroll
                for (int j = 0; j < 4; ++j) { const int d = half * 32 + i * 8 + 2 * j;
                    Vt[d * AT_VROW + key] = valid ? (bf16_t)(w[j] & 0xffffu) : (bf16_t)0; Vt[(d + 1) * AT_VROW + key] = valid ? (bf16_t)(w[j] >> 16) : (bf16_t)0; } }
            const int g = F.tid >> 7, dist = F.tid & 127;
            tb[g * 128 + dist] = relb[t5_bucket(dist) * 16 + kvh * 4 + g];
        }
        __syncthreads();
        for (int grp = F.wave; grp < 32; grp += NWAVES) {
            const int g = grp >> 3, qb = grp & 7, h = kvh * 4 + g, i0 = qb * 16;
            const size_t rowq = (size_t)b * SEQ + n * 128 + i0 + qi;
            bf16x8 qf[2];
            {   const u32x4 q0 = *(const u32x4*)(zatt + rowq * ZATT_W + h * 64 + q4 * 8), q1 = *(const u32x4*)(zatt + rowq * ZATT_W + h * 64 + 32 + q4 * 8);
                const unsigned w[8] = {q0.x, q0.y, q0.z, q0.w, q1.x, q1.y, q1.z, q1.w}; float qv[16]; float ss = 0.f;
#pragma unroll
                for (int j = 0; j < 8; ++j) { qv[2 * j] = bflo(w[j]); qv[2 * j + 1] = bfhi(w[j]); ss += qv[2 * j] * qv[2 * j] + qv[2 * j + 1] * qv[2 * j + 1]; }
                ss += __shfl_xor(ss, 16); ss += __shfl_xor(ss, 32);
                const float rs = rsqrtf(ss * (1.0f / 64.0f) + NORM_EPS) * 0.125f;
#pragma unroll
                for (int ks = 0; ks < 2; ++ks) { u32x4 o;
                    const float* gq = qg + ks * 32 + q4 * 8; const float* qq = qv + ks * 8;
                    o.x = pk2(qq[0] * rs * gq[0], qq[1] * rs * gq[1]); o.y = pk2(qq[2] * rs * gq[2], qq[3] * rs * gq[3]);
                    o.z = pk2(qq[4] * rs * gq[4], qq[5] * rs * gq[5]); o.w = pk2(qq[6] * rs * gq[6], qq[7] * rs * gq[7]);
                    qf[ks] = __builtin_bit_cast(bf16x8, o); }
            }
            f32x4 s[9];
#pragma unroll
            for (int kbi = 0; kbi < 9; ++kbi) {
                f32x4 c = (f32x4){0.f, 0.f, 0.f, 0.f};
#pragma unroll
                for (int ks = 0; ks < 2; ++ks) {
                    const bf16x8 kfr = *(const LAS bf16x8*)(Kn + (16 * (qb + kbi) + qi) * AT_KROW + ks * 32 + q4 * 8);
                    c = __builtin_amdgcn_mfma_f32_16x16x32_bf16(kfr, qf[ks], c, 0, 0, 0);
                }
                s[kbi] = c;
            }
            const float sink = sinks[h]; float mx = sink;
#pragma unroll
            for (int kbi = 0; kbi < 9; ++kbi)
#pragma unroll
                for (int r = 0; r < 4; ++r) {
                    const int j = 16 * (qb + kbi) + 4 * q4 + r, dist = 128 + i0 + qi - j;
                    const bool valid = dist >= 0 && dist < 128 && (n > 0 || j >= 128);
                    const float v = valid ? s[kbi][r] + tb[g * 128 + (dist & 127)] : -INFINITY;
                    s[kbi][r] = v; mx = fmaxf(mx, v);
                }
            mx = fmaxf(mx, __shfl_xor(mx, 16)); mx = fmaxf(mx, __shfl_xor(mx, 32));
            float sum = 0.f;
#pragma unroll
            for (int kbi = 0; kbi < 9; ++kbi)
#pragma unroll
                for (int r = 0; r < 4; ++r) { const float p = __expf(s[kbi][r] - mx); s[kbi][r] = p; sum += p; }
            sum += __shfl_xor(sum, 16); sum += __shfl_xor(sum, 32);
            const float inv = frcp(sum + __expf(sink - mx));
            bf16x8 pf[5];
#pragma unroll
            for (int pp = 0; pp < 5; ++pp) { u32x4 o; o.x = pk2(s[2 * pp][0], s[2 * pp][1]); o.y = pk2(s[2 * pp][2], s[2 * pp][3]);
                if (pp < 4) { o.z = pk2(s[2 * pp + 1][0], s[2 * pp + 1][1]); o.w = pk2(s[2 * pp + 1][2], s[2 * pp + 1][3]); } else { o.z = 0u; o.w = 0u; }
                pf[pp] = __builtin_bit_cast(bf16x8, o); }
            float osq = 0.f;
#pragma unroll
            for (int db = 0; db < 4; ++db) {
                f32x4 o = (f32x4){0.f, 0.f, 0.f, 0.f};
#pragma unroll
                for (int pp = 0; pp < 5; ++pp) {
                    const LAS bf16_t* vrow = Vt + (16 * db + qi) * AT_VROW + 4 * q4;
                    const u32x2 va = *(const LAS u32x2*)(vrow + 16 * (qb + 2 * pp));
                    const u32x2 vb = *(const LAS u32x2*)(vrow + 16 * (qb + (pp < 4 ? 2 * pp + 1 : 2 * pp)));
                    u32x4 vv; vv.x = va.x; vv.y = va.y; vv.z = vb.x; vv.w = vb.y;
                    o = __builtin_amdgcn_mfma_f32_16x16x32_bf16(__builtin_bit_cast(bf16x8, vv), pf[pp], o, 0, 0, 0);
                }
                o = o * inv; osq += (o[0] * o[0] + o[1] * o[1]) + (o[2] * o[2] + o[3] * o[3]);
                u32x2 w; w.x = pk2(o[0], o[1]); w.y = pk2(o[2], o[3]);
                *(u32x2*)(mixed + rowq * D + h * 64 + 16 * db + 4 * q4) = w;
            }
            osq += __shfl_xor(osq, 16); osq += __shfl_xor(osq, 32);
            if (q4 == 0) atomicAdd(ssA + rowq, ss_fix(osq));
        }
    }
}

__device__ __forceinline__ void phase_finalize_mixed(const Frame& F, const CAS Args& a, int layer, int dbg_zero) {
    const bf16_t* attraw = (const bf16_t*)(F.ws + MO(B_ATTRAW)); const bf16_t* ssraw = (const bf16_t*)(F.ws + MO(B_SSRAW)); bf16_t* mixed = (bf16_t*)(F.ws + MO(B_MIXED));
    const float* aog = a.in[I_AOG] + layer * ATT_W; const float* sog = a.in[I_SOG] + layer * SS_W;
    const int gw = F.bx * NWAVES + F.wave, NGW = F.G * NWAVES, lane = F.lane;
    for (int m = gw; m < T; m += NGW) {
        {   const u32x4* p = (const u32x4*)(attraw + (size_t)m * ATT_W) + lane * 2; const u32x4 v0 = p[0], v1 = p[1];
            const unsigned w[8] = {v0.x, v0.y, v0.z, v0.w, v1.x, v1.y, v1.z, v1.w}; float f[16]; float ss = 0.f;
#pragma unroll
            for (int j = 0; j < 8; ++j) { f[2 * j] = bflo(w[j]); f[2 * j + 1] = bfhi(w[j]); ss += f[2 * j] * f[2 * j] + f[2 * j + 1] * f[2 * j + 1]; }
            ss = wave_sum(ss); const float rs = rsqrtf(ss * (1.0f / ATT_W) + NORM_EPS); const float* g = aog + lane * 16;
            u32x4 o0, o1;
            o0.x = pk2(f[0] * rs * g[0], f[1] * rs * g[1]); o0.y = pk2(f[2] * rs * g[2], f[3] * rs * g[3]); o0.z = pk2(f[4] * rs * g[4], f[5] * rs * g[5]); o0.w = pk2(f[6] * rs * g[6], f[7] * rs * g[7]);
            o1.x = pk2(f[8] * rs * g[8], f[9] * rs * g[9]); o1.y = pk2(f[10] * rs * g[10], f[11] * rs * g[11]); o1.z = pk2(f[12] * rs * g[12], f[13] * rs * g[13]); o1.w = pk2(f[14] * rs * g[14], f[15] * rs * g[15]);
            u32x4* q = (u32x4*)(mixed + (size_t)m * D) + lane * 2; q[0] = o0; q[1] = o1; }
        {   const u32x4 v0 = *((const u32x4*)(ssraw + (size_t)m * SS_W) + lane);
            const unsigned w[4] = {v0.x, v0.y, v0.z, v0.w}; float f[8]; float ss = 0.f;
#pragma unroll
            for (int j = 0; j < 4; ++j) { f[2 * j] = bflo(w[j]); f[2 * j + 1] = bfhi(w[j]); ss += f[2 * j] * f[2 * j] + f[2 * j + 1] * f[2 * j + 1]; }
            ss = wave_sum(ss); const float rs = rsqrtf(ss * (1.0f / SS_W) + NORM_EPS); const float* g = sog + lane * 8;
            u32x4 o0; o0.x = pk2(f[0] * rs * g[0], f[1] * rs * g[1]); o0.y = pk2(f[2] * rs * g[2], f[3] * rs * g[3]); o0.z = pk2(f[4] * rs * g[4], f[5] * rs * g[5]); o0.w = pk2(f[6] * rs * g[6], f[7] * rs * g[7]);
            if (dbg_zero & 2) o0 = (u32x4){0u, 0u, 0u, 0u};
            *((u32x4*)(mixed + (size_t)m * D + 1536) + lane) = o0; }
        if (dbg_zero & 1) *((u32x4*)(mixed + (size_t)m * D + 1024) + lane) = (u32x4){0u, 0u, 0u, 0u};
    }
}

constexpr int S5L_PWR = 0, S5L_PWI = 65 * 64 * 4, S5L_BBR = 2 * 65 * 64 * 4, S5L_BBI = S5L_BBR + 4096, S5L_CR = S5L_BBI + 4096, S5L_CI = S5L_CR + 4096, S5L_KT = S5L_CI + 4096;
static_assert(S5L_KT + 64 * 256 * 4 <= RING_BYTES, "S5 build LDS");
__device__ __forceinline__ void phase_s5_build(const Frame& F, const CAS Args& a, int layer, int wg0, int nwg) {
    LAS float* pwr = (LAS float*)(F.lds + S5L_PWR); LAS float* pwi = (LAS float*)(F.lds + S5L_PWI);
    LAS float* bbr = (LAS float*)(F.lds + S5L_BBR); LAS float* bbi = (LAS float*)(F.lds + S5L_BBI);
    LAS float* cr = (LAS float*)(F.lds + S5L_CR); LAS float* ci = (LAS float*)(F.lds + S5L_CI); LAS float* kt = (LAS float*)(F.lds + S5L_KT);
    const int tid = F.tid;
    if (F.bx < wg0 || F.bx >= wg0 + nwg) return;
    for (int wi = F.bx - wg0; wi < 256; wi += nwg) {
        const int g = wi >> 3, part = wi & 7;
        __syncthreads();
        const int lg = layer * 32 + g;
        const float dt = expf(a.in[I_DT][lg]);
        {   const int p = tid & 63; const float lr = a.in[I_LRE][lg * 64 + p], li = a.in[I_LIM][lg * 64 + p];
            for (int tau = tid >> 6; tau <= 64; tau += 8) { const float mag = expf(lr * dt * (float)tau); float sn, cs; sincosf(li * dt * (float)tau, &sn, &cs); pwr[tau * 64 + p] = mag * cs; pwi[tau * 64 + p] = mag * sn; } }
        __syncthreads();
        for (int i = tid; i < 1024; i += NTHREADS) {
            const int p = i >> 4;
            const float lr = a.in[I_LRE][lg * 64 + p], li = a.in[I_LIM][lg * 64 + p], den = lr * lr + li * li;
            const float are = pwr[64 + p] - 1.0f, aim = pwi[64 + p];
            const float fr = (are * lr + aim * li) / den, fi = (aim * lr - are * li) / den;
            const float br = a.in[I_BRE][(size_t)lg * 1024 + i], bi = a.in[I_BIM][(size_t)lg * 1024 + i];
            bbr[i] = fr * br - fi * bi; bbi[i] = fr * bi + fi * br;
            cr[i] = a.in[I_CRE][(size_t)lg * 1024 + i]; ci[i] = a.in[I_CIM][(size_t)lg * 1024 + i];
        }
        __syncthreads();
        {
            const int mp = tid & 15, ml = (tid >> 4) & 1, m = 2 * part + ml, th = tid >> 5;
            float acc[4] = {0.f, 0.f, 0.f, 0.f};
            for (int p = 0; p < 64; ++p) {
                const float c_r = cr[m * 64 + p], c_i = ci[m * 64 + p], b_r = bbr[p * 16 + mp], b_i = bbi[p * 16 + mp];
                const float cbr = c_r * b_r - c_i * b_i, cbi = c_r * b_i + c_i * b_r;
#pragma unroll
                for (int j = 0; j < 4; ++j) { const int tau = 4 * th + j; acc[j] += pwr[tau * 64 + p] * cbr - pwi[tau * 64 + p] * cbi; }
            }
            if (th == 0 && m == mp) acc[0] += a.in[I_SD][layer * 512 + g * 16 + m];
#pragma unroll
            for (int j = 0; j < 4; ++j) kt[(4 * th + j) * 32 + ml * 16 + mp] = acc[j];
        }
        __syncthreads();
        bf16_t* B2 = (bf16_t*)(F.ws + OFF_S5B2) + (size_t)g * 1024 * S5K;
        for (int ch = tid; ch < 128 * 144; ch += NTHREADS) {
            const int nl = ch / 144, kc = ch % 144, t = nl >> 1, ml = nl & 1, m = 2 * part + ml, n = t * 16 + m; float v[8];
            if (kc < 128) { const int s = kc >> 1, m0 = (kc & 1) * 8;
#pragma unroll
                for (int j = 0; j < 8; ++j) v[j] = (s <= t) ? kt[(t - s) * 32 + ml * 16 + m0 + j] : 0.f; }
            else { const int p0 = (kc - 128) * 4;
#pragma unroll
                for (int j = 0; j < 4; ++j) { const int p = p0 + j; const float c_r = cr[m * 64 + p], c_i = ci[m * 64 + p], w_r = pwr[(t + 1) * 64 + p], w_i = pwi[(t + 1) * 64 + p];
                    v[2 * j] = c_r * w_r - c_i * w_i; v[2 * j + 1] = -(c_r * w_i + c_i * w_r); } }
            u32x4 o; o.x = pk2(v[0], v[1]); o.y = pk2(v[2], v[3]); o.z = pk2(v[4], v[5]); o.w = pk2(v[6], v[7]);
            *(u32x4*)(B2 + (size_t)n * S5K + kc * 8) = o;
        }
        bf16_t* E = (bf16_t*)(F.ws + OFF_S5E) + (size_t)g * 256 * 1024;
        for (int ch = part * 32 * 128 + tid; ch < (part + 1) * 32 * 128; ch += NTHREADS) {
            const int n = ch >> 7, kc = ch & 127, s = kc >> 1, m0 = (kc & 1) * 8; float v[8];
            if (n < 128) { const int p = n >> 1, ri = n & 1; const float w_r = pwr[(63 - s) * 64 + p], w_i = pwi[(63 - s) * 64 + p];
#pragma unroll
                for (int j = 0; j < 8; ++j) { const float b_r = bbr[p * 16 + m0 + j], b_i = bbi[p * 16 + m0 + j]; v[j] = ri == 0 ? (w_r * b_r - w_i * b_i) : (w_r * b_i + w_i * b_r); } }
            else {
#pragma unroll
                for (int j = 0; j < 8; ++j) v[j] = 0.f; }
            u32x4 o; o.x = pk2(v[0], v[1]); o.y = pk2(v[2], v[3]); o.z = pk2(v[4], v[5]); o.w = pk2(v[6], v[7]);
            *(u32x4*)(E + (size_t)n * 1024 + kc * 8) = o;
        }
    }
}
struct ProbS5a {
    static constexpr bool FP8 = false;
    const bf16_t* A; const bf16_t* Bt; int K, lda, ldb, G, c;
    __device__ __forceinline__ bool next(int i, Unit& u) const { const int L = i * G + c; if (L >= 64) return false; u.pm = L; u.pn = L >> 1; return true; }
    __device__ __forceinline__ const char* abase(const Unit& u) const { return (const char*)(A + (size_t)u.pm * 256 * lda); }
    __device__ __forceinline__ const char* bbase(const Unit& u) const { return (const char*)(Bt + (size_t)u.pn * 256 * ldb); }
};
struct EpiS5a {
    static constexpr bool PERM = false, MID = false;
    float* xloc;
    __device__ __forceinline__ void operator()(const f32x4 (&acc)[2][2][4][2], const Unit& u, int wr, int wc, int fr, int fq) const {
        const int row0 = u.pm * 256 + wr * 64 + fr, col0 = wc * 32 + 4 * fq;
#pragma unroll
        for (int ai = 0; ai < 2; ++ai)
#pragma unroll
            for (int m = 0; m < 4; ++m) { float* rp = xloc + (size_t)(row0 + ai * 128 + m * 16) * 128 + col0;
#pragma unroll
                for (int n = 0; n < 2; ++n) *(f32x4*)(rp + n * 16) = acc[ai][0][m][n]; }
    }
};
__device__ __forceinline__ void phase_s5_scan(const Frame& F, const CAS Args& a, int layer) {
    const int gt = F.bx * NTHREADS + F.tid; if (gt >= 4096) return;
    const int p = gt & 63, b = (gt >> 6) & 1, g = gt >> 7, lg = layer * 32 + g;
    const float dt = expf(a.in[I_DT][lg]), lr = a.in[I_LRE][lg * 64 + p], li = a.in[I_LIM][lg * 64 + p];
    const float mag = expf(lr * dt * 64.0f); float sn, cs; sincosf(li * dt * 64.0f, &sn, &cs); const float ar = mag * cs, ai = mag * sn;
    const float* xl = (const float*)(F.ws + MO(B_XLOC)) + (size_t)(g * 512 + b * 256) * 128 + 2 * p;
    unsigned* ux = (unsigned*)((bf16_t*)(F.ws + MO(B_UEXT)) + (size_t)(g * 512 + b * 256) * S5K + 1024 + 2 * p);
    float xr = 0.f, xi = 0.f;
    for (int cb = 0; cb < 256; cb += 32) {
        f32x2 l[32];
#pragma unroll
        for (int j = 0; j < 32; ++j) l[j] = *(const f32x2*)(xl + (size_t)(cb + j) * 128);
#pragma unroll
        for (int j = 0; j < 32; ++j) {
            ux[(size_t)(cb + j) * (S5K / 2)] = pk2(xr, xi);
            const float nr = ar * xr - ai * xi + l[j].x, ni = ar * xi + ai * xr + l[j].y; xr = nr; xi = ni;
        }
    }
}
struct ProbS5b {
    static constexpr bool FP8 = false;
    const bf16_t* A; const bf16_t* Bt; int K, lda, ldb, G, c;
    __device__ __forceinline__ bool next(int i, Unit& u) const { const int L = i * G + c; if (L < 0 || L >= 256) return false; u.pm = L >> 2; u.pn = (L >> 3) * 4 + (L & 3); return true; }
    __device__ __forceinline__ const char* abase(const Unit& u) const { return (const char*)(A + (size_t)u.pm * 256 * lda); }
    __device__ __forceinline__ const char* bbase(const Unit& u) const { return (const char*)(Bt + (size_t)u.pn * 256 * ldb); }
};
__device__ __forceinline__ float gelu_tanh(float x) { return x * frcp(1.0f + __builtin_amdgcn_exp2f(-2.3022082594043835f * (x + 0.044715f * x * x * x))); }
struct EpiS5b {
    static constexpr bool PERM = true, MID = false;
    bf16_t* zg;
    __device__ __forceinline__ void operator()(const f32x4 (&acc)[2][2][4][2], const Unit& u, int wr, int wc, int fr, int fq) const {
        const int row0 = u.pm * 256 + wr * 64 + fr, colt = (u.pn & 3) * 256 + wc * 32 + 8 * fq;
#pragma unroll
        for (int ai = 0; ai < 2; ++ai)
#pragma unroll
            for (int m = 0; m < 4; ++m) {
                const int rg = row0 + ai * 128 + m * 16, g = rg >> 9, bc = rg & 511;
#pragma unroll
                for (int bj = 0; bj < 2; ++bj) {
                    const int n = colt + bj * 128, t = n >> 4, m0 = n & 15; const size_t tok = (size_t)(bc >> 8) * SEQ + (bc & 255) * 64 + t;
                    const f32x4 v0 = acc[ai][bj][m][0], v1 = acc[ai][bj][m][1];
                    u32x4 w; w.x = pk2(gelu_tanh(v0[0]), gelu_tanh(v0[1])); w.y = pk2(gelu_tanh(v0[2]), gelu_tanh(v0[3])); w.z = pk2(gelu_tanh(v1[0]), gelu_tanh(v1[1])); w.w = pk2(gelu_tanh(v1[2]), gelu_tanh(v1[3]));
                    *(u32x4*)(zg + tok * 512 + g * 16 + m0) = w;
                }
            }
    }
};
struct EpiGlu {
    static constexpr bool PERM = true, MID = false;
    const bf16_t* zg; const float* glub; bf16_t* mixed; unsigned long long* ssS;
    __device__ __forceinline__ void operator()(const f32x4 (&acc)[2][2][4][2], const Unit& u, int wr, int wc, int fr, int fq) const {
        const int row0 = u.pm * 256 + wr * 64 + fr, col0 = u.pn * 256 + wc * 32 + 8 * fq;
#pragma unroll
        for (int ai = 0; ai < 2; ++ai)
#pragma unroll
            for (int m = 0; m < 4; ++m) {
                const size_t row = (size_t)(row0 + ai * 128 + m * 16); float sq = 0.f;
#pragma unroll
                for (int bj = 0; bj < 2; ++bj) {
                    const int n = col0 + bj * 128; const u32x4 z = *(const u32x4*)(zg + row * 512 + n);
                    const f32x4 b0 = *(const f32x4*)(glub + n), b1 = *(const f32x4*)(glub + n + 4);
                    const f32x4 v0 = acc[ai][bj][m][0] + b0, v1 = acc[ai][bj][m][1] + b1;
                    const float e0 = bflo(z.x) * sigmoidf_(v0[0]), e1 = bfhi(z.x) * sigmoidf_(v0[1]), e2 = bflo(z.y) * sigmoidf_(v0[2]), e3 = bfhi(z.y) * sigmoidf_(v0[3]);
                    const float e4 = bflo(z.z) * sigmoidf_(v1[0]), e5 = bfhi(z.z) * sigmoidf_(v1[1]), e6 = bflo(z.w) * sigmoidf_(v1[2]), e7 = bfhi(z.w) * sigmoidf_(v1[3]);
                    sq += (e0 * e0 + e1 * e1) + (e2 * e2 + e3 * e3) + (e4 * e4 + e5 * e5) + (e6 * e6 + e7 * e7);
                    u32x4 w; w.x = pk2(e0, e1); w.y = pk2(e2, e3); w.z = pk2(e4, e5); w.w = pk2(e6, e7);
                    *(u32x4*)(mixed + row * D + 1536 + n) = w;
                }
                sq += __shfl_xor(sq, 16); sq += __shfl_xor(sq, 32);
                if (fq == 0) atomicAdd(ssS + row, ss_fix(sq));
            }
    }
};

__device__ __forceinline__ void phase_rw_prep1(const Frame& F, const CAS Args& a, int layer) {
    const bf16_t* zrw = (const bf16_t*)(F.ws + MO(B_ZRW)); bf16_t* al = (bf16_t*)(F.ws + MO(B_ALORA)); const float* mu = a.in[I_MU] + layer * RW_COLS;
    const int lane = F.lane, gw = F.bx * NWAVES + F.wave, NGW = F.G * NWAVES;
    const int sc = lane < 16 ? 512 + 4 * lane : (lane < 32 ? 1600 + 4 * (lane - 16) : 1664 + 4 * (lane - 32));
    const f32x4 m4 = *(const f32x4*)(mu + sc);
    for (int row0 = gw; row0 < T; row0 += 4 * NGW) {
        u32x2 zc[4], zp[4];
#pragma unroll
        for (int u = 0; u < 4; ++u) { const int row = min(row0 + u * NGW, T - 1);
            zc[u] = *(const u32x2*)(zrw + (size_t)row * RW_COLS + sc);
            zp[u] = (u32x2){0u, 0u}; if ((row & (SEQ - 1)) != 0) zp[u] = *(const u32x2*)(zrw + (size_t)(row - 1) * RW_COLS + sc); }
#pragma unroll
        for (int u = 0; u < 4; ++u) { const int row = row0 + u * NGW; if (row >= T) break;
            float z[4] = {bflo(zc[u].x), bfhi(zc[u].x), bflo(zc[u].y), bfhi(zc[u].y)}; const float p[4] = {bflo(zp[u].x), bfhi(zp[u].x), bflo(zp[u].y), bfhi(zp[u].y)};
#pragma unroll
            for (int j = 0; j < 4; ++j) { float v = z[j] + m4[j] * (p[j] - z[j]); v = lane < 16 ? tanhf(v) : (lane < 32 ? v : sigmoidf_(v)); z[j] = v; }
            u32x2 o; o.x = pk2(z[0], z[1]); o.y = pk2(z[2], z[3]);
            *(u32x2*)(al + (size_t)row * 256 + 4 * lane) = o; }
    }
}
struct ProbLora {
    static constexpr bool FP8 = false;
    const bf16_t* A; const bf16_t* Bt; int K, lda, ldb, nM, nN, G, c;
    __device__ __forceinline__ bool next(int i, Unit& u) const { return pg8::static_unit(i * G + c, nM, nN, u); }
    __device__ __forceinline__ const char* abase(const Unit& u) const { return (const char*)(A + (size_t)u.pm * 256 * lda + (u.pn >= 4 ? 128 : 0)); }
    __device__ __forceinline__ const char* bbase(const Unit& u) const { return (const char*)(Bt + (size_t)u.pn * 256 * ldb + (u.pn >= 4 ? 128 : 0)); }
};
struct EpiLora {
    static constexpr bool PERM = true, MID = false;
    bf16_t* dec; bf16_t* iclr; bf16_t* gate;
    __device__ __forceinline__ void operator()(const f32x4 (&acc)[2][2][4][2], const Unit& u, int wr, int wc, int fr, int fq) const {
        const int row0 = u.pm * 256 + wr * 64 + fr, blk = u.pn >> 1, nn0 = (u.pn & 1) * 256 + wc * 32 + 8 * fq;
        if (blk == 0) store(acc, dec, row0, nn0); else if (blk == 1) store(acc, iclr, row0, nn0); else store(acc, gate, row0, nn0);
    }
    static __device__ __forceinline__ void store(const f32x4 (&acc)[2][2][4][2], bf16_t* dst, int row0, int nn0) {
#pragma unroll
        for (int ai = 0; ai < 2; ++ai)
#pragma unroll
            for (int m = 0; m < 4; ++m) {
                const size_t row = (size_t)(row0 + ai * 128 + m * 16);
#pragma unroll
                for (int bj = 0; bj < 2; ++bj) {
                    const int nn = nn0 + bj * 128; const f32x4 v0 = acc[ai][bj][m][0], v1 = acc[ai][bj][m][1];
                    u32x4 w; w.x = cvt_pk_bf16(v0[0], v0[1]); w.y = cvt_pk_bf16(v0[2], v0[3]); w.z = cvt_pk_bf16(v1[0], v1[1]); w.w = cvt_pk_bf16(v1[2], v1[3]);
                    *(u32x4*)(dst + row * 512 + nn) = w;
                }
            }
    }
};
constexpr int P1_RAW = 1280, P1_RAWRING = 8 * P1_RAW, P1_REC = 1536, P1_WAVE = P1_RAWRING + 2 * P1_REC, P1_LA = 5;
static_assert(NWAVES * P1_WAVE <= RING_BYTES, "pass-1 LDS");
__device__ __forceinline__ void glds4_s(const char* sbase, unsigned voff, unsigned ldsdst) {
    asm volatile("s_mov_b32 m0, %2\n\ts_nop 0\n\tglobal_load_lds_dword %0, %1" : : "v"(voff), "s"(sbase), "s"(ldsdst) : "memory", "m0");
}
__device__ __forceinline__ void phase_rw_pass1(const Frame& F, const CAS Args& a, int layer) {
    const bf16_t* zrw = (const bf16_t*)(F.ws + MO(B_ZRW)); const bf16_t* dec = (const bf16_t*)(F.ws + MO(B_DEC)); const bf16_t* icl = (const bf16_t*)(F.ws + MO(B_ICLR));
    float* yloc = (float*)(F.ws + MO(B_YLOC)); float* pvec = (float*)(F.ws + MO(B_PVEC)); float* bonus = (float*)(F.ws + MO(B_BONUS));
    float* pmat = (float*)(F.ws + MO(B_PMAT)); float* qmat = (float*)(F.ws + MO(B_QMAT));
    const int lane = F.lane, gw = F.bx * NWAVES + F.wave, NGW = F.G * NWAVES;
    const LAS unsigned char* wl = F.lds + F.wave * P1_WAVE; const unsigned rawbase = (unsigned)(unsigned long)wl, lane4 = (unsigned)lane * 4u;
    LAS float* recs = (LAS float*)(wl + P1_RAWRING);
#define P1_ISSUE(u) do { const size_t _row = row0 + (u); const unsigned _d = rawbase + (unsigned)(((u) & 7) * P1_RAW); \
        const char* _z = uniform_ptr((const char*)(zrw + _row * RW_COLS + h * 64)); \
        glds4_s(_z, lane4, _d); glds4_s(_z + 576 * 2, lane4, _d + 256u); glds4_s(_z + 1088 * 2, lane4, _d + 512u); \
        glds4_s(uniform_ptr((const char*)(dec + _row * 512 + h * 64)), lane4, _d + 768u); glds4_s(uniform_ptr((const char*)(icl + _row * 512 + h * 64)), lane4, _d + 1024u); } while (0)
    for (int item = gw; item < 2048; item += NGW) {
        const int bh = item >> 7, ch = item & 127, b = bh >> 3, h = bh & 7, c = h * 64 + lane;
        const size_t row0 = (size_t)b * SEQ + ch * RWC; const bool first = ch == 0;
        asm volatile("s_waitcnt vmcnt(0)" ::: "memory");
        if (!first) P1_ISSUE(-1);
#pragma unroll
        for (int u = 0; u <= P1_LA; ++u) P1_ISSUE(u);
        const float* mu = a.in[I_MU] + layer * RW_COLS;
        const float mur = mu[c], muk = mu[576 + c], muv = mu[1088 + c];
        const float cst0 = a.in[I_W0][layer * 512 + c], cst1 = a.in[I_A0][layer * 512 + c], cst2 = a.in[I_KK][layer * 512 + c], cst3 = a.in[I_KA][layer * 512 + c], cst4 = a.in[I_RK][layer * 512 + c];
#define P1_CST(i) cst##i
        f32x2 sq[32], sp[32];
        int li = lane; asm volatile("" : "+v"(li));
#pragma unroll
        for (int j = 0; j < 32; ++j) { sq[j] = (f32x2){0.f, 0.f}; sp[j] = (f32x2){li == 2 * j ? 1.f : 0.f, li == 2 * j + 1 ? 1.f : 0.f}; }
        float pzr = 0.f, pzk = 0.f, pzv = 0.f;
#define P1_BUILD(u, aout) do { const LAS unsigned char* _rs = wl + ((u) & 7) * P1_RAW; \
        const float _zr = bf2f(*(const LAS bf16_t*)(_rs + 2 * lane)), _zk = bf2f(*(const LAS bf16_t*)(_rs + 256 + 2 * lane)), _zv = bf2f(*(const LAS bf16_t*)(_rs + 512 + 2 * lane)); \
        const float _w = __expf(-0.6065306597126334f * sigmoidf_(P1_CST(0) + bf2f(*(const LAS bf16_t*)(_rs + 768 + 2 * lane)))), _ic = sigmoidf_(P1_CST(1) + bf2f(*(const LAS bf16_t*)(_rs + 1024 + 2 * lane))); \
        const float _r = _zr + mur * (pzr - _zr), _k = _zk + muk * (pzk - _zk), _v = _zv + muv * (pzv - _zv); pzr = _zr; pzk = _zk; pzv = _zv; \
        float _kk = _k * P1_CST(2); const float _n2 = wave_sum(_kk * _kk); _kk *= rsqrtf(fmaxf(_n2, 1e-12f)); \
        const float _k2 = _k * (1.0f + (_ic - 1.0f) * P1_CST(3)); const float _bs = wave_sum(_r * _k2 * P1_CST(4)); \
        LAS float* _rc = recs + ((u) & 1) * 384 + (lane >> 4) * 80 + (lane & 15); \
        _rc[0] = _w; _rc[16] = _kk * _ic; _rc[32] = _k2; _rc[48] = _r; recs[((u) & 1) * 384 + 320 + lane] = _v; \
        recs[(((u) + 1) & 1) * 384 + (lane >> 4) * 80 + 64 + (lane & 15)] = -_kk; \
        if (lane == 0) bonus[(row0 + (u)) * 8 + h] = _bs; \
        aout = -_kk; } while (0)
        float a0;
        if (!first) { asm volatile("s_waitcnt vmcnt(30)" ::: "memory");
            const LAS unsigned char* rs = wl + 7 * P1_RAW; pzr = bf2f(*(const LAS bf16_t*)(rs + 2 * lane)); pzk = bf2f(*(const LAS bf16_t*)(rs + 256 + 2 * lane)); pzv = bf2f(*(const LAS bf16_t*)(rs + 512 + 2 * lane)); }
        asm volatile("s_waitcnt vmcnt(25)" ::: "memory");
        P1_BUILD(0, a0);
        float saq = 0.f, sap = a0;
        for (int t = 0; t < RWC; ++t) {
            const size_t row = row0 + t;
            if (t + 1 + P1_LA < RWC) { P1_ISSUE(t + 1 + P1_LA); if (t >= P1_LA) asm volatile("s_waitcnt vmcnt(40)" ::: "memory"); else asm volatile("s_waitcnt vmcnt(25)" ::: "memory"); }
            else asm volatile("s_waitcnt vmcnt(15)" ::: "memory");
            if (t + 1 < RWC) { float an; P1_BUILD(t + 1, an); (void)an; }
            asm volatile("s_waitcnt lgkmcnt(0)" ::: "memory");
            const LAS f32x4* rec = (const LAS f32x4*)(recs + (t & 1) * 384);
            const float vi = ((const LAS float*)rec)[320 + lane];
            const f32x2 saq2 = (f32x2){saq, saq}, sap2 = (f32x2){sap, sap}, vi2 = (f32x2){vi, vi};
            f32x2 yq0 = (f32x2){0.f, 0.f}, yq1 = yq0, yp0 = yq0, yp1 = yq0, dq0 = yq0, dq1 = yq0, dp0 = yq0, dp1 = yq0;
            f32x4 cw, cb, ck, cr, cn, nw, nb, nk, nr, nn;
            cw = rec[0]; cb = rec[4]; ck = rec[8]; cr = rec[12]; cn = rec[16];
#pragma unroll
            for (int bt = 0; bt < 16; ++bt) {
                if (bt < 15) { const int i = ((bt + 1) >> 2) * 20 + ((bt + 1) & 3); nw = rec[i]; nb = rec[i + 4]; nk = rec[i + 8]; nr = rec[i + 12]; nn = rec[i + 16]; }
                __builtin_amdgcn_sched_barrier(0);
                {   const int j = bt * 2;
                    const f32x2 w0 = (f32x2){cw.x, cw.y}, w1 = (f32x2){cw.z, cw.w}, b0 = (f32x2){cb.x, cb.y}, b1 = (f32x2){cb.z, cb.w}, k0 = (f32x2){ck.x, ck.y}, k1 = (f32x2){ck.z, ck.w};
                    const f32x2 r0 = (f32x2){cr.x, cr.y}, r1 = (f32x2){cr.z, cr.w}, n0 = (f32x2){cn.x, cn.y}, n1 = (f32x2){cn.z, cn.w};
                    sq[j] = sq[j] * w0 + saq2 * b0 + vi2 * k0; sp[j] = sp[j] * w0 + sap2 * b0;
                    sq[j + 1] = sq[j + 1] * w1 + saq2 * b1 + vi2 * k1; sp[j + 1] = sp[j + 1] * w1 + sap2 * b1;
                    yq0 += sq[j] * r0; yp0 += sp[j] * r0; yq1 += sq[j + 1] * r1; yp1 += sp[j + 1] * r1;
                    dq0 += sq[j] * n0; dp0 += sp[j] * n0; dq1 += sq[j + 1] * n1; dp1 += sp[j + 1] * n1; }
                __builtin_amdgcn_sched_barrier(0);
                cw = nw; cb = nb; ck = nk; cr = nr; cn = nn;
            }
            ((bf16_t*)yloc)[row * 512 + h * 64 + lane] = (bf16_t)f2bf((yq0.x + yq0.y) + (yq1.x + yq1.y));
            ((bf16_t*)pvec)[row * 512 + h * 64 + lane] = (bf16_t)f2bf((yp0.x + yp0.y) + (yp1.x + yp1.y));
            saq = (dq0.x + dq0.y) + (dq1.x + dq1.y); sap = (dp0.x + dp0.y) + (dp1.x + dp1.y);
        }
        int l2 = lane; asm volatile("" : "+v"(l2));
        f32x4* po = (f32x4*)(pmat + (size_t)item * 4096 + l2 * 64); f32x4* qo = (f32x4*)(qmat + (size_t)item * 4096 + l2 * 64);
#pragma unroll
        for (int j = 0; j < 16; ++j) { po[j] = (f32x4){sp[2 * j].x, sp[2 * j].y, sp[2 * j + 1].x, sp[2 * j + 1].y}; qo[j] = (f32x4){sq[2 * j].x, sq[2 * j].y, sq[2 * j + 1].x, sq[2 * j + 1].y}; }
    }
#undef P1_ISSUE
#undef P1_BUILD
#undef P1_CST
}
__device__ __forceinline__ void phase_rw_scan(const Frame& F, int layer) {
    const float* pmat = (const float*)(F.ws + MO(B_PMAT)); const float* qmat = (const float*)(F.ws + MO(B_QMAT)); float* sst = (float*)(F.ws + MO(B_SST));
    LAS float* Sb = (LAS float*)F.lds;
    const int lane = F.lane, jt = F.wave, n = lane & 15, kq = lane >> 4;
    for (int w = F.bx; w < 64; w += F.G) {
        const int bh = w >> 2, qr = w & 3; const size_t it0 = (size_t)bh * RWNC;
        __syncthreads();
        if (jt < 4) {
            f32x4 s = (f32x4){0.f, 0.f, 0.f, 0.f};
            float pA[16], pB[16], pC[16]; f32x4 qA, qB, qC;
#define SC_LOAD(pb, qc, c) do { const int _c = (c) < RWNC ? (c) : RWNC - 1; const float* pp = pmat + (it0 + _c) * 4096 + 16 * jt + n; _Pragma("unroll") for (int kk = 0; kk < 16; ++kk) pb[kk] = pp[(4 * kk + kq) * 64]; \
                        const float* qq = qmat + (it0 + _c) * 4096 + (size_t)(qr * 16 + 4 * kq) * 64 + 16 * jt + n; qc = (f32x4){qq[0], qq[64], qq[128], qq[192]}; } while (0)
#define SC_STEP(pb, qc, c) do { \
                float* so = sst + (it0 + (c)) * 4096 + (size_t)(qr * 16 + 4 * kq) * 64 + 16 * jt + n; \
                so[0] = s[0]; so[64] = s[1]; so[128] = s[2]; so[192] = s[3]; \
                _Pragma("unroll") for (int r = 0; r < 4; ++r) Sb[(4 * kq + r) * 68 + 16 * jt + n] = s[r]; \
                asm volatile("s_waitcnt lgkmcnt(0)" ::: "memory"); __builtin_amdgcn_s_barrier(); asm volatile("" ::: "memory"); \
                f32x4 a0 = qc, a1 = (f32x4){0.f, 0.f, 0.f, 0.f}, a2 = a1, a3 = a1; \
                _Pragma("unroll") for (int kk = 0; kk < 16; kk += 4) { \
                    a0 = __builtin_amdgcn_mfma_f32_16x16x4f32(Sb[n * 68 + 4 * kk + kq], pb[kk], a0, 0, 0, 0); \
                    a1 = __builtin_amdgcn_mfma_f32_16x16x4f32(Sb[n * 68 + 4 * (kk + 1) + kq], pb[kk + 1], a1, 0, 0, 0); \
                    a2 = __builtin_amdgcn_mfma_f32_16x16x4f32(Sb[n * 68 + 4 * (kk + 2) + kq], pb[kk + 2], a2, 0, 0, 0); \
                    a3 = __builtin_amdgcn_mfma_f32_16x16x4f32(Sb[n * 68 + 4 * (kk + 3) + kq], pb[kk + 3], a3, 0, 0, 0); } \
                s = (a0 + a1) + (a2 + a3); \
                SC_LOAD(pb, qc, (c) + 3); \
                asm volatile("s_waitcnt lgkmcnt(0)" ::: "memory"); __builtin_amdgcn_s_barrier(); asm volatile("" ::: "memory"); } while (0)
            SC_LOAD(pA, qA, 0); SC_LOAD(pB, qB, 1); SC_LOAD(pC, qC, 2);
            static_assert(RWNC % 3 == 2, "scan loop tail");
            for (int c = 0; c + 2 < RWNC; c += 3) { SC_STEP(pA, qA, c); SC_STEP(pB, qB, c + 1); SC_STEP(pC, qC, c + 2); }
            SC_STEP(pA, qA, RWNC - 2); SC_STEP(pB, qB, RWNC - 1);
#undef SC_LOAD
#undef SC_STEP
        } else {
            for (int c = 0; c < RWNC; ++c) { __builtin_amdgcn_s_barrier(); __builtin_amdgcn_s_barrier(); }
        }
    }
}
__device__ __forceinline__ bf16x8 cvt8(f32x4 lo, f32x4 hi) { u32x4 o; o.x = cvt_pk_bf16(lo[0], lo[1]); o.y = cvt_pk_bf16(lo[2], lo[3]); o.z = cvt_pk_bf16(hi[0], hi[1]); o.w = cvt_pk_bf16(hi[2], hi[3]); return __builtin_bit_cast(bf16x8, o); }
__device__ __forceinline__ void phase_rw_fix(const Frame& F, const CAS Args& a, int layer) {
    const bf16_t* zrw = (const bf16_t*)(F.ws + MO(B_ZRW)); const float* muv = a.in[I_MU] + layer * RW_COLS + 1088; const float* yloc = (const float*)(F.ws + MO(B_YLOC)); const float* pvec = (const float*)(F.ws + MO(B_PVEC));
    const float* sst = (const float*)(F.ws + MO(B_SST)); const float* bonus = (const float*)(F.ws + MO(B_BONUS)); const bf16_t* gate = (const bf16_t*)(F.ws + MO(B_GATE));
    bf16_t* mixed = (bf16_t*)(F.ws + MO(B_MIXED));
    const float* lnw = a.in[I_LNW] + layer * 512; const float* lnb = a.in[I_LNB] + layer * 512;
    const int lane = F.lane, gw = F.bx * NWAVES + F.wave, NGW = F.G * NWAVES, tl = lane & 15, q4 = lane >> 4;
    for (int item = gw; item < 2048; item += NGW) {
        const int bh = item >> 7, ch = item & 127, b = bh >> 3, h = bh & 7;
        bf16x8 sa[4][2];
#pragma unroll
        for (int ib = 0; ib < 4; ++ib)
#pragma unroll
            for (int ks = 0; ks < 2; ++ks) { const float* p = sst + (size_t)item * 4096 + (16 * ib + tl) * 64 + 32 * ks + 8 * q4; sa[ib][ks] = cvt8(*(const f32x4*)p, *(const f32x4*)(p + 4)); }
        f32x4 lw[4], lb[4];
#pragma unroll
        for (int ib = 0; ib < 4; ++ib) { lw[ib] = *(const f32x4*)(lnw + h * 64 + 16 * ib + 4 * q4); lb[ib] = *(const f32x4*)(lnb + h * 64 + 16 * ib + 4 * q4); }
        for (int tb = 0; tb < RWC / 16; ++tb) {
            const size_t row = (size_t)b * SEQ + ch * RWC + tb * 16 + tl;
            bf16x8 pb[2];
#pragma unroll
            for (int ks = 0; ks < 2; ++ks) pb[ks] = *(const bf16x8*)((const bf16_t*)pvec + row * 512 + h * 64 + 32 * ks + 8 * q4);
            f32x4 y[4]; float s = 0.f;
#pragma unroll
            for (int ib = 0; ib < 4; ++ib) {
                const u32x2 yb = *(const u32x2*)((const bf16_t*)yloc + row * 512 + h * 64 + 16 * ib + 4 * q4); f32x4 d = (f32x4){bflo(yb.x), bfhi(yb.x), bflo(yb.y), bfhi(yb.y)};
                d = __builtin_amdgcn_mfma_f32_16x16x32_bf16(sa[ib][0], pb[0], d, 0, 0, 0);
                d = __builtin_amdgcn_mfma_f32_16x16x32_bf16(sa[ib][1], pb[1], d, 0, 0, 0);
                y[ib] = d; s += (d[0] + d[1]) + (d[2] + d[3]);
            }
            s += __shfl_xor(s, 16); s += __shfl_xor(s, 32);
            const float mean = s * (1.0f / 64.0f); float q = 0.f;
#pragma unroll
            for (int ib = 0; ib < 4; ++ib) { y[ib] = y[ib] - mean; q += (y[ib][0] * y[ib][0] + y[ib][1] * y[ib][1]) + (y[ib][2] * y[ib][2] + y[ib][3] * y[ib][3]); }
            q += __shfl_xor(q, 16); q += __shfl_xor(q, 32);
            const float rstd = rsqrtf(q * (1.0f / 64.0f) + 64e-5f), bon = bonus[row * 8 + h];
#pragma unroll
            for (int ib = 0; ib < 4; ++ib) {
                const int c = h * 64 + 16 * ib + 4 * q4;
                const u32x2 zc = *(const u32x2*)(zrw + row * RW_COLS + 1088 + c); u32x2 zp = (u32x2){0u, 0u}; if ((row & (SEQ - 1)) != 0) zp = *(const u32x2*)(zrw + (row - 1) * RW_COLS + 1088 + c);
                const f32x4 mv = *(const f32x4*)(muv + c), zcf = (f32x4){bflo(zc.x), bfhi(zc.x), bflo(zc.y), bfhi(zc.y)}, zpf = (f32x4){bflo(zp.x), bfhi(zp.x), bflo(zp.y), bfhi(zp.y)};
                const f32x4 vv = zcf + mv * (zpf - zcf); const u32x2 gg = *(const u32x2*)(gate + row * 512 + c);
                const f32x4 o = (y[ib] * rstd * lw[ib] + lb[ib] + vv * bon) * (f32x4){bflo(gg.x), bfhi(gg.x), bflo(gg.y), bfhi(gg.y)};
                u32x2 w; w.x = cvt_pk_bf16(o[0], o[1]); w.y = cvt_pk_bf16(o[2], o[3]);
                *(u32x2*)(mixed + row * D + 1024 + c) = w;
            }
        }
    }
}

template <bool F8, bool O8 = F8> struct EpiSwiglu {
    static constexpr bool PERM = true, MID = false;
    const unsigned long long* ssq; const float* rsslot; void* act; int ldact;
    __device__ __forceinline__ void operator()(const f32x4 (&acc)[2][2][4][2], const Unit& u, int wr, int wc, int fr, int fq) const {
        const int row0 = u.pm * 256 + wr * 64 + fr, col0 = u.pn * 128 + wc * 32 + 8 * fq;
        float rsv[2][4];
#pragma unroll
        for (int ai = 0; ai < 2; ++ai)
#pragma unroll
            for (int m = 0; m < 4; ++m) { const int row = row0 + ai * 128 + m * 16; rsv[ai][m] = (rsslot ? rsslot[row] : ss_rs(ssq[row])) * (F8 ? 1.0f / (SC_H * SC_W13) : 1.0f); }
#pragma unroll
        for (int ai = 0; ai < 2; ++ai)
#pragma unroll
            for (int m = 0; m < 4; ++m) {
                const int row = row0 + ai * 128 + m * 16; const float rs = rsv[ai][m];
                float o[8];
#pragma unroll
                for (int n = 0; n < 2; ++n)
#pragma unroll
                    for (int j = 0; j < 4; ++j) { const float g = acc[ai][0][m][n][j] * rs, up = acc[ai][1][m][n][j] * rs; o[n * 4 + j] = g * sigmoidf_(g) * up; }
                if constexpr (O8) { u32x2 w; w.x = pk8(clamp8(o[0] * SC_ACT), clamp8(o[1] * SC_ACT), clamp8(o[2] * SC_ACT), clamp8(o[3] * SC_ACT)); w.y = pk8(clamp8(o[4] * SC_ACT), clamp8(o[5] * SC_ACT), clamp8(o[6] * SC_ACT), clamp8(o[7] * SC_ACT));
                    *(u32x2*)((unsigned char*)act + (size_t)row * ldact + col0) = w; }
                else { u32x4 w; w.x = cvt_pk_bf16(o[0], o[1]); w.y = cvt_pk_bf16(o[2], o[3]); w.z = cvt_pk_bf16(o[4], o[5]); w.w = cvt_pk_bf16(o[6], o[7]);
                    *(u32x4*)((bf16_t*)act + (size_t)row * ldact + col0) = w; }
            }
    }
};
struct EpiBf16Out {
    static constexpr bool PERM = true, MID = false;
    bf16_t* o; int ld; float asc;
    __device__ __forceinline__ void operator()(const f32x4 (&acc)[2][2][4][2], const Unit& u, int wr, int wc, int fr, int fq) const {
        const int row0 = u.pm * 256 + wr * 64 + fr, col0 = u.pn * 256 + wc * 32 + 8 * fq;
#pragma unroll
        for (int ai = 0; ai < 2; ++ai)
#pragma unroll
            for (int m = 0; m < 4; ++m)
#pragma unroll
                for (int bj = 0; bj < 2; ++bj) { const f32x4 v0 = acc[ai][bj][m][0] * asc, v1 = acc[ai][bj][m][1] * asc;
                    u32x4 w; w.x = cvt_pk_bf16(v0[0], v0[1]); w.y = cvt_pk_bf16(v0[2], v0[3]); w.z = cvt_pk_bf16(v1[0], v1[1]); w.w = cvt_pk_bf16(v1[2], v1[3]);
                    *(u32x4*)(o + (size_t)(row0 + ai * 128 + m * 16) * ld + col0 + bj * 128) = w; }
    }
};
struct EpiProbe {
    static constexpr bool PERM = true, MID = false;
    float* dummy;
    __device__ __forceinline__ void operator()(const f32x4 (&acc)[2][2][4][2], const Unit& u, int wr, int wc, int fr, int fq) const {
        float s = 0.f;
#pragma unroll
        for (int ai = 0; ai < 2; ++ai)
#pragma unroll
            for (int bj = 0; bj < 2; ++bj)
#pragma unroll
                for (int m = 0; m < 4; ++m)
#pragma unroll
                    for (int n = 0; n < 2; ++n) s += (acc[ai][bj][m][n][0] + acc[ai][bj][m][n][1]) + (acc[ai][bj][m][n][2] + acc[ai][bj][m][n][3]);
        dummy[(wr * 4 + wc) * 64 + fq * 16 + fr] = s;
    }
};
template <int K_, int NN_> struct ProbMoe {
    static constexpr bool FP8 = true;
    static constexpr int K = K_, lda = K_, ldb = K_, nN = NN_; static constexpr size_t estride = (size_t)NN_ * 256 * K_;
    const unsigned char* A; const unsigned char* Bt; int tp[9]; int G, c, i0, ilim;
    __device__ __forceinline__ bool next(int i, Unit& u) const { const int ii = i + i0; if (ii >= ilim) return false; return pg8::static_unit(ii * G + c, tp[8], nN, u); }
    __device__ __forceinline__ const char* abase(const Unit& u) const { return (const char*)(A + (size_t)u.pm * 256 * lda); }
    __device__ __forceinline__ const char* bbase(const Unit& u) const { int e = 0;
#pragma unroll
        for (int j = 1; j < 8; ++j) e += (u.pm >= tp[j]) ? 1 : 0;
        return (const char*)(Bt + (size_t)e * estride + (size_t)u.pn * 256 * ldb); }
};
__device__ __forceinline__ int moe_pos(int c, int G) { return (G & 7) ? c : (c & 7) * (G >> 3) + (c >> 3); }
__device__ __forceinline__ void moe_ord_unit(int w, int nM, int nN, Unit& u) {
    const int nig = pg8::WGM * nN, gid = w / nig, fm = gid * pg8::WGM, gsz = (nM - fm) < pg8::WGM ? (nM - fm) : pg8::WGM, r = w - gid * nig;
    u.pm = fm + r % gsz; u.pn = r / gsz;
}
template <int K_, int NN_> struct ProbMoeOrd {
    static constexpr bool FP8 = true;
    static constexpr int K = K_, lda = K_, ldb = K_, nN = NN_; static constexpr size_t estride = (size_t)NN_ * 256 * K_;
    const unsigned char* A; const unsigned char* Bt; int tp[9]; int G, pos, base, lim;
    __device__ __forceinline__ bool next(int i, Unit& u) const { const int w = base + i * G + pos; if (w >= lim) return false; moe_ord_unit(w, tp[8], nN, u); return true; }
    __device__ __forceinline__ const char* abase(const Unit& u) const { return (const char*)(A + (size_t)u.pm * 256 * lda); }
    __device__ __forceinline__ const char* bbase(const Unit& u) const { int e = 0;
#pragma unroll
        for (int j = 1; j < 8; ++j) e += (u.pm >= tp[j]) ? 1 : 0;
        return (const char*)(Bt + (size_t)e * estride + (size_t)u.pn * 256 * ldb); }
};
__device__ __forceinline__ void phase_router(const Frame& F, const CAS Args& a) {
    LAS float* rt = (LAS float*)F.lds;
    LAS int* cnt = (LAS int*)(F.lds + 65536);
    const float* rw = a.in[I_ROUTER]; const float* g2 = a.in[I_N2G] + D; const unsigned long long* ssq = (const unsigned long long*)(F.ws + OFF_SS) + 3 * (size_t)T; const bf16_t* h = (const bf16_t*)(F.ws + OFF_HB);
    int* toke = (int*)(F.ws + OFF_TOKE); float* tokg = (float*)(F.ws + OFF_TOKG); int* wgcnt = (int*)(F.ws + OFF_WGCNT);
    for (int i = F.tid; i < 2048 * 8; i += NTHREADS) rt[(i & 7) * 2048 + (i >> 3)] = rw[i];
    const int lane = F.lane;
    for (int tg = F.bx; tg < 256; tg += F.G) {
        if (F.tid < 8) cnt[F.tid] = 0;
        __syncthreads();
        for (int k = 0; k < 16; ++k) {
            const int tok = tg * 128 + F.wave * 16 + k;
            const float rs = ss_rs(ssq[tok]);
            float lg[8];
#pragma unroll
            for (int e = 0; e < 8; ++e) lg[e] = 0.f;
#pragma unroll
            for (int j = 0; j < 4; ++j) {
                const int c = lane * 8 + 512 * j; const u32x4 hb = *(const u32x4*)(h + (size_t)tok * D + c); const f32x4 gv0 = *(const f32x4*)(g2 + c), gv1 = *(const f32x4*)(g2 + c + 4);
                const f32x4 hn0 = (f32x4){bflo(hb.x), bfhi(hb.x), bflo(hb.y), bfhi(hb.y)} * rs * gv0, hn1 = (f32x4){bflo(hb.z), bfhi(hb.z), bflo(hb.w), bfhi(hb.w)} * rs * gv1;
#pragma unroll
                for (int e = 0; e < 8; ++e) { const f32x4 r0 = *(const LAS f32x4*)(rt + e * 2048 + c), r1 = *(const LAS f32x4*)(rt + e * 2048 + c + 4);
                    lg[e] += ((hn0.x * r0.x + hn0.y * r0.y) + (hn0.z * r0.z + hn0.w * r0.w)) + ((hn1.x * r1.x + hn1.y * r1.y) + (hn1.z * r1.z + hn1.w * r1.w)); }
            }
#pragma unroll
            for (int e = 0; e < 8; ++e) lg[e] = wave_sum(lg[e]);
            int i0 = 0; float v0 = lg[0];
#pragma unroll
            for (int e = 1; e < 8; ++e) if (lg[e] > v0) { v0 = lg[e]; i0 = e; }
            int i1 = -1; float v1 = -INFINITY;
#pragma unroll
            for (int e = 0; e < 8; ++e) if (e != i0 && lg[e] > v1) { v1 = lg[e]; i1 = e; }
            if (lane == 0) { const float g0 = 1.0f / (1.0f + expf(v1 - v0)); toke[tok] = i0; toke[T + tok] = i1; tokg[tok] = g0; tokg[T + tok] = 1.0f - g0; __hip_atomic_fetch_add((int*)(cnt + i0), 1, __ATOMIC_RELAXED, __HIP_MEMORY_SCOPE_WORKGROUP); __hip_atomic_fetch_add((int*)(cnt + i1), 1, __ATOMIC_RELAXED, __HIP_MEMORY_SCOPE_WORKGROUP); }
        }
        __syncthreads();
        if (F.tid < 8) wgcnt[tg * 8 + F.tid] = cnt[F.tid];
        __syncthreads();
    }
}
__device__ __forceinline__ void phase_assign(const Frame& F) {
    LAS int* wc = (LAS int*)F.lds;
    LAS int* base = wc + 2048;
    LAS int* seg = base + 8;
    LAS int* le = seg + 16;
    LAS int* ls = le + 256;
    const int* wgcnt = (const int*)(F.ws + OFF_WGCNT); const int* toke = (const int*)(F.ws + OFF_TOKE);
    int* slotof = (int*)(F.ws + OFF_SLOT); int* tokof = (int*)(F.ws + OFF_TOKOF); int* tiles = (int*)(F.ws + OFF_TILES);
    float* rsslot = (float*)(F.ws + OFF_RSSLOT); const unsigned long long* ssq3 = (const unsigned long long*)(F.ws + OFF_SS) + 3 * (size_t)T;
    const unsigned char* xb = F.ws + OFF_XB; unsigned char* asort = F.ws + OFF_ASORT;
    for (int tg = F.bx; tg < 256; tg += F.G) {
        __syncthreads();
        for (int i = F.tid; i < 2048; i += NTHREADS) wc[i] = wgcnt[i];
        if (F.tid < 256) le[F.tid] = toke[(F.tid & 1) * T + tg * 128 + (F.tid >> 1)];
        __syncthreads();
        if (F.tid < 8) { const int e = F.tid; int tot = 0, bef = 0; for (int w = 0; w < 256; ++w) { const int v = wc[w * 8 + e]; tot += v; bef += (w < tg) ? v : 0; }
            seg[8 + e] = tot; base[e] = bef; }
        __syncthreads();
        if (F.tid == 0) {
            int pre = 0;
            for (int e = 0; e < 8; ++e) { const int tot = seg[8 + e]; seg[e] = pre * 256; base[e] = pre * 256 + base[e]; if (tg == 0) tiles[e] = pre; pre += (tot + 255) >> 8; }
            if (tg == 0) tiles[8] = pre;
        }
        __syncthreads();
        if (F.tid < 8) { const int e = F.tid; int bs = base[e]; for (int i = 0; i < 256; ++i) if (le[i] == e) { ls[i] = bs; ++bs; } }
        __syncthreads();
        if (F.tid < 256) { const int tok = tg * 128 + (F.tid >> 1), s = F.tid & 1; slotof[s * T + tok] = ls[F.tid]; tokof[ls[F.tid]] = tok; rsslot[ls[F.tid]] = ss_rs(ssq3[tok]); }
        for (int i0 = F.wave * 32; i0 < F.wave * 32 + 32; i0 += 8) {
            u32x4 r[8][2];
#pragma unroll
            for (int u = 0; u < 8; ++u) { const int tok = tg * 128 + ((i0 + u) >> 1); const u32x4* srcp = (const u32x4*)(xb + (size_t)tok * D) + F.lane; r[u][0] = srcp[0]; r[u][1] = srcp[64]; }
#pragma unroll
            for (int u = 0; u < 8; ++u) { u32x4* dst = (u32x4*)(asort + (size_t)ls[i0 + u] * D) + F.lane; dst[0] = r[u][0]; dst[64] = r[u][1]; }
        }
        if (tg < 8) {
            const int p0 = seg[tg] + seg[8 + tg], p1 = seg[tg] + (((seg[8 + tg] + 255) >> 8) << 8);
            for (int s = p0 + F.wave; s < p1; s += NWAVES) { if (F.lane == 0) { tokof[s] = -1; rsslot[s] = 0.f; } u32x4* dst = (u32x4*)(asort + (size_t)s * D) + F.lane;
#pragma unroll
                for (int j = 0; j < 2; ++j) dst[64 * j] = (u32x4){0u, 0u, 0u, 0u}; }
        }
    }
}
__device__ __forceinline__ void phase_combine(const Frame& F, int sel, int fr, int extra) {
    const int* slotof = (const int*)(F.ws + OFF_SLOT); const float* tokg = (const float*)(F.ws + OFF_TOKG); const bf16_t* y = (const bf16_t*)(F.ws + OFF_ASORT); const bf16_t* hb16 = (const bf16_t*)(F.ws + OFF_HB); float* out = F.out;
    LAS int* late = (LAS int*)F.lds;
    if (sel) { const int R = ((const int*)(F.ws + OFF_TILES))[8];
        __syncthreads();
        for (int i = F.tid; i < 512; i += NTHREADS) late[i] = 0;
        __syncthreads();
        if (F.tid < extra) { pg8::Unit u; moe_ord_unit(fr * F.G + F.tid, R, D / 256, u); late[u.pm] = 1; }
        __syncthreads(); }
    const int w0 = sel == 1 ? extra : 0;
    const int gw = (F.bx - w0) * NWAVES + F.wave, NGW = (F.G - w0) * NWAVES, lane = F.lane;
    for (int tok = gw; tok < T; tok += NGW) {
        const int s0 = slotof[tok], s1 = slotof[T + tok];
        if (sel) { const int lt = late[s0 >> 8] | late[s1 >> 8]; if ((sel == 1) == (lt != 0)) continue; }
        const float g0 = tokg[tok], g1 = tokg[T + tok];
#pragma unroll
        for (int j = 0; j < 4; ++j) {
            const int c = lane * 8 + 512 * j; float* op = out + (size_t)tok * D + c;
            const u32x4 a0 = __builtin_nontemporal_load((const u32x4*)(y + (size_t)s0 * D + c)), a1 = __builtin_nontemporal_load((const u32x4*)(y + (size_t)s1 * D + c));
            const u32x4 hb = __builtin_nontemporal_load((const u32x4*)(hb16 + (size_t)tok * D + c));
            f32x4 h0 = (f32x4){bflo(hb.x), bfhi(hb.x), bflo(hb.y), bfhi(hb.y)}, h1 = (f32x4){bflo(hb.z), bfhi(hb.z), bflo(hb.w), bfhi(hb.w)};
            h0.x += g0 * bflo(a0.x) + g1 * bflo(a1.x); h0.y += g0 * bfhi(a0.x) + g1 * bfhi(a1.x); h0.z += g0 * bflo(a0.y) + g1 * bflo(a1.y); h0.w += g0 * bfhi(a0.y) + g1 * bfhi(a1.y);
            h1.x += g0 * bflo(a0.z) + g1 * bflo(a1.z); h1.y += g0 * bfhi(a0.z) + g1 * bfhi(a1.z); h1.z += g0 * bflo(a0.w) + g1 * bflo(a1.w); h1.w += g0 * bfhi(a0.w) + g1 * bfhi(a1.w);
            __builtin_nontemporal_store(h0, (f32x4*)op); __builtin_nontemporal_store(h1, (f32x4*)(op + 4));
        }
    }
}

enum LPhase { LP_INPROJ = 0, LP_G1, LP_G2, LP_G3, LP_G4, LP_G5, LP_OUTPROJ, LP_F0, LP_F1, LP_F2, LP_F3, LP_F4, LP_F5, LP_N };
constexpr int PH_TOTAL = 1 + 2 * LP_N;

template <int L> __device__ __forceinline__ void layer_mixer(const Frame& F, const CAS Args& args, int lo, int hi, const XcdBarrier& bar) {
    unsigned char* ws = F.ws;
#define IN(k) (lo <= (k) && (k) < hi)
#define SEAM(k) do { if ((k) + 1 < hi) xcd_barrier(bar); } while (0)
    {
        constexpr int l = L; constexpr int layer = L; const int pb = 1 + LP_N * l;
        unsigned long long* ssq = (unsigned long long*)(ws + OFF_SS);
        if (IN(pb + LP_INPROJ)) {
            ProbPlain P{(const bf16_t*)(ws + (l == 0 ? OFF_XB : OFF_HB)), (const bf16_t*)(ws + OFF_WIN + l * SZ_WIN), D, D, D, T / 256, IN_COLS / 256, F.G, F.bx};
            EpiInProj E{ssq + (size_t)(2 * l) * T, (bf16_t*)(ws + MO(B_ZATT)), (bf16_t*)(ws + MO(B_ZRW)), (bf16_t*)(ws + MO(B_UEXT))};
            pg8::gemm_phase(F.lds, P, E, F.wave);
            if (S5_BUILD_TAIL && F.G == 256) { __syncthreads(); phase_s5_build(fresh(F), args, l, 128, 128); }
            if (MOE_TAIL > 0 && F.G == 256) { __syncthreads(); moe_convert_range(fresh(F), args, l * (MOE_TAIL + MOE_EARLY), l * (MOE_TAIL + MOE_EARLY) + MOE_TAIL, 128, 128); }
            SEAM(pb + LP_INPROJ);
        }
        if (IN(pb + LP_G1)) {
            if (!(S5_BUILD_TAIL && F.G == 256 && IN(pb + LP_INPROJ))) { phase_s5_build(fresh(F), args, l, 0, F.G); __syncthreads(); }
            phase_attention(fresh(F), args, l); __syncthreads();
            phase_rw_prep1(fresh(F), args, l);
            SEAM(pb + LP_G1);
        }
        if (IN(pb + LP_G2)) {
            const bool scan_here = S5_SCAN_IN_G2 && F.G == 256;
            unsigned* s5flag = (unsigned*)(ws + OFF_CTL) + XS_S5FLAG(l);
            { ProbS5a P{(const bf16_t*)(ws + MO(B_UEXT)), (const bf16_t*)(ws + OFF_S5E), 1024, S5K, 1024, F.G, F.bx};
              EpiS5a E{(float*)(ws + MO(B_XLOC))};
              pg8::gemm_phase(F.lds, P, E, F.wave); }
            if (scan_here && F.bx < 64) {
                asm volatile("s_waitcnt vmcnt(0)" ::: "memory"); __syncthreads();
                if (F.tid == 0) { __builtin_amdgcn_fence(__ATOMIC_RELEASE, "agent"); asm volatile("s_waitcnt vmcnt(0)" ::: "memory"); (void)xb_add(s5flag, 1u); }
            }
            { ProbLora P{(const bf16_t*)(ws + MO(B_ALORA)), (const bf16_t*)(ws + OFF_BCAT + l * SZ_BCAT), 128, 256, 256, T / 256, 6, F.G, F.bx};
              EpiLora E{(bf16_t*)(ws + MO(B_DEC)), (bf16_t*)(ws + MO(B_ICLR)), (bf16_t*)(ws + MO(B_GATE))};
              pg8::gemm_phase(F.lds, P, E, F.wave); }
            if (scan_here && F.bx >= F.G - 8) {
                if (F.tid == 0) { XB_SPIN(xb_ld(s5flag) != 64u, (unsigned*)(ws + OFF_CTL)); __builtin_amdgcn_fence(__ATOMIC_ACQUIRE, "agent"); asm volatile("s_waitcnt vmcnt(0)" ::: "memory"); }
                __syncthreads();
                Frame Fs = fresh(F); Fs.bx = F.bx - (F.G - 8); phase_s5_scan(Fs, args, l);
            }
            SEAM(pb + LP_G2);
        }
        if (IN(pb + LP_G3)) {
            if (!(S5_SCAN_IN_G2 && F.G == 256)) phase_s5_scan(fresh(F), args, l);
            phase_rw_pass1(fresh(F), args, l);
            SEAM(pb + LP_G3);
        }
        if (IN(pb + LP_G4)) {
            phase_rw_scan(fresh(F), l);
            { const bool sub = F.G > 64;
              ProbS5b P{(const bf16_t*)(ws + MO(B_UEXT)), (const bf16_t*)(ws + OFF_S5B2), S5K, S5K, S5K, sub ? F.G - 64 : F.G, sub ? F.bx - 64 : F.bx};
              EpiS5b E{(bf16_t*)(ws + MO(B_ZG))};
              pg8::gemm_phase(F.lds, P, E, F.wave);
              if (sub) moe_convert_range(fresh(F), args, l * (MOE_TAIL + MOE_EARLY) + MOE_TAIL, (l + 1) * (MOE_TAIL + MOE_EARLY), 64, F.G - 64); }
            SEAM(pb + LP_G4);
        }
        if (IN(pb + LP_G5)) {
            { ProbPlain P{(const bf16_t*)(ws + MO(B_ZG)), (const bf16_t*)(ws + OFF_WGLU + l * SZ_WGLU), 512, 512, 512, T / 256, 2, F.G, F.bx};
              EpiGlu E{(const bf16_t*)(ws + MO(B_ZG)), args.in[I_GLUB] + l * 512, (bf16_t*)(ws + MO(B_MIXED)), ssq + (size_t)(5 + 2 * l) * T};
              pg8::gemm_phase(F.lds, P, E, F.wave); }
            phase_rw_fix(fresh(F), args, l);
            SEAM(pb + LP_G5);
        }
        if (IN(pb + LP_OUTPROJ)) {
            ProbPlain P{(const bf16_t*)(ws + MO(B_MIXED)), (const bf16_t*)(ws + OFF_WOUT + l * SZ_WOUT), D, D, D, T / 256, D / 256, F.G, F.bx};
            EpiResid<(L == 1 || (FFN_FP8 & 1)), true, true> E{l == 0 ? (const void*)(ws + OFF_XB) : (const void*)(ws + OFF_HB), (bf16_t*)(ws + OFF_HB), ws + (l == 0 ? OFF_X8 : OFF_XB), ssq + (size_t)(2 * l + 1) * T, 1.0f, ssq + (size_t)(4 + 2 * l) * T, ssq + (size_t)(5 + 2 * l) * T};
            pg8::gemm_phase(F.lds, P, E, F.wave); SEAM(pb + LP_OUTPROJ);
        }
    }
#undef IN
#undef SEAM
}

__global__ void __launch_bounds__(NTHREADS, 2) mk_fwd(Args args_) {
    const CAS Args& args = *(const CAS Args*)__builtin_amdgcn_kernarg_segment_ptr();
    extern __shared__ __attribute__((aligned(16))) unsigned char lds_raw[];
    Frame F; F.lds = (LAS unsigned char*)lds_raw; F.wave = __builtin_amdgcn_readfirstlane((int)threadIdx.x >> 6); F.lane = lane_id(); F.tid = F.wave * 64 + F.lane; F.G = gridDim.x; F.bx = blockIdx.x;
    F.ws = args.ws; F.out = args.out;
    unsigned char* ws = args.ws;
    const int lo = args.ph_lo, hi = args.ph_hi;
    LAS unsigned* misc = (LAS unsigned*)(F.lds + MISC_OFF);
    if (F.tid < 4) misc[F.tid] = 0u;
    __syncthreads();
    XcdBarrier bar; bar.bar = (unsigned*)(ws + OFF_CTL); bar.x = 0; bar.st = (volatile LAS unsigned*)misc; bar.wave = F.wave;
    if (hi - lo > 1) bar = xcd_barrier_post((unsigned*)(ws + OFF_CTL), (volatile LAS unsigned*)misc, F.wave);
#define IN(k) (lo <= (k) && (k) < hi)
#define SEAM(k) do { if ((k) + 1 < hi) xcd_barrier(bar); } while (0)
    if (IN(0)) { phase_prologue(fresh(F), args); SEAM(0); }
    layer_mixer<0>(F, args, lo, hi, bar);
    {
        const int pb = 1; unsigned long long* ssq = (unsigned long long*)(ws + OFF_SS);
        if (IN(pb + LP_F0)) {
            ProbPlainT<(FFN_FP8 & 1) != 0> P{ws + OFF_X8, ws + OFF_W13, D, D, D, T / 256, 2 * DFF / 256, F.G, F.bx};
            EpiSwiglu<(FFN_FP8 & 1) != 0, (FFN_FP8 & 2) != 0> E{ssq + T, nullptr, ws + OFF_ACT, DFF};
            pg8::gemm_phase(F.lds, P, E, F.wave); SEAM(pb + LP_F0);
        }
        if (IN(pb + LP_F1)) {
            ProbPlainT<(FFN_FP8 & 2) != 0> P{ws + OFF_ACT, ws + OFF_W2, DFF, DFF, DFF, T / 256, D / 256, F.G, F.bx};
            EpiResid<false, false, true, false> E{ws + OFF_HB, (bf16_t*)(ws + OFF_HB), nullptr, ssq + 2 * (size_t)T, (FFN_FP8 & 2) ? 1.0f / (SC_ACT * SC_W2) : 1.0f};
            pg8::gemm_phase(F.lds, P, E, F.wave); SEAM(pb + LP_F1);
        }
    }
    layer_mixer<1>(F, args, lo, hi, bar);
    {
        const int pb = 1 + LP_N; unsigned long long* ssq = (unsigned long long*)(ws + OFF_SS);
        if (IN(pb + LP_F0)) { phase_router(fresh(F), args); SEAM(pb + LP_F0); }
        if (IN(pb + LP_F1)) {
            phase_assign(fresh(F));
            __syncthreads();
            moe_convert_range(fresh(F), args, F.G == 256 ? 2 * (MOE_TAIL + MOE_EARLY) : 0, MOE_ITEMS, 0, F.G);
            SEAM(pb + LP_F1);
        }
        if (IN(pb + LP_F2) || IN(pb + LP_F4)) {
            const int* tl = (const int*)(ws + OFF_TILES);
            if (IN(pb + LP_F2)) {
                constexpr int NN = 2 * DFFE / 256;
                ProbMoeOrd<D, NN> P{ws + OFF_ASORT, ws + OFF_WM13, {RFL(tl[0]), RFL(tl[1]), RFL(tl[2]), RFL(tl[3]), RFL(tl[4]), RFL(tl[5]), RFL(tl[6]), RFL(tl[7]), RFL(tl[8])}, F.G, moe_pos(F.bx, F.G), 0, RFL(tl[8]) * NN};
                EpiSwiglu<true> E{ssq + 3 * (size_t)T, (const float*)(ws + OFF_RSSLOT), ws + OFF_MACT, DFFE};
                pg8::gemm_phase(F.lds, P, E, F.wave);
#if DBG_PROBE_MOE13
                { __syncthreads(); EpiProbe E2{(float*)(ws + OFF_CTL + 65536) + F.bx * 512}; pg8::gemm_phase(F.lds, P, E2, F.wave); }
#endif
                SEAM(pb + LP_F2);
            }
        }
        int csel = 0, cfr = 0, cextra = 0;
        if (IN(pb + LP_F4)) {
            const int* tl = (const int*)(ws + OFF_TILES);
            constexpr int NN2 = D / 256;
            ProbMoeOrd<DFFE, NN2> P{ws + OFF_MACT, ws + OFF_WM2, {RFL(tl[0]), RFL(tl[1]), RFL(tl[2]), RFL(tl[3]), RFL(tl[4]), RFL(tl[5]), RFL(tl[6]), RFL(tl[7]), RFL(tl[8])}, F.G, moe_pos(F.bx, F.G), 0, RFL(tl[8]) * NN2};
            EpiBf16Out E{(bf16_t*)(ws + OFF_ASORT), D, 1.0f / (SC_ACT * SC_W2)};
            const int ntile = RFL(tl[8]) * NN2, fr = ntile / F.G, extra = ntile - fr * F.G, pc = moe_pos(F.bx, F.G);
            const bool split = MK_SPLIT_COMBINE && IN(pb + LP_F5) && extra > 0 && fr > 0 && extra < F.G;
            if (split) { P.lim = fr * F.G; csel = 2; cfr = fr; cextra = extra; }
#pragma nounroll
            for (int part = 0; part < 2; ++part) {
                if (part == 1) {
                    if (!split) break;
                    split_arrive(bar);
                    if (pc >= extra) { split_wait(bar); Frame Fc = fresh(F); Fc.bx = pc; phase_combine(Fc, 1, fr, extra); break; }
                    P.base = fr * F.G; P.lim = ntile;
                }
                pg8::gemm_phase(F.lds, P, E, F.wave);
            }
            SEAM(pb + LP_F4);
        }
        if (IN(pb + LP_F5)) { phase_combine(fresh(F), csel, cfr, cextra); }
    }
#undef IN
#undef SEAM
}

extern "C" void kernel_launch(void* const* d_in, const int* in_sizes, int n_in, void* d_out, int out_size, void* d_ws, size_t ws_size, hipStream_t stream) {
    static int grid = 0;
    if (grid == 0) {
        int dev = 0, cus = 0;
        if (n_in != 39 || ws_size < WS_NEED || ws_size < OFF_MIX_END) { fprintf(stderr, "kernel_launch: unexpected shapes (n_in %d, ws %zu)\n", n_in, ws_size); grid = -1; return; }
        (void)hipGetDevice(&dev); (void)hipDeviceGetAttribute(&cus, hipDeviceAttributeMultiprocessorCount, dev);
        if (hipFuncSetAttribute((const void*)mk_fwd, hipFuncAttributeMaxDynamicSharedMemorySize, LDS_BYTES) != hipSuccess) { fprintf(stderr, "kernel_launch: hipFuncSetAttribute failed\n"); grid = -1; return; }
        grid = cus;
    }
    if (grid < 0) return;
    (void)hipMemsetAsync((char*)d_ws + OFF_CTL, 0, CTL_ZERO_BYTES, stream);
    Args a{};
    for (int i = 0; i < 39; ++i) a.in[i] = (const float*)d_in[i];
    a.out = (float*)d_out; a.ws = (unsigned char*)d_ws;
#if MK_ONE_LAUNCH
    a.ph_lo = 0; a.ph_hi = PH_TOTAL; hipLaunchKernelGGL(mk_fwd, dim3(grid), dim3(NTHREADS), LDS_BYTES, stream, a);
#else
    for (int ph = 0; ph < PH_TOTAL; ++ph) {
        if (ph >= 1 + LP_F2 && ph < 1 + LP_N) continue;
        if (ph > DBG_LAST_PHASE) break;
        a.ph_lo = ph; a.ph_hi = ph + 1;
        const int nrep = ((DBG_REP_MASK >> ph) & 1ull) ? DBG_REP_N : 1;
        for (int r = 0; r < nrep; ++r) hipLaunchKernelGGL(mk_fwd, dim3(grid), dim3(NTHREADS), LDS_BYTES, stream, a);
    }
#endif
}
```

```cpp
#include <hip/hip_runtime.h>
#include <cstdint>
#include <cstdio>

#define LAS __attribute__((address_space(3)))
#define GAS __attribute__((address_space(1)))
#define CAS __attribute__((address_space(4)))
typedef unsigned short bf16_t;
typedef short bf16x8 __attribute__((ext_vector_type(8)));
typedef short s16x4 __attribute__((ext_vector_type(4)));
typedef float f32x4 __attribute__((ext_vector_type(4)));
typedef float f32x2 __attribute__((ext_vector_type(2)));
typedef unsigned u32x4 __attribute__((ext_vector_type(4)));
typedef unsigned u32x2 __attribute__((ext_vector_type(2)));
typedef int i32x4 __attribute__((ext_vector_type(4)));
typedef int i32x8 __attribute__((ext_vector_type(8)));

constexpr int BATCH = 2, SEQ = 16384, T = BATCH * SEQ, D = 2048;
constexpr int IN_COLS = 3840, ATT_W = 1024, KV_W = 256, RW_W = 512, SS_W = 512, RW_COLS = 1792;
constexpr int ZATT_W = ATT_W + 2 * KV_W;
constexpr int DFF = 5632, DFFE = 7168, NEXP = 8;
constexpr float NORM_EPS = 1e-6f;
constexpr int NWAVES = 8, NTHREADS = 512;
#ifndef MK_ONE_LAUNCH
#define MK_ONE_LAUNCH 1
#define S5_BUILD_TAIL 1
#define S5_BUILD_PRO 1
#define S5_SCAN_IN_G2 1
#define MK_SPLIT_COMBINE 1
#endif
#ifndef FFN_FP8
#define FFN_FP8 3
#endif
#ifndef DBG_PROBE_MOE13
#define DBG_PROBE_MOE13 0
#endif
#ifndef DBG_REP_MASK
#define DBG_REP_MASK 0ull
#endif
#ifndef DBG_REP_N
#define DBG_REP_N 2
#endif
#ifndef DBG_LAST_PHASE
#define DBG_LAST_PHASE 1000
#endif
constexpr int S5C = 64;
constexpr int S5K = 1152;
constexpr int RWC = 128, RWNC = SEQ / RWC;
constexpr int MAXSLOTS = 2 * T + NEXP * 256;

constexpr size_t MiB = 1u << 20;
constexpr size_t OFF_CTL = 0;
constexpr size_t CTL_ZERO_BYTES = 1 * MiB;
constexpr size_t OFF_SS = 1 * MiB;
constexpr size_t OFF_TOKE = OFF_SS + 8 * (size_t)T * 8;
constexpr size_t OFF_TOKG = OFF_TOKE + 2 * (size_t)T * 4;
constexpr size_t OFF_SLOT = OFF_TOKG + 2 * (size_t)T * 4;
constexpr size_t OFF_TOKOF = OFF_SLOT + 2 * (size_t)T * 4;
constexpr size_t OFF_WGCNT = OFF_TOKOF + (size_t)MAXSLOTS * 4;
constexpr size_t OFF_TILES = OFF_WGCNT + 256 * 8 * 4;
constexpr size_t OFF_RSSLOT = OFF_TILES + 256;
static_assert(OFF_RSSLOT + (size_t)MAXSLOTS * 4 <= 6 * MiB, "ctl region");
constexpr size_t OFF_XB = 6 * MiB;
constexpr size_t SZ_XB = (size_t)T * D * 2;
constexpr size_t OFF_WIN = OFF_XB + SZ_XB;
constexpr size_t SZ_WIN = (size_t)IN_COLS * D * 2;
constexpr size_t OFF_WOUT = OFF_WIN + 2 * SZ_WIN;
constexpr size_t SZ_WOUT = (size_t)D * D * 2;
constexpr size_t OFF_W13 = OFF_WOUT + 2 * SZ_WOUT;
constexpr size_t OFF_W2 = OFF_W13 + (size_t)2 * DFF * D * 2;
constexpr size_t OFF_BCAT = OFF_W2 + (size_t)D * DFF * 2;
constexpr size_t SZ_BCAT = (size_t)1536 * 256 * 2;
constexpr size_t OFF_WGLU = OFF_BCAT + 2 * SZ_BCAT;
constexpr size_t SZ_WGLU = (size_t)512 * 512 * 2;
constexpr size_t OFF_S5B2 = OFF_WGLU + 2 * SZ_WGLU;
constexpr size_t SZ_S5B2 = (size_t)32 * 1024 * S5K * 2;
constexpr size_t OFF_S5E = OFF_S5B2 + SZ_S5B2;
constexpr size_t SZ_S5E = (size_t)32 * 256 * 1024 * 2;
constexpr size_t OFF_MIX = OFF_S5E + SZ_S5E;
enum MixBuf { B_ZATT = 0, B_ZRW, B_UEXT, B_XLOC, B_ZG, B_ALORA, B_DEC, B_ICLR, B_GATE, B_STREAM, B_BONUS, B_YLOC, B_PVEC, B_PMAT, B_QMAT, B_SST, B_ATTRAW, B_SSRAW, B_MIXED, B_N };
constexpr size_t mb_size(int b) {
    switch (b) {
        case B_ZATT: return (size_t)T * ZATT_W * 2;
        case B_ZRW: return (size_t)T * RW_COLS * 2;
        case B_UEXT: return (size_t)32 * 512 * S5K * 2;
        case B_XLOC: return (size_t)32 * 512 * 128 * 4;
        case B_ZG: return (size_t)T * 512 * 2;
        case B_ALORA: return (size_t)T * 256 * 2;
        case B_DEC: return (size_t)T * 512 * 4;
        case B_ICLR: return (size_t)T * 512 * 4;
        case B_GATE: return (size_t)T * 512 * 2;
        case B_STREAM: return 0;
        case B_BONUS: return (size_t)2 * T * 8 * 4;
        case B_YLOC: return (size_t)T * 512 * 4;
        case B_PVEC: return (size_t)T * 512 * 4;
        case B_PMAT: return (size_t)2048 * 4096 * 4;
        case B_QMAT: return (size_t)2048 * 4096 * 4;
        case B_SST: return (size_t)2048 * 4096 * 4;
        case B_ATTRAW: return (size_t)T * 1024 * 2;
        case B_SSRAW: return (size_t)T * 512 * 2;
        case B_MIXED: return (size_t)T * D * 2;
    }
    return 0;
}
constexpr int mb_order(int L, int i) {
    constexpr int o0[B_N] = {B_ZATT, B_ZRW, B_UEXT, B_XLOC, B_ZG, B_ALORA, B_DEC, B_ICLR, B_GATE, B_STREAM, B_BONUS, B_YLOC, B_PVEC, B_PMAT, B_QMAT, B_SST, B_ATTRAW, B_SSRAW, B_MIXED};
    constexpr int o1[B_N] = {B_STREAM, B_PVEC, B_ZATT, B_ZRW, B_UEXT, B_XLOC, B_ZG, B_ALORA, B_DEC, B_ICLR, B_GATE, B_BONUS, B_YLOC, B_PMAT, B_QMAT, B_SST, B_ATTRAW, B_SSRAW, B_MIXED};
    return L ? o1[i] : o0[i];
}
constexpr size_t moff(int L, int b) { size_t o = OFF_MIX; for (int i = 0; i < B_N; ++i) { if (mb_order(L, i) == b) return o; o += mb_size(mb_order(L, i)); } return o; }
constexpr size_t OFF_MIX_END = moff(0, B_MIXED) + mb_size(B_MIXED);
static_assert(moff(1, B_MIXED) + mb_size(B_MIXED) == OFF_MIX_END, "both layouts fill the same range");
#define MO(b) (layer ? moff(1, b) : moff(0, b))
constexpr size_t OFF_ACT = OFF_MIX;
static_assert(OFF_ACT + (size_t)T * DFF * 2 <= OFF_MIX_END, "dense act");
constexpr size_t OFF_MACT = OFF_XB;
constexpr size_t OFF_ASORT = OFF_MACT + (size_t)MAXSLOTS * DFFE;
constexpr size_t OFF_WM13 = OFF_MIX_END;
constexpr size_t OFF_WM2 = OFF_WM13 + (size_t)NEXP * 2 * DFFE * D;
__host__ __device__ constexpr size_t s5b2_off(int l) { return l == 0 ? OFF_S5B2 : OFF_WM2 - (SZ_S5B2 + SZ_S5E); }
__host__ __device__ constexpr size_t s5e_off(int l) { return l == 0 ? OFF_S5E : OFF_WM2 - SZ_S5E; }
constexpr size_t OFF_HB = OFF_WM2 + (size_t)NEXP * DFFE * D;
constexpr size_t OFF_X8 = OFF_HB + (size_t)T * D * 2;
constexpr size_t WS_NEED = OFF_X8 + (size_t)T * D;
static_assert((FFN_FP8 & 1) != 0, "OFF_X8 holds an fp8 copy");
static_assert(WS_NEED <= 1879048192ull && OFF_MIX_END <= 1879048192ull && OFF_ASORT + (size_t)MAXSLOTS * D * 2 <= OFF_WM13, "d_ws budget (4 x largest tensor)");

constexpr int RING_BYTES = 131072;
constexpr int MISC_OFF = RING_BYTES;
constexpr int LDS_BYTES = 147456;

__device__ __forceinline__ int lane_id() { int l; asm volatile("v_mbcnt_lo_u32_b32 %0, -1, 0\n\tv_mbcnt_hi_u32_b32 %0, -1, %0" : "=v"(l)); return l; }
#define RFL(x) __builtin_amdgcn_readfirstlane(x)
#define LDS_WAIT() asm volatile("s_waitcnt lgkmcnt(0)" ::: "memory")
#define VM_WAIT() asm volatile("s_waitcnt vmcnt(0)" ::: "memory")
__device__ __forceinline__ unsigned f2bf(float f) { unsigned u = __builtin_bit_cast(unsigned, f); return (u + 0x7fffu + ((u >> 16) & 1u)) >> 16; }
__device__ __forceinline__ unsigned pk2(float lo, float hi) { return f2bf(lo) | (f2bf(hi) << 16); }
__device__ __forceinline__ float bflo(unsigned w) { return __builtin_bit_cast(float, w << 16); }
__device__ __forceinline__ float bfhi(unsigned w) { return __builtin_bit_cast(float, w & 0xffff0000u); }
__device__ __forceinline__ float bf2f(bf16_t b) { return __builtin_bit_cast(float, (unsigned)b << 16); }
__device__ __forceinline__ unsigned cvt_pk_bf16(float lo, float hi) { unsigned r; asm volatile("v_cvt_pk_bf16_f32 %0, %1, %2" : "=v"(r) : "v"(lo), "v"(hi)); return r; }
__device__ __forceinline__ float clamp8(float v) { return __builtin_amdgcn_fmed3f(v, -448.0f, 448.0f); }
__device__ __forceinline__ unsigned pk8(float a, float b, float c, float d) { int w = 0; w = __builtin_amdgcn_cvt_pk_fp8_f32(a, b, w, false); w = __builtin_amdgcn_cvt_pk_fp8_f32(c, d, w, true); return (unsigned)w; }
__device__ __forceinline__ bf16x8 as_bf16(i32x4 v) { return __builtin_bit_cast(bf16x8, v); }
__device__ __forceinline__ i32x8 cat8(bf16x8 lo, bf16x8 hi) { return __builtin_shufflevector(__builtin_bit_cast(i32x4, lo), __builtin_bit_cast(i32x4, hi), 0, 1, 2, 3, 4, 5, 6, 7); }
constexpr float SC_H = 16.0f, SC_ACT = 8.0f, SC_W13 = 1024.0f, SC_W2 = 2048.0f;
__device__ __forceinline__ float wave_sum(float v) {
#pragma unroll
    for (int o = 1; o < 64; o <<= 1) v += __shfl_xor(v, o);
    return v;
}
__device__ __forceinline__ float frcp(float x) { return __builtin_amdgcn_rcpf(x); }
__device__ __forceinline__ float sigmoidf_(float x) { return frcp(1.0f + __builtin_amdgcn_exp2f(-1.4426950408889634f * x)); }
__device__ __forceinline__ unsigned long long ss_fix(float s) { return (unsigned long long)(s * 1048576.0f); }
__device__ __forceinline__ float ss_mean(unsigned long long v, float inv_n) { return (float)v * (1.0f / 1048576.0f) * inv_n + 1e-6f; }
__device__ __forceinline__ float ss_rs(unsigned long long v) { return rsqrtf((float)v * (1.0f / (1048576.0f * 2048.0f)) + 1e-6f); }

#define XB_TMO      128
#define XB_XCNT(j)  (256  + 64 * (j))
#define XB_XSUB(j)  (1280 + 64 * (j))
#define XB_XGEN(j)  (2304 + 64 * (j))
#define XB_TOP      3328
#define XB_TOPGEN   3392
#define XCD_BAR_WORDS 3456
#define XB_SPIN_CAP (1u << 18)
__device__ __forceinline__ unsigned xb_ld(unsigned* p)              { return __hip_atomic_load(p, __ATOMIC_RELAXED, __HIP_MEMORY_SCOPE_AGENT); }
__device__ __forceinline__ unsigned xb_add(unsigned* p, unsigned v) { return __hip_atomic_fetch_add(p, v, __ATOMIC_RELAXED, __HIP_MEMORY_SCOPE_AGENT); }
__device__ __forceinline__ unsigned xb_xcc_id() { return (unsigned)__builtin_amdgcn_s_getreg((3 << 11) | 20) & 0xFu; }
#define XB_SPIN(cond, bar) do { unsigned _sp = 0; while (cond) { __builtin_amdgcn_s_sleep(1); \
    if ((++_sp & 255u) == 0u) { if (xb_ld(&(bar)[XB_TMO])) break; if (_sp > XB_SPIN_CAP) { atomicAdd(&(bar)[XB_TMO], 1u); break; } } } } while (0)
struct XcdBarrier { unsigned* bar; unsigned x; volatile LAS unsigned* st; int wave; };
__device__ __forceinline__ XcdBarrier xcd_barrier_post(unsigned* bar, volatile LAS unsigned* st, int wave) {
    XcdBarrier b; b.bar = bar; b.x = xb_xcc_id(); b.st = st; b.wave = wave;
    if (wave == 0 && lane_id() == 0) (void)xb_add(&bar[XB_XCNT(b.x)], 1u);
    return b;
}
__device__ __forceinline__ void xcd_barrier_complete(unsigned* bar, unsigned x, unsigned& nloc, unsigned& nx) {
    const unsigned G = gridDim.x * gridDim.y * gridDim.z;
    unsigned sum, cnt, mine, sp = 0u;
    for (;;) {
        sum = 0u; cnt = 0u; mine = 0u;
#pragma unroll
        for (unsigned j = 0; j < 16; ++j) { const unsigned c = xb_ld(&bar[XB_XCNT(j)]); sum += c; cnt += (c > 0u) ? 1u : 0u; mine = (j == x) ? c : mine; }
        if (sum == G) break;
        __builtin_amdgcn_s_sleep(1);
        if ((++sp & 255u) == 0u) { if (xb_ld(&bar[XB_TMO])) break; if (sp > XB_SPIN_CAP) { atomicAdd(&bar[XB_TMO], 1u); break; } }
    }
    nloc = mine > 0u ? mine : 1u; nx = cnt > 0u ? cnt : 1u;
}
__device__ __forceinline__ void xcd_barrier(const XcdBarrier& b) {
    asm volatile("s_waitcnt vmcnt(0)" ::: "memory");
    __syncthreads();
    if (b.wave == 0 && lane_id() == 0) {
        unsigned* bar = b.bar;
        __builtin_amdgcn_s_waitcnt(0);
        unsigned nloc = b.st[0], nx = b.st[1];
        if (nloc == 0u) { xcd_barrier_complete(bar, b.x, nloc, nx); b.st[0] = nloc; b.st[1] = nx; }
        const unsigned old = xb_add(&bar[XB_XSUB(b.x)], 1u);
        const unsigned gen = old / nloc;
        if (old + 1u == (gen + 1u) * nloc) {
            __builtin_amdgcn_fence(__ATOMIC_RELEASE, "agent");
            asm volatile("s_waitcnt vmcnt(0)" ::: "memory");
            const unsigned og = xb_add(&bar[XB_TOP], 1u);
            const unsigned tg = og / nx;
            if (og + 1u == (tg + 1u) * nx) xb_add(&bar[XB_TOPGEN], 1u);
            else XB_SPIN(xb_ld(&bar[XB_TOPGEN]) == tg, bar);
            __builtin_amdgcn_fence(__ATOMIC_ACQUIRE, "agent");
            xb_add(&bar[XB_XGEN(b.x)], 1u);
            asm volatile("s_waitcnt vmcnt(0)" ::: "memory");
        } else {
            XB_SPIN(xb_ld(&bar[XB_XGEN(b.x)]) == gen, bar);
            __builtin_amdgcn_fence(__ATOMIC_ACQUIRE, "agent");
            asm volatile("s_waitcnt vmcnt(0)" ::: "memory");
        }
    }
    __syncthreads();
}

#define XS_SUB(j)  (8192 + 64 * (j))
#define XS_TOP     (8192 + 64 * 16)
#define XS_S5FLAG(l) (8192 + 64 * (17 + (l)))
__device__ __forceinline__ void split_arrive(const XcdBarrier& b) {
    asm volatile("s_waitcnt vmcnt(0)" ::: "memory");
    __syncthreads();
    if (b.wave == 0 && lane_id() == 0) {
        unsigned* bar = b.bar;
        __builtin_amdgcn_s_waitcnt(0);
        unsigned nloc = b.st[0], nx = b.st[1];
        if (nloc == 0u) { xcd_barrier_complete(bar, b.x, nloc, nx); b.st[0] = nloc; b.st[1] = nx; }
        const unsigned old = xb_add(&bar[XS_SUB(b.x)], 1u);
        if (old + 1u == nloc) { __builtin_amdgcn_fence(__ATOMIC_RELEASE, "agent"); asm volatile("s_waitcnt vmcnt(0)" ::: "memory"); xb_add(&bar[XS_TOP], 1u); }
    }
}
__device__ __forceinline__ void split_wait(const XcdBarrier& b) {
    if (b.wave == 0 && lane_id() == 0) {
        unsigned* bar = b.bar; const unsigned nx = b.st[1];
        XB_SPIN(xb_ld(&bar[XS_TOP]) != nx, bar);
        __builtin_amdgcn_fence(__ATOMIC_ACQUIRE, "agent");
        asm volatile("s_waitcnt vmcnt(0)" ::: "memory");
    }
    __syncthreads();
}

namespace pg8 {
constexpr int BM = 256, BK = 64, HALF = 128, HTB = HALF * BK * 2, STAGE_BYTES = 8 * HTB, NXCD = 8, WGM = 4;
__host__ __device__ __forceinline__ int lds_byte(int r, int c) { const int st = (r >> 4) * 2 + (c >> 5), rr = r & 15, cc = c & 31, ob = rr * 64 + cc * 2; return st * 1024 + (ob ^ (((ob >> 9) & 1) << 5)); }
__host__ __device__ __forceinline__ void stage_rc(int b, int& R, int& C) { const int st = b / 1024, sb = b % 1024, swz = sb ^ (((sb >> 9) & 1) << 5); R = (st >> 1) * 16 + swz / 64; C = (st & 1) * 32 + (swz % 64) / 2; }
__host__ __device__ __forceinline__ int perm32(int rho) { const int n = rho >> 4, i = rho & 15; return 8 * (i >> 2) + 4 * n + (i & 3); }
struct Unit { int pm, pn; };
__device__ __forceinline__ bool static_unit(int L, int nM, int nN, Unit& u) {
    const int nwg = nM * nN; if (L < 0 || L >= nwg) return false;
    int wgid = (int)L; { const int q = nwg / NXCD, r = nwg % NXCD, xcd = wgid % NXCD, off = wgid / NXCD; wgid = (xcd < r ? xcd * (q + 1) : r * (q + 1) + (xcd - r) * q) + off; }
    const int nig = WGM * nN, gid = wgid / nig, fm = gid * WGM, gsz = (nM - fm) < WGM ? (nM - fm) : WGM;
    u.pm = fm + ((wgid % nig) % gsz); u.pn = (wgid % nig) / gsz; return true;
}

__device__ __forceinline__ void glds_s(const char* sbase, unsigned voff, unsigned ldsdst) {
    asm volatile("s_mov_b32 m0, %2\n\ts_nop 0\n\tglobal_load_lds_dwordx4 %0, %1" : : "v"(voff), "s"(sbase), "s"(ldsdst) : "memory", "m0");
}
__device__ __forceinline__ const char* uniform_ptr(const char* p) { const unsigned long v = (unsigned long)p;
    const unsigned lo = __builtin_amdgcn_readfirstlane((unsigned)v), hi = __builtin_amdgcn_readfirstlane((unsigned)(v >> 32)); return (const char*)(((unsigned long)hi << 32) | lo); }
template <class Epi, class Prob>
__device__ __forceinline__ void gemm_phase(LAS unsigned char* lds, const Prob& P, const Epi& E, int wave) {
    int lane = lane_id(); asm volatile("" : "+v"(lane));
    const int wid = wave, tid = wave * 64 + lane, wr = wid >> 2, wc = wid & 3, fr = lane & 15, fq = lane >> 4;
    constexpr int ESZ = Prob::FP8 ? 1 : 2;
    const int K = P.K, nt = K * ESZ / 128;
    unsigned voffA, voffB;
    { int R, C; stage_rc(tid * 16, R, C); const int Rb = Epi::PERM ? ((R & ~31) + perm32(R & 31)) : R;
      voffA = (unsigned)(R * P.lda * ESZ + 2 * C); voffB = (unsigned)(Rb * P.ldb * ESZ + 2 * C); }
    const size_t r64A = (size_t)64 * P.lda * ESZ, r64B = (size_t)64 * P.ldb * ESZ;
    const unsigned ldsbase = (unsigned)(unsigned long)lds;
    const size_t kstep = (size_t)(BK * 2);
    const size_t hA = (size_t)HALF * P.lda * ESZ, hB = (size_t)HALF * P.ldb * ESZ;
    const unsigned ldsw = (unsigned)wid * 1024u;
    int aoff = lds_byte(wr * 64 + fr, fq * 8), boff = lds_byte(wc * 32 + fr, fq * 8) + 4 * HTB; asm volatile("" : "+v"(aoff), "+v"(boff));
    const LAS unsigned char* la = lds + aoff; const LAS unsigned char* lb = lds + boff;
#define PG8_SA(b, h) (((b) * 2 + (h)) * HTB)
#define PG8_SB(b, h) ((4 + (b) * 2 + (h)) * HTB)
#define PG8_STAGE(bufoff, gbase, AB) do { glds_s((const char*)(gbase), voff##AB, ldsbase + (bufoff) + ldsw); glds_s((const char*)(gbase) + r64##AB, voff##AB, ldsbase + (bufoff) + ldsw + 8192u); } while (0)
#define PG8_LDA(dst, b, h) do { _Pragma("unroll") for (int m = 0; m < 4; ++m) { dst[m].lo = *(const LAS i32x4*)(la + PG8_SA(b, h) + m * 2048); dst[m].hi = *(const LAS i32x4*)(la + PG8_SA(b, h) + m * 2048 + 1024); } } while (0)
#define PG8_LDB(dst, b, h) do { _Pragma("unroll") for (int n = 0; n < 2; ++n) { dst[n].lo = *(const LAS i32x4*)(lb + (PG8_SB(b, h) - 4 * HTB) + n * 2048); dst[n].hi = *(const LAS i32x4*)(lb + (PG8_SB(b, h) - 4 * HTB) + n * 2048 + 1024); } } while (0)
#define PG8_MMA(ai, bj, At, Bt) do { __builtin_amdgcn_s_setprio(1); _Pragma("unroll") for (int m = 0; m < 4; ++m) _Pragma("unroll") for (int n = 0; n < 2; ++n) { \
        if constexpr (Prob::FP8) acc[ai][bj][m][n] = __builtin_amdgcn_mfma_scale_f32_16x16x128_f8f6f4(Bt[n], At[m], acc[ai][bj][m][n], 0, 0, 0, 0x7f7f7f7f, 0, 0x7f7f7f7f); \
        else { acc[ai][bj][m][n] = __builtin_amdgcn_mfma_f32_16x16x32_bf16(as_bf16(Bt[n].lo), as_bf16(At[m].lo), acc[ai][bj][m][n], 0, 0, 0); \
               acc[ai][bj][m][n] = __builtin_amdgcn_mfma_f32_16x16x32_bf16(as_bf16(Bt[n].hi), as_bf16(At[m].hi), acc[ai][bj][m][n], 0, 0, 0); } } \
        __builtin_amdgcn_s_setprio(0); } while (0)
#define PG8_WAIT_V(n) asm volatile("s_waitcnt vmcnt(" #n ")" ::: "memory")
#define PG8_WAIT_L(n) asm volatile("s_waitcnt lgkmcnt(" #n ")" ::: "memory")
#define PG8_BAR __builtin_amdgcn_s_barrier()
#define PG8_SCHED __builtin_amdgcn_sched_barrier(0)
    Unit cur, nxt; int ui = 0;
    if (!P.next(0, cur)) return;
    f32x4 acc[2][2][4][2];
#pragma unroll
    for (int a = 0; a < 2; ++a)
#pragma unroll
        for (int b = 0; b < 2; ++b)
#pragma unroll
            for (int m = 0; m < 4; ++m)
#pragma unroll
                for (int n = 0; n < 2; ++n) acc[a][b][m][n] = (f32x4){0.f, 0.f, 0.f, 0.f};
    i32x8 At[4], B0[2], B1[2];
    const char* cA = uniform_ptr(P.abase(cur)); const char* cB = uniform_ptr(P.bbase(cur));
    PG8_STAGE(PG8_SB(0, 0), cB, B); PG8_STAGE(PG8_SB(0, 1), cB + hB, B); PG8_STAGE(PG8_SA(0, 0), cA, A); PG8_STAGE(PG8_SA(0, 1), cA + hA, A);
    if (wr == 1) PG8_BAR;
    PG8_WAIT_V(2); PG8_BAR;
    PG8_STAGE(PG8_SB(1, 0), cB + kstep, B); PG8_STAGE(PG8_SA(1, 0), cA + kstep, A); PG8_STAGE(PG8_SB(1, 1), cB + hB + kstep, B);
    PG8_WAIT_V(6); PG8_BAR;
    for (;;) {
        const bool has_next = P.next(ui + 1, nxt);
        const char* nA = uniform_ptr(has_next ? P.abase(nxt) : cA); const char* nB = uniform_ptr(has_next ? P.bbase(nxt) : cB);
        int tb = 0;
        for (int seg = 0; seg < (Epi::MID ? 3 : 1); ++seg) {
        int te = nt; if constexpr (Epi::MID) { te = seg == 0 ? Epi::T1 : (seg == 1 ? Epi::T2 : nt); }
        for (int t = tb; t < te; t += 2) {
            const bool last = (t == nt - 2);
            const char* a1 = cA + (size_t)(t + 1) * kstep;
            const char* a2 = last ? nA : cA + (size_t)(t + 2) * kstep; const char* b2 = last ? nB : cB + (size_t)(t + 2) * kstep;
            const char* a3 = a2 + kstep; const char* b3 = b2 + kstep;
            PG8_LDB(B0, 0, 0); PG8_LDB(B1, 0, 1); PG8_SCHED; PG8_LDA(At, 0, 0); PG8_STAGE(PG8_SA(1, 1), a1 + hA, A);
            PG8_WAIT_V(8); PG8_WAIT_L(0); PG8_BAR; PG8_MMA(0, 0, At, B0); PG8_MMA(0, 1, At, B1); PG8_BAR; PG8_SCHED;
            PG8_LDA(At, 0, 1); PG8_STAGE(PG8_SB(0, 0), b2, B); PG8_STAGE(PG8_SB(0, 1), b2 + hB, B); PG8_STAGE(PG8_SA(0, 0), a2, A);
            PG8_WAIT_V(8); PG8_WAIT_L(0); PG8_BAR; PG8_MMA(1, 0, At, B0); PG8_MMA(1, 1, At, B1); PG8_BAR; PG8_SCHED;
            PG8_LDB(B0, 1, 0); PG8_LDB(B1, 1, 1); PG8_SCHED; PG8_LDA(At, 1, 0); PG8_STAGE(PG8_SA(0, 1), a2 + hA, A);
            PG8_WAIT_V(8); PG8_WAIT_L(0); PG8_BAR; PG8_MMA(0, 0, At, B0); PG8_MMA(0, 1, At, B1); PG8_BAR; PG8_SCHED;
            PG8_LDA(At, 1, 1); PG8_STAGE(PG8_SB(1, 0), b3, B); PG8_STAGE(PG8_SB(1, 1), b3 + hB, B); PG8_STAGE(PG8_SA(1, 0), a3, A);
            PG8_WAIT_V(8); PG8_WAIT_L(0); PG8_BAR; PG8_MMA(1, 0, At, B0); PG8_MMA(1, 1, At, B1); PG8_BAR; PG8_SCHED;
        }
        if constexpr (Epi::MID) { if (seg < 2) E.mid(acc, cur, wr, fr, seg); }
        tb = te;
        }
        if (wr == 0) PG8_BAR;
        { int frx = fr, fqx = fq; asm volatile("" : "+v"(frx), "+v"(fqx));
          E(acc, cur, wr, wc, frx, fqx); }
        if (!has_next) break;
#pragma unroll
        for (int a = 0; a < 2; ++a)
#pragma unroll
            for (int b = 0; b < 2; ++b)
#pragma unroll
                for (int m = 0; m < 4; ++m)
#pragma unroll
                    for (int n = 0; n < 2; ++n) acc[a][b][m][n] = (f32x4){0.f, 0.f, 0.f, 0.f};
        cur = nxt; cA = nA; cB = nB; ++ui;
        if (wr == 1) PG8_BAR;
    }
    PG8_WAIT_V(0);
    PG8_BAR;
#undef PG8_SA
#undef PG8_SB
#undef PG8_STAGE
#undef PG8_LDA
#undef PG8_LDB
#undef PG8_MMA
#undef PG8_WAIT_V
#undef PG8_WAIT_L
#undef PG8_BAR
#undef PG8_SCHED
}
}
using pg8::Unit; using pg8::glds_s; using pg8::uniform_ptr;

template <bool FP8_ = false> struct ProbPlainT {
    static constexpr bool FP8 = FP8_;
    const void* A; const void* Bt; int K, lda, ldb, nM, nN, G, c;
    __device__ __forceinline__ bool next(int i, Unit& u) const { return pg8::static_unit(i * G + c, nM, nN, u); }
    __device__ __forceinline__ const char* abase(const Unit& u) const { return (const char*)A + (size_t)u.pm * 256 * lda * (FP8 ? 1 : 2); }
    __device__ __forceinline__ const char* bbase(const Unit& u) const { return (const char*)Bt + (size_t)u.pn * 256 * ldb * (FP8 ? 1 : 2); }
};
typedef ProbPlainT<false> ProbPlain;
typedef ProbPlainT<true> ProbPlain8;

struct Args { const float* in[39]; float* out; unsigned char* ws; int ph_lo, ph_hi; };
static_assert(sizeof(Args) == 39 * 8 + 8 + 8 + 8, "no padding in Args");
enum In { I_X = 0, I_N1G, I_WIN, I_QG, I_KG, I_SINK, I_RELB, I_MU, I_W0, I_W2, I_A0, I_A2, I_G2, I_KK, I_KA, I_RK, I_LNW, I_LNB,
          I_LRE, I_LIM, I_BRE, I_BIM, I_CRE, I_CIM, I_SD, I_DT, I_GLUW, I_GLUB, I_AOG, I_SOG, I_WOUT, I_N2G, I_F1, I_F3, I_F2, I_ROUTER, I_M1, I_M3, I_M2 };

struct Frame {
    LAS unsigned char* lds;
    int tid, lane, wave, G, bx;
    unsigned char* ws; float* out;
};

__device__ __forceinline__ Frame fresh(const Frame& F0) { Frame F = F0; int l = lane_id(); asm volatile("" : "+v"(l)); F.lane = l; F.tid = F0.wave * 64 + l; return F; }
__device__ __forceinline__ void transpose_item(const float* W, int N, bf16_t* WT, int ldt, int k0, int n0, int drow0, const float* gk, LAS float* scr, int lane, const float* gk2 = nullptr) {
#pragma unroll 8
    for (int i = 0; i < 32; ++i) { const int kk = 2 * i + (lane >> 5), k = k0 + kk; float w = W[(size_t)k * N + n0 + (lane & 31)];
        if (gk) w *= gk2 ? (k < 1024 ? gk[k] : (k < 1536 ? 1.0f : gk2[k - 1536])) : gk[k]; scr[kk * 33 + (lane & 31)] = w; }
    LDS_WAIT(); asm volatile("" ::: "memory");
    const int c = lane & 7;
#pragma unroll
    for (int j = 0; j < 4; ++j) { const int n = (lane >> 3) + 8 * j; const LAS float* s = scr + (8 * c) * 33 + n;
        u32x4 o; o.x = pk2(s[0 * 33], s[1 * 33]); o.y = pk2(s[2 * 33], s[3 * 33]); o.z = pk2(s[4 * 33], s[5 * 33]); o.w = pk2(s[6 * 33], s[7 * 33]);
        *(u32x4*)(WT + (size_t)(drow0 + n) * ldt + k0 + 8 * c) = o; }
    LDS_WAIT(); asm volatile("" ::: "memory");
}
__device__ __forceinline__ void cvt8_load(const float* W, int N, int k0, int n0, int lane, f32x4 (&v)[8]) {
    const float* p = W + (size_t)(k0 + (lane >> 3)) * N + n0 + 4 * (lane & 7);
#pragma unroll
    for (int i = 0; i < 8; ++i) v[i] = __builtin_nontemporal_load((const f32x4*)(p + (size_t)(8 * i) * N));
}
__device__ __forceinline__ void cvt8_finish(const f32x4 (&v)[8], unsigned char* WT, int ldt, int k0, int drow0, const float* gk, float wsc, LAS float* scr, int lane) {
    const int r = lane >> 3, c4 = 4 * (lane & 7);
#pragma unroll
    for (int i = 0; i < 8; ++i) { const int kk = 8 * i + r; float sc = wsc; if (gk) sc *= gk[k0 + kk];
        LAS float* d = scr + kk * 33 + c4; d[0] = v[i].x * sc; d[1] = v[i].y * sc; d[2] = v[i].z * sc; d[3] = v[i].w * sc; }
    LDS_WAIT(); asm volatile("" ::: "memory");
    const int c = lane & 3;
#pragma unroll
    for (int j = 0; j < 2; ++j) { const int n = (lane >> 2) + 16 * j; const LAS float* s = scr + (16 * c) * 33 + n;
        u32x4 o; o.x = pk8(s[0 * 33], s[1 * 33], s[2 * 33], s[3 * 33]); o.y = pk8(s[4 * 33], s[5 * 33], s[6 * 33], s[7 * 33]); o.z = pk8(s[8 * 33], s[9 * 33], s[10 * 33], s[11 * 33]); o.w = pk8(s[12 * 33], s[13 * 33], s[14 * 33], s[15 * 33]);
        *(u32x4*)(WT + (size_t)(drow0 + n) * ldt + k0 + 16 * c) = o; }
    LDS_WAIT(); asm volatile("" ::: "memory");
}
__device__ __forceinline__ void transpose_item8(const float* W, int N, unsigned char* WT, int ldt, int k0, int n0, int drow0, const float* gk, float wsc, LAS float* scr, int lane) {
    f32x4 v[8]; cvt8_load(W, N, k0, n0, lane, v); cvt8_finish(v, WT, ldt, k0, drow0, gk, wsc, scr, lane);
}
__device__ __forceinline__ void transpose_matrix8(const Frame& F, const float* W, int K, int N, unsigned char* WT, int ldt, const float* gk, float wsc, int mode) {
    LAS float* scr = (LAS float*)(F.lds + F.wave * 16384);
    const int gw = F.bx * NWAVES + F.wave, NGW = F.G * NWAVES, nblk = N / 32, nitems = (K / 64) * nblk;
    for (int it = gw; it < nitems; it += NGW) {
        const int kb = it / nblk, nb = it % nblk, n0 = 32 * nb;
        const int drow0 = mode == 0 ? n0 : (n0 >> 7) * 256 + (n0 & 127) + (mode == 2 ? 128 : 0);
        transpose_item8(W, N, WT, ldt, 64 * kb, n0, drow0, gk, wsc, scr, F.lane);
    }
}
__device__ __forceinline__ void transpose_matrix(const Frame& F, const float* W, int K, int N, bf16_t* WT, int ldt, const float* gk, int mode, const float* gk2 = nullptr) {
    LAS float* scr = (LAS float*)(F.lds + F.wave * 16384);
    const int gw = F.bx * NWAVES + F.wave, NGW = F.G * NWAVES, nblk = N / 32, nitems = (K / 64) * nblk;
    for (int it = gw; it < nitems; it += NGW) {
        const int kb = it / nblk, nb = it % nblk, n0 = 32 * nb;
        const int drow0 = mode == 0 ? n0 : (n0 >> 7) * 256 + (n0 & 127) + (mode == 2 ? 128 : 0);
        transpose_item(W, N, WT, ldt, 64 * kb, n0, drow0, gk, scr, F.lane, gk2);
    }
}

constexpr int MOE_ITEMS = NEXP * 3 * 7168;
struct MoeItem { const float* W; unsigned char* WT; const float* gk; float wsc; int N, ldt, k0, n0, drow0; };
__device__ __forceinline__ MoeItem moe_item(const CAS Args& a, unsigned char* ws, int I) {
    MoeItem m; const int e = I / 21504, r = I - e * 21504, mat = r / 7168, it = r - mat * 7168;
    if (mat < 2) { const int nblk = DFFE / 32, kb = it / nblk, n0 = 32 * (it % nblk);
        m.W = (mat == 0 ? a.in[I_M1] : a.in[I_M3]) + (size_t)e * D * DFFE; m.N = DFFE; m.WT = ws + OFF_WM13 + (size_t)e * 2 * DFFE * D; m.ldt = D; m.k0 = 64 * kb; m.n0 = n0;
        m.drow0 = (n0 >> 7) * 256 + (n0 & 127) + (mat == 1 ? 128 : 0); m.gk = a.in[I_N2G] + D; m.wsc = SC_W13; }
    else { const int nblk = D / 32, kb = it / nblk, n0 = 32 * (it % nblk);
        m.W = a.in[I_M2] + (size_t)e * DFFE * D; m.N = D; m.WT = ws + OFF_WM2 + (size_t)e * D * DFFE; m.ldt = DFFE; m.k0 = 64 * kb; m.n0 = n0; m.drow0 = n0; m.gk = nullptr; m.wsc = SC_W2; }
    return m;
}
__device__ __forceinline__ void moe_convert_range(const Frame& F, const CAS Args& a, int i0, int i1, int wg0, int nwg) {
    if (F.bx < wg0 || F.bx >= wg0 + nwg) return;
    LAS float* scr = (LAS float*)(F.lds + F.wave * 16384);
    const int step = nwg * NWAVES;
    int I = i0 + (F.bx - wg0) * NWAVES + F.wave;
    if (I >= i1) return;
    MoeItem cur = moe_item(a, F.ws, I); f32x4 v[8]; cvt8_load(cur.W, cur.N, cur.k0, cur.n0, F.lane, v);
    for (;;) {
        const int In = I + step; const bool more = In < i1;
        MoeItem nxt = cur; f32x4 w[8];
        if (more) { nxt = moe_item(a, F.ws, In); cvt8_load(nxt.W, nxt.N, nxt.k0, nxt.n0, F.lane, w); }
        cvt8_finish(v, cur.WT, cur.ldt, cur.k0, cur.drow0, cur.gk, cur.wsc, scr, F.lane);
        if (!more) break;
        cur = nxt; I = In;
#pragma unroll
        for (int i = 0; i < 8; ++i) v[i] = w[i];
    }
}
constexpr int MOE_EARLY = 42000;
static_assert(!S5_BUILD_PRO || 2 * MOE_EARLY <= 4 * 21504, "layer 1's S5 operators live in the w1|w3 region of experts >= 4 until the F1 phase");
__device__ __forceinline__ void phase_s5_build(const Frame& F, const CAS Args& a, int layer, int wg0, int nwg);
__device__ __forceinline__ void phase_prologue(const Frame& F, const CAS Args& a) {
    unsigned char* ws = F.ws;
    if (S5_BUILD_PRO && (F.bx & 1)) { phase_s5_build(F, a, 0, 0, F.G); phase_s5_build(F, a, 1, 0, F.G); __syncthreads(); }
    { unsigned long long* ss = (unsigned long long*)(ws + OFF_SS); for (size_t i = (size_t)F.bx * NTHREADS + F.tid; i < 8 * (size_t)T; i += (size_t)F.G * NTHREADS) if (i >= (size_t)T) ss[i] = 0ull; }
    for (int l = 0; l < 2; ++l) {
        transpose_matrix(F, a.in[I_WIN] + (size_t)l * D * IN_COLS, D, IN_COLS, (bf16_t*)(ws + OFF_WIN + l * SZ_WIN), D, a.in[I_N1G] + l * D, 0);
        transpose_matrix(F, a.in[I_WOUT] + (size_t)l * D * D, D, D, (bf16_t*)(ws + OFF_WOUT + l * SZ_WOUT), D, a.in[I_AOG] + l * ATT_W, 0, a.in[I_SOG] + l * SS_W);
        transpose_matrix(F, a.in[I_GLUW] + (size_t)l * 512 * 512, 512, 512, (bf16_t*)(ws + OFF_WGLU + l * SZ_WGLU), 512, nullptr, 0);
    }
    if constexpr (FFN_FP8 & 1) { transpose_matrix8(F, a.in[I_F1], D, DFF, ws + OFF_W13, D, a.in[I_N2G], SC_W13, 1); transpose_matrix8(F, a.in[I_F3], D, DFF, ws + OFF_W13, D, a.in[I_N2G], SC_W13, 2); }
    else { transpose_matrix(F, a.in[I_F1], D, DFF, (bf16_t*)(ws + OFF_W13), D, a.in[I_N2G], 1); transpose_matrix(F, a.in[I_F3], D, DFF, (bf16_t*)(ws + OFF_W13), D, a.in[I_N2G], 2); }
    if constexpr (FFN_FP8 & 2) transpose_matrix8(F, a.in[I_F2], DFF, D, ws + OFF_W2, DFF, nullptr, SC_W2, 0);
    else transpose_matrix(F, a.in[I_F2], DFF, D, (bf16_t*)(ws + OFF_W2), DFF, nullptr, 0);
    for (int l = 0; l < 2; ++l) {
        bf16_t* bc = (bf16_t*)(ws + OFF_BCAT + l * SZ_BCAT);
        const float* w2 = a.in[I_W2] + (size_t)l * 64 * 512; const float* a2 = a.in[I_A2] + (size_t)l * 64 * 512; const float* g2 = a.in[I_G2] + (size_t)l * 128 * 512;
        for (int i = F.bx * NTHREADS + F.tid; i < 1536 * 256; i += F.G * NTHREADS) {
            const int n = i >> 8, k = i & 255, blk = n >> 9, nn = n & 511; float v = 0.f;
            if (blk == 0 && k < 64) v = w2[k * 512 + nn];
            else if (blk == 1 && k >= 64 && k < 128) v = a2[(k - 64) * 512 + nn];
            else if (blk == 2 && k >= 128) v = g2[(k - 128) * 512 + nn];
            bc[i] = (bf16_t)f2bf(v);
        }
    }
    { const float* x = a.in[I_X]; bf16_t* xb = (bf16_t*)(ws + OFF_XB); unsigned long long* ss0 = (unsigned long long*)(ws + OFF_SS);
      const int gw = F.bx * NWAVES + F.wave, NGW = F.G * NWAVES;
      for (int m = gw; m < T; m += NGW) {
          const f32x4* xr = (const f32x4*)(x + (size_t)m * D) + F.lane; u32x2* o8 = (u32x2*)(xb + (size_t)m * D) + F.lane; float s = 0.f;
#pragma unroll
          for (int j = 0; j < 8; ++j) { const f32x4 v = __builtin_nontemporal_load(xr + 64 * j); s += (v.x * v.x + v.y * v.y) + (v.z * v.z + v.w * v.w); u32x2 w; w.x = pk2(v.x, v.y); w.y = pk2(v.z, v.w); o8[64 * j] = w; }
          s = wave_sum(s); if (F.lane == 0) ss0[m] = ss_fix(s);
      } }
    if (S5_BUILD_PRO && !(F.bx & 1)) { __syncthreads(); phase_s5_build(F, a, 0, 0, F.G); phase_s5_build(F, a, 1, 0, F.G); }
}

struct EpiInProj {
    static constexpr bool PERM = true, MID = false;
    const unsigned long long* ssq; bf16_t* zatt; bf16_t* zrw; bf16_t* uext;
    __device__ __forceinline__ void operator()(const f32x4 (&acc)[2][2][4][2], const Unit& u, int wr, int wc, int fr, int fq) const {
        const int row0 = u.pm * 256 + wr * 64 + fr, colt = wc * 32 + 8 * fq;
        float rsv[2][4];
#pragma unroll
        for (int ai = 0; ai < 2; ++ai)
#pragma unroll
            for (int m = 0; m < 4; ++m) rsv[ai][m] = ss_rs(ssq[row0 + ai * 128 + m * 16]);
#pragma unroll
        for (int ai = 0; ai < 2; ++ai)
#pragma unroll
            for (int m = 0; m < 4; ++m) {
                const int row = row0 + ai * 128 + m * 16; const float rs = rsv[ai][m];
#pragma unroll
                for (int bj = 0; bj < 2; ++bj) {
                    const f32x4 v0 = acc[ai][bj][m][0] * rs, v1 = acc[ai][bj][m][1] * rs;
                    u32x4 w; w.x = cvt_pk_bf16(v0[0], v0[1]); w.y = cvt_pk_bf16(v0[2], v0[3]); w.z = cvt_pk_bf16(v1[0], v1[1]); w.w = cvt_pk_bf16(v1[2], v1[3]);
                    const int ct = bj * 128 + colt;
                    if (u.pn < 6) *(u32x4*)(zatt + (size_t)row * ZATT_W + u.pn * 256 + ct) = w;
                    else if (u.pn < 13) *(u32x4*)(zrw + (size_t)row * RW_COLS + (u.pn - 6) * 256 + ct) = w;
                    else { const int ch = (u.pn - 13) * 256 + ct, g = ch >> 4, half = (ch >> 3) & 1;
                           *(u32x4*)(uext + ((size_t)(g * 512 + (row >> 6)) * S5K + (row & 63) * 16 + half * 8)) = w; }
                }
            }
    }
};

template <bool OUT8, bool MIX = false, bool H16IN = true, bool COPY = true> struct EpiResid {
    static constexpr bool PERM = true, MID = MIX; static constexpr int T1 = 16, T2 = 24;
    const void* hold; bf16_t* hnew; void* xb; unsigned long long* ssq; float asc; const unsigned long long* ssA; const unsigned long long* ssS;
    __device__ __forceinline__ void mid(f32x4 (&acc)[2][2][4][2], const Unit& u, int wr, int fr, int which) const {
        const int row0 = u.pm * 256 + wr * 64 + fr; float f[2][4];
#pragma unroll
        for (int ai = 0; ai < 2; ++ai)
#pragma unroll
            for (int m = 0; m < 4; ++m) { const int row = row0 + ai * 128 + m * 16; f[ai][m] = which == 0 ? rsqrtf(ss_mean(ssA[row], 1.0f / ATT_W)) : sqrtf(ss_mean(ssS[row], 1.0f / SS_W)); }
#pragma unroll
        for (int ai = 0; ai < 2; ++ai)
#pragma unroll
            for (int bj = 0; bj < 2; ++bj)
#pragma unroll
                for (int m = 0; m < 4; ++m)
#pragma unroll
                    for (int n = 0; n < 2; ++n) acc[ai][bj][m][n] *= f[ai][m];
    }
    __device__ __forceinline__ void operator()(const f32x4 (&acc)[2][2][4][2], const Unit& u, int wr, int wc, int fr, int fq) const {
        const int row0 = u.pm * 256 + wr * 64 + fr, col0 = u.pn * 256 + wc * 32 + 8 * fq;
#pragma unroll
        for (int ai = 0; ai < 2; ++ai) {
            f32x4 hv[4][2][2];
#pragma unroll
            for (int m = 0; m < 4; ++m)
#pragma unroll
                for (int bj = 0; bj < 2; ++bj) { const size_t off = (size_t)(row0 + ai * 128 + m * 16) * D + col0 + bj * 128;
                    if constexpr (H16IN) { const u32x4 hb = *(const u32x4*)((const bf16_t*)hold + off);
                        hv[m][bj][0] = (f32x4){bflo(hb.x), bfhi(hb.x), bflo(hb.y), bfhi(hb.y)}; hv[m][bj][1] = (f32x4){bflo(hb.z), bfhi(hb.z), bflo(hb.w), bfhi(hb.w)}; }
                    else { hv[m][bj][0] = *(const f32x4*)((const float*)hold + off); hv[m][bj][1] = *(const f32x4*)((const float*)hold + off + 4); } }
#pragma unroll
            for (int m = 0; m < 4; ++m) {
                const int row = row0 + ai * 128 + m * 16; float s = 0.f; const float sc = MIX ? asc * rsqrtf(ss_mean(ssS[row], 1.0f / SS_W)) : asc;
#pragma unroll
                for (int bj = 0; bj < 2; ++bj) {
                    const size_t off = (size_t)row * D + col0 + bj * 128;
                    const f32x4 v0 = acc[ai][bj][m][0] * sc + hv[m][bj][0], v1 = acc[ai][bj][m][1] * sc + hv[m][bj][1];
                    { u32x4 w; w.x = cvt_pk_bf16(v0[0], v0[1]); w.y = cvt_pk_bf16(v0[2], v0[3]); w.z = cvt_pk_bf16(v1[0], v1[1]); w.w = cvt_pk_bf16(v1[2], v1[3]);
                      *(u32x4*)(hnew + off) = w; }
                    if constexpr (COPY && OUT8) { u32x2 w; w.x = pk8(clamp8(v0[0] * SC_H), clamp8(v0[1] * SC_H), clamp8(v0[2] * SC_H), clamp8(v0[3] * SC_H)); w.y = pk8(clamp8(v1[0] * SC_H), clamp8(v1[1] * SC_H), clamp8(v1[2] * SC_H), clamp8(v1[3] * SC_H));
                        *(u32x2*)((unsigned char*)xb + off) = w; }
                    else if constexpr (COPY) { u32x4 w; w.x = cvt_pk_bf16(v0[0], v0[1]); w.y = cvt_pk_bf16(v0[2], v0[3]); w.z = cvt_pk_bf16(v1[0], v1[1]); w.w = cvt_pk_bf16(v1[2], v1[3]);
                        *(u32x4*)((bf16_t*)xb + off) = w; }
                    s += (v0[0] * v0[0] + v0[1] * v0[1]) + (v0[2] * v0[2] + v0[3] * v0[3]) + (v1[0] * v1[0] + v1[1] * v1[1]) + (v1[2] * v1[2] + v1[3] * v1[3]);
                }
                s += __shfl_xor(s, 16); s += __shfl_xor(s, 32);
                if (fq == 0) atomicAdd(ssq + row, ss_fix(s));
            }
            asm volatile("" ::: "memory");
        }
    }
};

constexpr int AT_KN = 0, AT_KROW = 72;
constexpr int AT_VT = 256 * AT_KROW * 2, AT_VROW = 264;
constexpr int AT_TB = AT_VT + 64 * AT_VROW * 2;
__device__ __forceinline__ int t5_bucket(int d) {
    if (d < 16) return d;
    int lg = 16 + (int)(logf((float)d / 16.0f) / 2.0794415416798357f * 16.0f);
    return lg < 31 ? lg : 31;
}
__device__ __forceinline__ void phase_attention(const Frame& F, const CAS Args& a, int layer) {
    const bf16_t* zatt = (const bf16_t*)(F.ws + MO(B_ZATT)); bf16_t* mixed = (bf16_t*)(F.ws + MO(B_MIXED));
    unsigned long long* ssA = (unsigned long long*)(F.ws + OFF_SS) + (size_t)(4 + 2 * layer) * T;
    const float* qg = a.in[I_QG] + layer * 64; const float* kg = a.in[I_KG] + layer * 64; const float* sinks = a.in[I_SINK] + layer * 16; const float* relb = a.in[I_RELB];
    LAS bf16_t* Kn = (LAS bf16_t*)(F.lds + AT_KN); LAS bf16_t* Vt = (LAS bf16_t*)(F.lds + AT_VT); LAS float* tb = (LAS float*)(F.lds + AT_TB);
    const int lane = F.lane, qi = lane & 15, q4 = lane >> 4;
    for (int unit = F.bx; unit < 1024; unit += F.G) {
        const int kvh = unit & 3, n = (unit >> 2) & 127, b = unit >> 9;
        __syncthreads();
        {
            const int key = F.tid >> 1, half = F.tid & 1, tk = (n - 1) * 128 + key; const bool valid = tk >= 0;
            const size_t row = (size_t)b * SEQ + (valid ? tk : 0);
            const u32x4* kp = (const u32x4*)(zatt + row * ZATT_W + ATT_W + kvh * 64 + half * 32);
            const u32x4* vp = (const u32x4*)(zatt + row * ZATT_W + ATT_W + KV_W + kvh * 64 + half * 32);
            u32x4 kr[4], vr[4];
#pragma unroll
            for (int i = 0; i < 4; ++i) { kr[i] = kp[i]; vr[i] = vp[i]; }
            float kf[32]; float ss = 0.f;
#pragma unroll
            for (int i = 0; i < 4; ++i) { const unsigned w[4] = {kr[i].x, kr[i].y, kr[i].z, kr[i].w};
#pragma unroll
                for (int j = 0; j < 4; ++j) { const float lo = bflo(w[j]), hi = bfhi(w[j]); kf[i * 8 + 2 * j] = lo; kf[i * 8 + 2 * j + 1] = hi; ss += lo * lo + hi * hi; } }
            ss += __shfl_xor(ss, 1);
            const float rs = valid ? rsqrtf(ss * (1.0f / 64.0f) + NORM_EPS) : 0.f;
#pragma unroll
            for (int i = 0; i < 4; ++i) { u32x4 o;
                o.x = pk2(kf[i * 8 + 0] * rs * kg[half * 32 + i * 8 + 0], kf[i * 8 + 1] * rs * kg[half * 32 + i * 8 + 1]);
                o.y = pk2(kf[i * 8 + 2] * rs * kg[half * 32 + i * 8 + 2], kf[i * 8 + 3] * rs * kg[half * 32 + i * 8 + 3]);
                o.z = pk2(kf[i * 8 + 4] * rs * kg[half * 32 + i * 8 + 4], kf[i * 8 + 5] * rs * kg[half * 32 + i * 8 + 5]);
                o.w = pk2(kf[i * 8 + 6] * rs * kg[half * 32 + i * 8 + 6], kf[i * 8 + 7] * rs * kg[half * 32 + i * 8 + 7]);
                *(LAS u32x4*)(Kn + key * AT_KROW + half * 32 + i * 8) = o; }
#pragma unroll
            for (int i = 0; i < 4; ++i) { const unsigned w[4] = {vr[i].x, vr[i].y, vr[i].z, vr[i].w};
#pragma unroll
                for (int j = 0; j < 4; ++j) { const int d = half * 32 + i * 8 + 2 * j;
                    Vt[d * AT_VROW + key] = valid ? (bf16_t)(w[j] & 0xffffu) : (bf16_t)0; Vt[(d + 1) * AT_VROW + key] = valid ? (bf16_t)(w[j] >> 16) : (bf16_t)0; } }
            const int g = F.tid >> 7, dist = F.tid & 127;
            tb[g * 128 + dist] = relb[t5_bucket(dist) * 16 + kvh * 4 + g];
        }
        __syncthreads();
        for (int grp = F.wave; grp < 32; grp += NWAVES) {
            const int g = grp >> 3, qb = grp & 7, h = kvh * 4 + g, i0 = qb * 16;
            const size_t rowq = (size_t)b * SEQ + n * 128 + i0 + qi;
            bf16x8 qf[2];
            {   const u32x4 q0 = *(const u32x4*)(zatt + rowq * ZATT_W + h * 64 + q4 * 8), q1 = *(const u32x4*)(zatt + rowq * ZATT_W + h * 64 + 32 + q4 * 8);
                const unsigned w[8] = {q0.x, q0.y, q0.z, q0.w, q1.x, q1.y, q1.z, q1.w}; float qv[16]; float ss = 0.f;
#pragma unroll
                for (int j = 0; j < 8; ++j) { qv[2 * j] = bflo(w[j]); qv[2 * j + 1] = bfhi(w[j]); ss += qv[2 * j] * qv[2 * j] + qv[2 * j + 1] * qv[2 * j + 1]; }
                ss += __shfl_xor(ss, 16); ss += __shfl_xor(ss, 32);
                const float rs = rsqrtf(ss * (1.0f / 64.0f) + NORM_EPS) * 0.125f;
#pragma unroll
                for (int ks = 0; ks < 2; ++ks) { u32x4 o;
                    const float* gq = qg + ks * 32 + q4 * 8; const float* qq = qv + ks * 8;
                    o.x = pk2(qq[0] * rs * gq[0], qq[1] * rs * gq[1]); o.y = pk2(qq[2] * rs * gq[2], qq[3] * rs * gq[3]);
                    o.z = pk2(qq[4] * rs * gq[4], qq[5] * rs * gq[5]); o.w = pk2(qq[6] * rs * gq[6], qq[7] * rs * gq[7]);
                    qf[ks] = __builtin_bit_cast(bf16x8, o); }
            }
            f32x4 s[9];
#pragma unroll
            for (int kbi = 0; kbi < 9; ++kbi) {
                f32x4 c = (f32x4){0.f, 0.f, 0.f, 0.f};
#pragma unroll
                for (int ks = 0; ks < 2; ++ks) {
                    const bf16x8 kfr = *(const LAS bf16x8*)(Kn + (16 * (qb + kbi) + qi) * AT_KROW + ks * 32 + q4 * 8);
                    c = __builtin_amdgcn_mfma_f32_16x16x32_bf16(kfr, qf[ks], c, 0, 0, 0);
                }
                s[kbi] = c;
            }
            const float sink = sinks[h]; float mx = sink;
#pragma unroll
            for (int kbi = 0; kbi < 9; ++kbi)
#pragma unroll
                for (int r = 0; r < 4; ++r) {
                    const int j = 16 * (qb + kbi) + 4 * q4 + r, dist = 128 + i0 + qi - j;
                    const bool valid = dist >= 0 && dist < 128 && (n > 0 || j >= 128);
                    const float v = valid ? s[kbi][r] + tb[g * 128 + (dist & 127)] : -INFINITY;
                    s[kbi][r] = v; mx = fmaxf(mx, v);
                }
            mx = fmaxf(mx, __shfl_xor(mx, 16)); mx = fmaxf(mx, __shfl_xor(mx, 32));
            float sum = 0.f;
#pragma unroll
            for (int kbi = 0; kbi < 9; ++kbi)
#pragma unroll
                for (int r = 0; r < 4; ++r) { const float p = __expf(s[kbi][r] - mx); s[kbi][r] = p; sum += p; }
            sum += __shfl_xor(sum, 16); sum += __shfl_xor(sum, 32);
            const float inv = frcp(sum + __expf(sink - mx));
            bf16x8 pf[5];
#pragma unroll
            for (int pp = 0; pp < 5; ++pp) { u32x4 o; o.x = pk2(s[2 * pp][0], s[2 * pp][1]); o.y = pk2(s[2 * pp][2], s[2 * pp][3]);
                if (pp < 4) { o.z = pk2(s[2 * pp + 1][0], s[2 * pp + 1][1]); o.w = pk2(s[2 * pp + 1][2], s[2 * pp + 1][3]); } else { o.z = 0u; o.w = 0u; }
                pf[pp] = __builtin_bit_cast(bf16x8, o); }
            float osq = 0.f;
#pragma unroll
            for (int db = 0; db < 4; ++db) {
                f32x4 o = (f32x4){0.f, 0.f, 0.f, 0.f};
#pragma unroll
                for (int pp = 0; pp < 5; ++pp) {
                    const LAS bf16_t* vrow = Vt + (16 * db + qi) * AT_VROW + 4 * q4;
                    const u32x2 va = *(const LAS u32x2*)(vrow + 16 * (qb + 2 * pp));
                    const u32x2 vb = *(const LAS u32x2*)(vrow + 16 * (qb + (pp < 4 ? 2 * pp + 1 : 2 * pp)));
                    u32x4 vv; vv.x = va.x; vv.y = va.y; vv.z = vb.x; vv.w = vb.y;
                    o = __builtin_amdgcn_mfma_f32_16x16x32_bf16(__builtin_bit_cast(bf16x8, vv), pf[pp], o, 0, 0, 0);
                }
                o = o * inv; osq += (o[0] * o[0] + o[1] * o[1]) + (o[2] * o[2] + o[3] * o[3]);
                u32x2 w; w.x = pk2(o[0], o[1]); w.y = pk2(o[2], o[3]);
                *(u32x2*)(mixed + rowq * D + h * 64 + 16 * db + 4 * q4) = w;
            }
            osq += __shfl_xor(osq, 16); osq += __shfl_xor(osq, 32);
            if (q4 == 0) atomicAdd(ssA + rowq, ss_fix(osq));
        }
    }
}

__device__ __forceinline__ void phase_finalize_mixed(const Frame& F, const CAS Args& a, int layer, int dbg_zero) {
    const bf16_t* attraw = (const bf16_t*)(F.ws + MO(B_ATTRAW)); const bf16_t* ssraw = (const bf16_t*)(F.ws + MO(B_SSRAW)); bf16_t* mixed = (bf16_t*)(F.ws + MO(B_MIXED));
    const float* aog = a.in[I_AOG] + layer * ATT_W; const float* sog = a.in[I_SOG] + layer * SS_W;
    const int gw = F.bx * NWAVES + F.wave, NGW = F.G * NWAVES, lane = F.lane;
    for (int m = gw; m < T; m += NGW) {
        {   const u32x4* p = (const u32x4*)(attraw + (size_t)m * ATT_W) + lane * 2; const u32x4 v0 = p[0], v1 = p[1];
            const unsigned w[8] = {v0.x, v0.y, v0.z, v0.w, v1.x, v1.y, v1.z, v1.w}; float f[16]; float ss = 0.f;
#pragma unroll
            for (int j = 0; j < 8; ++j) { f[2 * j] = bflo(w[j]); f[2 * j + 1] = bfhi(w[j]); ss += f[2 * j] * f[2 * j] + f[2 * j + 1] * f[2 * j + 1]; }
            ss = wave_sum(ss); const float rs = rsqrtf(ss * (1.0f / ATT_W) + NORM_EPS); const float* g = aog + lane * 16;
            u32x4 o0, o1;
            o0.x = pk2(f[0] * rs * g[0], f[1] * rs * g[1]); o0.y = pk2(f[2] * rs * g[2], f[3] * rs * g[3]); o0.z = pk2(f[4] * rs * g[4], f[5] * rs * g[5]); o0.w = pk2(f[6] * rs * g[6], f[7] * rs * g[7]);
            o1.x = pk2(f[8] * rs * g[8], f[9] * rs * g[9]); o1.y = pk2(f[10] * rs * g[10], f[11] * rs * g[11]); o1.z = pk2(f[12] * rs * g[12], f[13] * rs * g[13]); o1.w = pk2(f[14] * rs * g[14], f[15] * rs * g[15]);
            u32x4* q = (u32x4*)(mixed + (size_t)m * D) + lane * 2; q[0] = o0; q[1] = o1; }
        {   const u32x4 v0 = *((const u32x4*)(ssraw + (size_t)m * SS_W) + lane);
            const unsigned w[4] = {v0.x, v0.y, v0.z, v0.w}; float f[8]; float ss = 0.f;
#pragma unroll
            for (int j = 0; j < 4; ++j) { f[2 * j] = bflo(w[j]); f[2 * j + 1] = bfhi(w[j]); ss += f[2 * j] * f[2 * j] + f[2 * j + 1] * f[2 * j + 1]; }
            ss = wave_sum(ss); const float rs = rsqrtf(ss * (1.0f / SS_W) + NORM_EPS); const float* g = sog + lane * 8;
            u32x4 o0; o0.x = pk2(f[0] * rs * g[0], f[1] * rs * g[1]); o0.y = pk2(f[2] * rs * g[2], f[3] * rs * g[3]); o0.z = pk2(f[4] * rs * g[4], f[5] * rs * g[5]); o0.w = pk2(f[6] * rs * g[6], f[7] * rs * g[7]);
            if (dbg_zero & 2) o0 = (u32x4){0u, 0u, 0u, 0u};
            *((u32x4*)(mixed + (size_t)m * D + 1536) + lane) = o0; }
        if (dbg_zero & 1) *((u32x4*)(mixed + (size_t)m * D + 1024) + lane) = (u32x4){0u, 0u, 0u, 0u};
    }
}

constexpr int S5L_PWR = 0, S5L_PWI = 65 * 64 * 4, S5L_BBR = 2 * 65 * 64 * 4, S5L_BBI = S5L_BBR + 4096, S5L_CR = S5L_BBI + 4096, S5L_CI = S5L_CR + 4096, S5L_KT = S5L_CI + 4096;
static_assert(S5L_KT + 64 * 256 * 4 <= RING_BYTES, "S5 build LDS");
__device__ __forceinline__ void phase_s5_build(const Frame& F, const CAS Args& a, int layer, int wg0, int nwg) {
    LAS float* pwr = (LAS float*)(F.lds + S5L_PWR); LAS float* pwi = (LAS float*)(F.lds + S5L_PWI);
    LAS float* bbr = (LAS float*)(F.lds + S5L_BBR); LAS float* bbi = (LAS float*)(F.lds + S5L_BBI);
    LAS float* cr = (LAS float*)(F.lds + S5L_CR); LAS float* ci = (LAS float*)(F.lds + S5L_CI); LAS float* kt = (LAS float*)(F.lds + S5L_KT);
    const int tid = F.tid;
    if (F.bx < wg0 || F.bx >= wg0 + nwg) return;
    for (int wi = F.bx - wg0; wi < 256; wi += nwg) {
        const int g = wi >> 3, part = wi & 7;
        __syncthreads();
        const int lg = layer * 32 + g;
        const float dt = expf(a.in[I_DT][lg]);
        {   const int p = tid & 63; const float lr = a.in[I_LRE][lg * 64 + p], li = a.in[I_LIM][lg * 64 + p];
            for (int tau = tid >> 6; tau <= 64; tau += 8) { const float mag = expf(lr * dt * (float)tau); float sn, cs; sincosf(li * dt * (float)tau, &sn, &cs); pwr[tau * 64 + p] = mag * cs; pwi[tau * 64 + p] = mag * sn; } }
        __syncthreads();
        for (int i = tid; i < 1024; i += NTHREADS) {
            const int p = i >> 4;
            const float lr = a.in[I_LRE][lg * 64 + p], li = a.in[I_LIM][lg * 64 + p], den = lr * lr + li * li;
            const float are = pwr[64 + p] - 1.0f, aim = pwi[64 + p];
            const float fr = (are * lr + aim * li) / den, fi = (aim * lr - are * li) / den;
            const float br = a.in[I_BRE][(size_t)lg * 1024 + i], bi = a.in[I_BIM][(size_t)lg * 1024 + i];
            bbr[i] = fr * br - fi * bi; bbi[i] = fr * bi + fi * br;
            cr[i] = a.in[I_CRE][(size_t)lg * 1024 + i]; ci[i] = a.in[I_CIM][(size_t)lg * 1024 + i];
        }
        __syncthreads();
        {
            const int mp = tid & 15, ml = (tid >> 4) & 1, m = 2 * part + ml, th = tid >> 5;
            float acc[4] = {0.f, 0.f, 0.f, 0.f};
            for (int p = 0; p < 64; ++p) {
                const float c_r = cr[m * 64 + p], c_i = ci[m * 64 + p], b_r = bbr[p * 16 + mp], b_i = bbi[p * 16 + mp];
                const float cbr = c_r * b_r - c_i * b_i, cbi = c_r * b_i + c_i * b_r;
#pragma unroll
                for (int j = 0; j < 4; ++j) { const int tau = 4 * th + j; acc[j] += pwr[tau * 64 + p] * cbr - pwi[tau * 64 + p] * cbi; }
            }
            if (th == 0 && m == mp) acc[0] += a.in[I_SD][layer * 512 + g * 16 + m];
#pragma unroll
            for (int j = 0; j < 4; ++j) kt[(4 * th + j) * 32 + ml * 16 + mp] = acc[j];
        }
        __syncthreads();
        bf16_t* B2 = (bf16_t*)(F.ws + (S5_BUILD_PRO ? s5b2_off(layer) : OFF_S5B2)) + (size_t)g * 1024 * S5K;
        for (int ch = tid; ch < 128 * 144; ch += NTHREADS) {
            const int nl = ch / 144, kc = ch % 144, t = nl >> 1, ml = nl & 1, m = 2 * part + ml, n = t * 16 + m; float v[8];
            if (kc < 128) { const int s = kc >> 1, m0 = (kc & 1) * 8;
#pragma unroll
                for (int j = 0; j < 8; ++j) v[j] = (s <= t) ? kt[(t - s) * 32 + ml * 16 + m0 + j] : 0.f; }
            else { const int p0 = (kc - 128) * 4;
#pragma unroll
                for (int j = 0; j < 4; ++j) { const int p = p0 + j; const float c_r = cr[m * 64 + p], c_i = ci[m * 64 + p], w_r = pwr[(t + 1) * 64 + p], w_i = pwi[(t + 1) * 64 + p];
                    v[2 * j] = c_r * w_r - c_i * w_i; v[2 * j + 1] = -(c_r * w_i + c_i * w_r); } }
            u32x4 o; o.x = pk2(v[0], v[1]); o.y = pk2(v[2], v[3]); o.z = pk2(v[4], v[5]); o.w = pk2(v[6], v[7]);
            *(u32x4*)(B2 + (size_t)n * S5K + kc * 8) = o;
        }
        bf16_t* E = (bf16_t*)(F.ws + (S5_BUILD_PRO ? s5e_off(layer) : OFF_S5E)) + (size_t)g * 256 * 1024;
        for (int ch = part * 32 * 128 + tid; ch < (part + 1) * 32 * 128; ch += NTHREADS) {
            const int n = ch >> 7, kc = ch & 127, s = kc >> 1, m0 = (kc & 1) * 8; float v[8];
            if (n < 128) { const int p = n >> 1, ri = n & 1; const float w_r = pwr[(63 - s) * 64 + p], w_i = pwi[(63 - s) * 64 + p];
#pragma unroll
                for (int j = 0; j < 8; ++j) { const float b_r = bbr[p * 16 + m0 + j], b_i = bbi[p * 16 + m0 + j]; v[j] = ri == 0 ? (w_r * b_r - w_i * b_i) : (w_r * b_i + w_i * b_r); } }
            else {
#pragma unroll
                for (int j = 0; j < 8; ++j) v[j] = 0.f; }
            u32x4 o; o.x = pk2(v[0], v[1]); o.y = pk2(v[2], v[3]); o.z = pk2(v[4], v[5]); o.w = pk2(v[6], v[7]);
            *(u32x4*)(E + (size_t)n * 1024 + kc * 8) = o;
        }
    }
}
struct ProbS5a {
    static constexpr bool FP8 = false;
    const bf16_t* A; const bf16_t* Bt; int K, lda, ldb, G, c;
    __device__ __forceinline__ bool next(int i, Unit& u) const { const int L = i * G + c; if (L >= 64) return false; u.pm = L; u.pn = L >> 1; return true; }
    __device__ __forceinline__ const char* abase(const Unit& u) const { return (const char*)(A + (size_t)u.pm * 256 * lda); }
    __device__ __forceinline__ const char* bbase(const Unit& u) const { return (const char*)(Bt + (size_t)u.pn * 256 * ldb); }
};
struct EpiS5a {
    static constexpr bool PERM = false, MID = false;
    float* xloc;
    __device__ __forceinline__ void operator()(const f32x4 (&acc)[2][2][4][2], const Unit& u, int wr, int wc, int fr, int fq) const {
        const int row0 = u.pm * 256 + wr * 64 + fr, col0 = wc * 32 + 4 * fq;
#pragma unroll
        for (int ai = 0; ai < 2; ++ai)
#pragma unroll
            for (int m = 0; m < 4; ++m) { float* rp = xloc + (size_t)(row0 + ai * 128 + m * 16) * 128 + col0;
#pragma unroll
                for (int n = 0; n < 2; ++n) *(f32x4*)(rp + n * 16) = acc[ai][0][m][n]; }
    }
};
__device__ __forceinline__ void phase_s5_scan(const Frame& F, const CAS Args& a, int layer) {
    const int gt = F.bx * NTHREADS + F.tid; if (gt >= 4096) return;
    const int p = gt & 63, b = (gt >> 6) & 1, g = gt >> 7, lg = layer * 32 + g;
    const float dt = expf(a.in[I_DT][lg]), lr = a.in[I_LRE][lg * 64 + p], li = a.in[I_LIM][lg * 64 + p];
    const float mag = expf(lr * dt * 64.0f); float sn, cs; sincosf(li * dt * 64.0f, &sn, &cs); const float ar = mag * cs, ai = mag * sn;
    const float* xl = (const float*)(F.ws + MO(B_XLOC)) + (size_t)(g * 512 + b * 256) * 128 + 2 * p;
    unsigned* ux = (unsigned*)((bf16_t*)(F.ws + MO(B_UEXT)) + (size_t)(g * 512 + b * 256) * S5K + 1024 + 2 * p);
    float xr = 0.f, xi = 0.f;
    for (int cb = 0; cb < 256; cb += 32) {
        f32x2 l[32];
#pragma unroll
        for (int j = 0; j < 32; ++j) l[j] = *(const f32x2*)(xl + (size_t)(cb + j) * 128);
#pragma unroll
        for (int j = 0; j < 32; ++j) {
            ux[(size_t)(cb + j) * (S5K / 2)] = pk2(xr, xi);
            const float nr = ar * xr - ai * xi + l[j].x, ni = ar * xi + ai * xr + l[j].y; xr = nr; xi = ni;
        }
    }
}
struct ProbS5b {
    static constexpr bool FP8 = false;
    const bf16_t* A; const bf16_t* Bt; int K, lda, ldb, G, c;
    __device__ __forceinline__ bool next(int i, Unit& u) const { const int L = i * G + c; if (L < 0 || L >= 256) return false; u.pm = L >> 2; u.pn = (L >> 3) * 4 + (L & 3); return true; }
    __device__ __forceinline__ const char* abase(const Unit& u) const { return (const char*)(A + (size_t)u.pm * 256 * lda); }
    __device__ __forceinline__ const char* bbase(const Unit& u) const { return (const char*)(Bt + (size_t)u.pn * 256 * ldb); }
};
__device__ __forceinline__ float gelu_tanh(float x) { return x * frcp(1.0f + __builtin_amdgcn_exp2f(-2.3022082594043835f * (x + 0.044715f * x * x * x))); }
struct EpiS5b {
    static constexpr bool PERM = true, MID = false;
    bf16_t* zg;
    __device__ __forceinline__ void operator()(const f32x4 (&acc)[2][2][4][2], const Unit& u, int wr, int wc, int fr, int fq) const {
        const int row0 = u.pm * 256 + wr * 64 + fr, colt = (u.pn & 3) * 256 + wc * 32 + 8 * fq;
#pragma unroll
        for (int ai = 0; ai < 2; ++ai)
#pragma unroll
            for (int m = 0; m < 4; ++m) {
                const int rg = row0 + ai * 128 + m * 16, g = rg >> 9, bc = rg & 511;
#pragma unroll
                for (int bj = 0; bj < 2; ++bj) {
                    const int n = colt + bj * 128, t = n >> 4, m0 = n & 15; const size_t tok = (size_t)(bc >> 8) * SEQ + (bc & 255) * 64 + t;
                    const f32x4 v0 = acc[ai][bj][m][0], v1 = acc[ai][bj][m][1];
                    u32x4 w; w.x = pk2(gelu_tanh(v0[0]), gelu_tanh(v0[1])); w.y = pk2(gelu_tanh(v0[2]), gelu_tanh(v0[3])); w.z = pk2(gelu_tanh(v1[0]), gelu_tanh(v1[1])); w.w = pk2(gelu_tanh(v1[2]), gelu_tanh(v1[3]));
                    *(u32x4*)(zg + tok * 512 + g * 16 + m0) = w;
                }
            }
    }
};
struct EpiGlu {
    static constexpr bool PERM = true, MID = false;
    const bf16_t* zg; const float* glub; bf16_t* mixed; unsigned long long* ssS;
    __device__ __forceinline__ void operator()(const f32x4 (&acc)[2][2][4][2], const Unit& u, int wr, int wc, int fr, int fq) const {
        const int row0 = u.pm * 256 + wr * 64 + fr, col0 = u.pn * 256 + wc * 32 + 8 * fq;
#pragma unroll
        for (int ai = 0; ai < 2; ++ai)
#pragma unroll
            for (int m = 0; m < 4; ++m) {
                const size_t row = (size_t)(row0 + ai * 128 + m * 16); float sq = 0.f;
#pragma unroll
                for (int bj = 0; bj < 2; ++bj) {
                    const int n = col0 + bj * 128; const u32x4 z = *(const u32x4*)(zg + row * 512 + n);
                    const f32x4 b0 = *(const f32x4*)(glub + n), b1 = *(const f32x4*)(glub + n + 4);
                    const f32x4 v0 = acc[ai][bj][m][0] + b0, v1 = acc[ai][bj][m][1] + b1;
                    const float e0 = bflo(z.x) * sigmoidf_(v0[0]), e1 = bfhi(z.x) * sigmoidf_(v0[1]), e2 = bflo(z.y) * sigmoidf_(v0[2]), e3 = bfhi(z.y) * sigmoidf_(v0[3]);
                    const float e4 = bflo(z.z) * sigmoidf_(v1[0]), e5 = bfhi(z.z) * sigmoidf_(v1[1]), e6 = bflo(z.w) * sigmoidf_(v1[2]), e7 = bfhi(z.w) * sigmoidf_(v1[3]);
                    sq += (e0 * e0 + e1 * e1) + (e2 * e2 + e3 * e3) + (e4 * e4 + e5 * e5) + (e6 * e6 + e7 * e7);
                    u32x4 w; w.x = pk2(e0, e1); w.y = pk2(e2, e3); w.z = pk2(e4, e5); w.w = pk2(e6, e7);
                    *(u32x4*)(mixed + row * D + 1536 + n) = w;
                }
                sq += __shfl_xor(sq, 16); sq += __shfl_xor(sq, 32);
                if (fq == 0) atomicAdd(ssS + row, ss_fix(sq));
            }
    }
};

__device__ __forceinline__ void phase_rw_prep1(const Frame& F, const CAS Args& a, int layer) {
    const bf16_t* zrw = (const bf16_t*)(F.ws + MO(B_ZRW)); bf16_t* al = (bf16_t*)(F.ws + MO(B_ALORA)); const float* mu = a.in[I_MU] + layer * RW_COLS;
    const int lane = F.lane, gw = F.bx * NWAVES + F.wave, NGW = F.G * NWAVES;
    const int sc = lane < 16 ? 512 + 4 * lane : (lane < 32 ? 1600 + 4 * (lane - 16) : 1664 + 4 * (lane - 32));
    const f32x4 m4 = *(const f32x4*)(mu + sc);
    for (int row0 = gw; row0 < T; row0 += 4 * NGW) {
        u32x2 zc[4], zp[4];
#pragma unroll
        for (int u = 0; u < 4; ++u) { const int row = min(row0 + u * NGW, T - 1);
            zc[u] = *(const u32x2*)(zrw + (size_t)row * RW_COLS + sc);
            zp[u] = (u32x2){0u, 0u}; if ((row & (SEQ - 1)) != 0) zp[u] = *(const u32x2*)(zrw + (size_t)(row - 1) * RW_COLS + sc); }
#pragma unroll
        for (int u = 0; u < 4; ++u) { const int row = row0 + u * NGW; if (row >= T) break;
            float z[4] = {bflo(zc[u].x), bfhi(zc[u].x), bflo(zc[u].y), bfhi(zc[u].y)}; const float p[4] = {bflo(zp[u].x), bfhi(zp[u].x), bflo(zp[u].y), bfhi(zp[u].y)};
#pragma unroll
            for (int j = 0; j < 4; ++j) { float v = z[j] + m4[j] * (p[j] - z[j]); v = lane < 16 ? tanhf(v) : (lane < 32 ? v : sigmoidf_(v)); z[j] = v; }
            u32x2 o; o.x = pk2(z[0], z[1]); o.y = pk2(z[2], z[3]);
            *(u32x2*)(al + (size_t)row * 256 + 4 * lane) = o; }
    }
}
struct ProbLora {
    static constexpr bool FP8 = false;
    const bf16_t* A; const bf16_t* Bt; int K, lda, ldb, nM, nN, G, c;
    __device__ __forceinline__ bool next(int i, Unit& u) const { return pg8::static_unit(i * G + c, nM, nN, u); }
    __device__ __forceinline__ const char* abase(const Unit& u) const { return (const char*)(A + (size_t)u.pm * 256 * lda + (u.pn >= 4 ? 128 : 0)); }
    __device__ __forceinline__ const char* bbase(const Unit& u) const { return (const char*)(Bt + (size_t)u.pn * 256 * ldb + (u.pn >= 4 ? 128 : 0)); }
};
struct EpiLora {
    static constexpr bool PERM = true, MID = false;
    bf16_t* dec; bf16_t* iclr; bf16_t* gate;
    __device__ __forceinline__ void operator()(const f32x4 (&acc)[2][2][4][2], const Unit& u, int wr, int wc, int fr, int fq) const {
        const int row0 = u.pm * 256 + wr * 64 + fr, blk = u.pn >> 1, nn0 = (u.pn & 1) * 256 + wc * 32 + 8 * fq;
        if (blk == 0) store(acc, dec, row0, nn0); else if (blk == 1) store(acc, iclr, row0, nn0); else store(acc, gate, row0, nn0);
    }
    static __device__ __forceinline__ void store(const f32x4 (&acc)[2][2][4][2], bf16_t* dst, int row0, int nn0) {
#pragma unroll
        for (int ai = 0; ai < 2; ++ai)
#pragma unroll
            for (int m = 0; m < 4; ++m) {
                const size_t row = (size_t)(row0 + ai * 128 + m * 16);
#pragma unroll
                for (int bj = 0; bj < 2; ++bj) {
                    const int nn = nn0 + bj * 128; const f32x4 v0 = acc[ai][bj][m][0], v1 = acc[ai][bj][m][1];
                    u32x4 w; w.x = cvt_pk_bf16(v0[0], v0[1]); w.y = cvt_pk_bf16(v0[2], v0[3]); w.z = cvt_pk_bf16(v1[0], v1[1]); w.w = cvt_pk_bf16(v1[2], v1[3]);
                    *(u32x4*)(dst + row * 512 + nn) = w;
                }
            }
    }
};
constexpr int P1_RAW = 1280, P1_RAWRING = 8 * P1_RAW, P1_REC = 1536, P1_WAVE = P1_RAWRING + 2 * P1_REC, P1_LA = 5;
static_assert(NWAVES * P1_WAVE <= RING_BYTES, "pass-1 LDS");
__device__ __forceinline__ void glds4_s(const char* sbase, unsigned voff, unsigned ldsdst) {
    asm volatile("s_mov_b32 m0, %2\n\ts_nop 0\n\tglobal_load_lds_dword %0, %1" : : "v"(voff), "s"(sbase), "s"(ldsdst) : "memory", "m0");
}
__device__ __forceinline__ void phase_rw_pass1(const Frame& F, const CAS Args& a, int layer) {
    const bf16_t* zrw = (const bf16_t*)(F.ws + MO(B_ZRW)); const bf16_t* dec = (const bf16_t*)(F.ws + MO(B_DEC)); const bf16_t* icl = (const bf16_t*)(F.ws + MO(B_ICLR));
    float* yloc = (float*)(F.ws + MO(B_YLOC)); float* pvec = (float*)(F.ws + MO(B_PVEC)); float* bonus = (float*)(F.ws + MO(B_BONUS));
    float* pmat = (float*)(F.ws + MO(B_PMAT)); float* qmat = (float*)(F.ws + MO(B_QMAT));
    const int lane = F.lane, gw = F.bx * NWAVES + F.wave, NGW = F.G * NWAVES;
    const LAS unsigned char* wl = F.lds + F.wave * P1_WAVE; const unsigned rawbase = (unsigned)(unsigned long)wl, lane4 = (unsigned)lane * 4u;
    LAS float* recs = (LAS float*)(wl + P1_RAWRING);
#define P1_ISSUE(u) do { const size_t _row = row0 + (u); const unsigned _d = rawbase + (unsigned)(((u) & 7) * P1_RAW); \
        const char* _z = uniform_ptr((const char*)(zrw + _row * RW_COLS + h * 64)); \
        glds4_s(_z, lane4, _d); glds4_s(_z + 576 * 2, lane4, _d + 256u); glds4_s(_z + 1088 * 2, lane4, _d + 512u); \
        glds4_s(uniform_ptr((const char*)(dec + _row * 512 + h * 64)), lane4, _d + 768u); glds4_s(uniform_ptr((const char*)(icl + _row * 512 + h * 64)), lane4, _d + 1024u); } while (0)
    for (int item = gw; item < 2048; item += NGW) {
        const int bh = item >> 7, ch = item & 127, b = bh >> 3, h = bh & 7, c = h * 64 + lane;
        const size_t row0 = (size_t)b * SEQ + ch * RWC; const bool first = ch == 0;
        asm volatile("s_waitcnt vmcnt(0)" ::: "memory");
        if (!first) P1_ISSUE(-1);
#pragma unroll
        for (int u = 0; u <= P1_LA; ++u) P1_ISSUE(u);
        const float* mu = a.in[I_MU] + layer * RW_COLS;
        const float mur = mu[c], muk = mu[576 + c], muv = mu[1088 + c];
        const float cst0 = a.in[I_W0][layer * 512 + c], cst1 = a.in[I_A0][layer * 512 + c], cst2 = a.in[I_KK][layer * 512 + c], cst3 = a.in[I_KA][layer * 512 + c], cst4 = a.in[I_RK][layer * 512 + c];
#define P1_CST(i) cst##i
        f32x2 sq[32], sp[32];
        int li = lane; asm volatile("" : "+v"(li));
#pragma unroll
        for (int j = 0; j < 32; ++j) { sq[j] = (f32x2){0.f, 0.f}; sp[j] = (f32x2){li == 2 * j ? 1.f : 0.f, li == 2 * j + 1 ? 1.f : 0.f}; }
        float pzr = 0.f, pzk = 0.f, pzv = 0.f;
#define P1_BUILD(u, aout) do { const LAS unsigned char* _rs = wl + ((u) & 7) * P1_RAW; \
        const float _zr = bf2f(*(const LAS bf16_t*)(_rs + 2 * lane)), _zk = bf2f(*(const LAS bf16_t*)(_rs + 256 + 2 * lane)), _zv = bf2f(*(const LAS bf16_t*)(_rs + 512 + 2 * lane)); \
        const float _w = __expf(-0.6065306597126334f * sigmoidf_(P1_CST(0) + bf2f(*(const LAS bf16_t*)(_rs + 768 + 2 * lane)))), _ic = sigmoidf_(P1_CST(1) + bf2f(*(const LAS bf16_t*)(_rs + 1024 + 2 * lane))); \
        const float _r = _zr + mur * (pzr - _zr), _k = _zk + muk * (pzk - _zk), _v = _zv + muv * (pzv - _zv); pzr = _zr; pzk = _zk; pzv = _zv; \
        float _kk = _k * P1_CST(2); const float _n2 = wave_sum(_kk * _kk); _kk *= rsqrtf(fmaxf(_n2, 1e-12f)); \
        const float _k2 = _k * (1.0f + (_ic - 1.0f) * P1_CST(3)); const float _bs = wave_sum(_r * _k2 * P1_CST(4)); \
        LAS float* _rc = recs + ((u) & 1) * 384 + (lane >> 4) * 80 + (lane & 15); \
        _rc[0] = _w; _rc[16] = _kk * _ic; _rc[32] = _k2; _rc[48] = _r; recs[((u) & 1) * 384 + 320 + lane] = _v; \
        recs[(((u) + 1) & 1) * 384 + (lane >> 4) * 80 + 64 + (lane & 15)] = -_kk; \
        if (lane == 0) bonus[(row0 + (u)) * 8 + h] = _bs; \
        aout = -_kk; } while (0)
        float a0;
        if (!first) { asm volatile("s_waitcnt vmcnt(30)" ::: "memory");
            const LAS unsigned char* rs = wl + 7 * P1_RAW; pzr = bf2f(*(const LAS bf16_t*)(rs + 2 * lane)); pzk = bf2f(*(const LAS bf16_t*)(rs + 256 + 2 * lane)); pzv = bf2f(*(const LAS bf16_t*)(rs + 512 + 2 * lane)); }
        asm volatile("s_waitcnt vmcnt(25)" ::: "memory");
        P1_BUILD(0, a0);
        float saq = 0.f, sap = a0;
        for (int t = 0; t < RWC; ++t) {
            const size_t row = row0 + t;
            if (t + 1 + P1_LA < RWC) { P1_ISSUE(t + 1 + P1_LA); if (t >= P1_LA) asm volatile("s_waitcnt vmcnt(40)" ::: "memory"); else asm volatile("s_waitcnt vmcnt(25)" ::: "memory"); }
            else asm volatile("s_waitcnt vmcnt(15)" ::: "memory");
            if (t + 1 < RWC) { float an; P1_BUILD(t + 1, an); (void)an; }
            asm volatile("s_waitcnt lgkmcnt(0)" ::: "memory");
            const LAS f32x4* rec = (const LAS f32x4*)(recs + (t & 1) * 384);
            const float vi = ((const LAS float*)rec)[320 + lane];
            const f32x2 saq2 = (f32x2){saq, saq}, sap2 = (f32x2){sap, sap}, vi2 = (f32x2){vi, vi};
            f32x2 yq0 = (f32x2){0.f, 0.f}, yq1 = yq0, yp0 = yq0, yp1 = yq0, dq0 = yq0, dq1 = yq0, dp0 = yq0, dp1 = yq0;
            f32x4 cw, cb, ck, cr, cn, nw, nb, nk, nr, nn;
            cw = rec[0]; cb = rec[4]; ck = rec[8]; cr = rec[12]; cn = rec[16];
#pragma unroll
            for (int bt = 0; bt < 16; ++bt) {
                if (bt < 15) { const int i = ((bt + 1) >> 2) * 20 + ((bt + 1) & 3); nw = rec[i]; nb = rec[i + 4]; nk = rec[i + 8]; nr = rec[i + 12]; nn = rec[i + 16]; }
                __builtin_amdgcn_sched_barrier(0);
                {   const int j = bt * 2;
                    const f32x2 w0 = (f32x2){cw.x, cw.y}, w1 = (f32x2){cw.z, cw.w}, b0 = (f32x2){cb.x, cb.y}, b1 = (f32x2){cb.z, cb.w}, k0 = (f32x2){ck.x, ck.y}, k1 = (f32x2){ck.z, ck.w};
                    const f32x2 r0 = (f32x2){cr.x, cr.y}, r1 = (f32x2){cr.z, cr.w}, n0 = (f32x2){cn.x, cn.y}, n1 = (f32x2){cn.z, cn.w};
                    sq[j] = sq[j] * w0 + saq2 * b0 + vi2 * k0; sp[j] = sp[j] * w0 + sap2 * b0;
                    sq[j + 1] = sq[j + 1] * w1 + saq2 * b1 + vi2 * k1; sp[j + 1] = sp[j + 1] * w1 + sap2 * b1;
                    yq0 += sq[j] * r0; yp0 += sp[j] * r0; yq1 += sq[j + 1] * r1; yp1 += sp[j + 1] * r1;
                    dq0 += sq[j] * n0; dp0 += sp[j] * n0; dq1 += sq[j + 1] * n1; dp1 += sp[j + 1] * n1; }
                __builtin_amdgcn_sched_barrier(0);
                cw = nw; cb = nb; ck = nk; cr = nr; cn = nn;
            }
            ((bf16_t*)yloc)[row * 512 + h * 64 + lane] = (bf16_t)f2bf((yq0.x + yq0.y) + (yq1.x + yq1.y));
            ((bf16_t*)pvec)[row * 512 + h * 64 + lane] = (bf16_t)f2bf((yp0.x + yp0.y) + (yp1.x + yp1.y));
            saq = (dq0.x + dq0.y) + (dq1.x + dq1.y); sap = (dp0.x + dp0.y) + (dp1.x + dp1.y);
        }
        int l2 = lane; asm volatile("" : "+v"(l2));
        f32x4* po = (f32x4*)(pmat + (size_t)item * 4096 + l2 * 64); f32x4* qo = (f32x4*)(qmat + (size_t)item * 4096 + l2 * 64);
#pragma unroll
        for (int j = 0; j < 16; ++j) { po[j] = (f32x4){sp[2 * j].x, sp[2 * j].y, sp[2 * j + 1].x, sp[2 * j + 1].y}; qo[j] = (f32x4){sq[2 * j].x, sq[2 * j].y, sq[2 * j + 1].x, sq[2 * j + 1].y}; }
    }
#undef P1_ISSUE
#undef P1_BUILD
#undef P1_CST
}
__device__ __forceinline__ void phase_rw_scan(const Frame& F, int layer) {
    const float* pmat = (const float*)(F.ws + MO(B_PMAT)); const float* qmat = (const float*)(F.ws + MO(B_QMAT)); float* sst = (float*)(F.ws + MO(B_SST));
    LAS float* Sb = (LAS float*)F.lds;
    const int lane = F.lane, jt = F.wave, n = lane & 15, kq = lane >> 4;
    for (int w = F.bx; w < 64; w += F.G) {
        const int bh = w >> 2, qr = w & 3; const size_t it0 = (size_t)bh * RWNC;
        __syncthreads();
        if (jt < 4) {
            f32x4 s = (f32x4){0.f, 0.f, 0.f, 0.f};
            float pA[16], pB[16], pC[16]; f32x4 qA, qB, qC;
#define SC_LOAD(pb, qc, c) do { const int _c = (c) < RWNC ? (c) : RWNC - 1; const float* pp = pmat + (it0 + _c) * 4096 + 16 * jt + n; _Pragma("unroll") for (int kk = 0; kk < 16; ++kk) pb[kk] = pp[(4 * kk + kq) * 64]; \
                        const float* qq = qmat + (it0 + _c) * 4096 + (size_t)(qr * 16 + 4 * kq) * 64 + 16 * jt + n; qc = (f32x4){qq[0], qq[64], qq[128], qq[192]}; } while (0)
#define SC_STEP(pb, qc, c) do { \
                float* so = sst + (it0 + (c)) * 4096 + (size_t)(qr * 16 + 4 * kq) * 64 + 16 * jt + n; \
                so[0] = s[0]; so[64] = s[1]; so[128] = s[2]; so[192] = s[3]; \
                _Pragma("unroll") for (int r = 0; r < 4; ++r) Sb[(4 * kq + r) * 68 + 16 * jt + n] = s[r]; \
                asm volatile("s_waitcnt lgkmcnt(0)" ::: "memory"); __builtin_amdgcn_s_barrier(); asm volatile("" ::: "memory"); \
                f32x4 a0 = qc, a1 = (f32x4){0.f, 0.f, 0.f, 0.f}, a2 = a1, a3 = a1; \
                _Pragma("unroll") for (int kk = 0; kk < 16; kk += 4) { \
                    a0 = __builtin_amdgcn_mfma_f32_16x16x4f32(Sb[n * 68 + 4 * kk + kq], pb[kk], a0, 0, 0, 0); \
                    a1 = __builtin_amdgcn_mfma_f32_16x16x4f32(Sb[n * 68 + 4 * (kk + 1) + kq], pb[kk + 1], a1, 0, 0, 0); \
                    a2 = __builtin_amdgcn_mfma_f32_16x16x4f32(Sb[n * 68 + 4 * (kk + 2) + kq], pb[kk + 2], a2, 0, 0, 0); \
                    a3 = __builtin_amdgcn_mfma_f32_16x16x4f32(Sb[n * 68 + 4 * (kk + 3) + kq], pb[kk + 3], a3, 0, 0, 0); } \
                s = (a0 + a1) + (a2 + a3); \
                SC_LOAD(pb, qc, (c) + 3); \
                asm volatile("s_waitcnt lgkmcnt(0)" ::: "memory"); __builtin_amdgcn_s_barrier(); asm volatile("" ::: "memory"); } while (0)
            SC_LOAD(pA, qA, 0); SC_LOAD(pB, qB, 1); SC_LOAD(pC, qC, 2);
            static_assert(RWNC % 3 == 2, "scan loop tail");
            for (int c = 0; c + 2 < RWNC; c += 3) { SC_STEP(pA, qA, c); SC_STEP(pB, qB, c + 1); SC_STEP(pC, qC, c + 2); }
            SC_STEP(pA, qA, RWNC - 2); SC_STEP(pB, qB, RWNC - 1);
#undef SC_LOAD
#undef SC_STEP
        } else {
            for (int c = 0; c < RWNC; ++c) { __builtin_amdgcn_s_barrier(); __builtin_amdgcn_s_barrier(); }
        }
    }
}
__device__ __forceinline__ bf16x8 cvt8(f32x4 lo, f32x4 hi) { u32x4 o; o.x = cvt_pk_bf16(lo[0], lo[1]); o.y = cvt_pk_bf16(lo[2], lo[3]); o.z = cvt_pk_bf16(hi[0], hi[1]); o.w = cvt_pk_bf16(hi[2], hi[3]); return __builtin_bit_cast(bf16x8, o); }
__device__ __forceinline__ void phase_rw_fix(const Frame& F, const CAS Args& a, int layer) {
    const bf16_t* zrw = (const bf16_t*)(F.ws + MO(B_ZRW)); const float* muv = a.in[I_MU] + layer * RW_COLS + 1088; const float* yloc = (const float*)(F.ws + MO(B_YLOC)); const float* pvec = (const float*)(F.ws + MO(B_PVEC));
    const float* sst = (const float*)(F.ws + MO(B_SST)); const float* bonus = (const float*)(F.ws + MO(B_BONUS)); const bf16_t* gate = (const bf16_t*)(F.ws + MO(B_GATE));
    bf16_t* mixed = (bf16_t*)(F.ws + MO(B_MIXED));
    const float* lnw = a.in[I_LNW] + layer * 512; const float* lnb = a.in[I_LNB] + layer * 512;
    const int lane = F.lane, gw = F.bx * NWAVES + F.wave, NGW = F.G * NWAVES, tl = lane & 15, q4 = lane >> 4;
    for (int item = gw; item < 2048; item += NGW) {
        const int bh = item >> 7, ch = item & 127, b = bh >> 3, h = bh & 7;
        bf16x8 sa[4][2];
#pragma unroll
        for (int ib = 0; ib < 4; ++ib)
#pragma unroll
            for (int ks = 0; ks < 2; ++ks) { const float* p = sst + (size_t)item * 4096 + (16 * ib + tl) * 64 + 32 * ks + 8 * q4; sa[ib][ks] = cvt8(*(const f32x4*)p, *(const f32x4*)(p + 4)); }
        f32x4 lw[4], lb[4];
#pragma unroll
        for (int ib = 0; ib < 4; ++ib) { lw[ib] = *(const f32x4*)(lnw + h * 64 + 16 * ib + 4 * q4); lb[ib] = *(const f32x4*)(lnb + h * 64 + 16 * ib + 4 * q4); }
        for (int tb = 0; tb < RWC / 16; ++tb) {
            const size_t row = (size_t)b * SEQ + ch * RWC + tb * 16 + tl;
            bf16x8 pb[2];
#pragma unroll
            for (int ks = 0; ks < 2; ++ks) pb[ks] = *(const bf16x8*)((const bf16_t*)pvec + row * 512 + h * 64 + 32 * ks + 8 * q4);
            f32x4 y[4]; float s = 0.f;
#pragma unroll
            for (int ib = 0; ib < 4; ++ib) {
                const u32x2 yb = *(const u32x2*)((const bf16_t*)yloc + row * 512 + h * 64 + 16 * ib + 4 * q4); f32x4 d = (f32x4){bflo(yb.x), bfhi(yb.x), bflo(yb.y), bfhi(yb.y)};
                d = __builtin_amdgcn_mfma_f32_16x16x32_bf16(sa[ib][0], pb[0], d, 0, 0, 0);
                d = __builtin_amdgcn_mfma_f32_16x16x32_bf16(sa[ib][1], pb[1], d, 0, 0, 0);
                y[ib] = d; s += (d[0] + d[1]) + (d[2] + d[3]);
            }
            s += __shfl_xor(s, 16); s += __shfl_xor(s, 32);
            const float mean = s * (1.0f / 64.0f); float q = 0.f;
#pragma unroll
            for (int ib = 0; ib < 4; ++ib) { y[ib] = y[ib] - mean; q += (y[ib][0] * y[ib][0] + y[ib][1] * y[ib][1]) + (y[ib][2] * y[ib][2] + y[ib][3] * y[ib][3]); }
            q += __shfl_xor(q, 16); q += __shfl_xor(q, 32);
            const float rstd = rsqrtf(q * (1.0f / 64.0f) + 64e-5f), bon = bonus[row * 8 + h];
#pragma unroll
            for (int ib = 0; ib < 4; ++ib) {
                const int c = h * 64 + 16 * ib + 4 * q4;
                const u32x2 zc = *(const u32x2*)(zrw + row * RW_COLS + 1088 + c); u32x2 zp = (u32x2){0u, 0u}; if ((row & (SEQ - 1)) != 0) zp = *(const u32x2*)(zrw + (row - 1) * RW_COLS + 1088 + c);
                const f32x4 mv = *(const f32x4*)(muv + c), zcf = (f32x4){bflo(zc.x), bfhi(zc.x), bflo(zc.y), bfhi(zc.y)}, zpf = (f32x4){bflo(zp.x), bfhi(zp.x), bflo(zp.y), bfhi(zp.y)};
                const f32x4 vv = zcf + mv * (zpf - zcf); const u32x2 gg = *(const u32x2*)(gate + row * 512 + c);
                const f32x4 o = (y[ib] * rstd * lw[ib] + lb[ib] + vv * bon) * (f32x4){bflo(gg.x), bfhi(gg.x), bflo(gg.y), bfhi(gg.y)};
                u32x2 w; w.x = cvt_pk_bf16(o[0], o[1]); w.y = cvt_pk_bf16(o[2], o[3]);
                *(u32x2*)(mixed + row * D + 1024 + c) = w;
            }
        }
    }
}

template <bool F8, bool O8 = F8> struct EpiSwiglu {
    static constexpr bool PERM = true, MID = false;
    const unsigned long long* ssq; const float* rsslot; void* act; int ldact;
    __device__ __forceinline__ void operator()(const f32x4 (&acc)[2][2][4][2], const Unit& u, int wr, int wc, int fr, int fq) const {
        const int row0 = u.pm * 256 + wr * 64 + fr, col0 = u.pn * 128 + wc * 32 + 8 * fq;
        float rsv[2][4];
#pragma unroll
        for (int ai = 0; ai < 2; ++ai)
#pragma unroll
            for (int m = 0; m < 4; ++m) { const int row = row0 + ai * 128 + m * 16; rsv[ai][m] = (rsslot ? rsslot[row] : ss_rs(ssq[row])) * (F8 ? 1.0f / (SC_H * SC_W13) : 1.0f); }
#pragma unroll
        for (int ai = 0; ai < 2; ++ai)
#pragma unroll
            for (int m = 0; m < 4; ++m) {
                const int row = row0 + ai * 128 + m * 16; const float rs = rsv[ai][m];
                float o[8];
#pragma unroll
                for (int n = 0; n < 2; ++n)
#pragma unroll
                    for (int j = 0; j < 4; ++j) { const float g = acc[ai][0][m][n][j] * rs, up = acc[ai][1][m][n][j] * rs; o[n * 4 + j] = g * sigmoidf_(g) * up; }
                if constexpr (O8) { u32x2 w; w.x = pk8(clamp8(o[0] * SC_ACT), clamp8(o[1] * SC_ACT), clamp8(o[2] * SC_ACT), clamp8(o[3] * SC_ACT)); w.y = pk8(clamp8(o[4] * SC_ACT), clamp8(o[5] * SC_ACT), clamp8(o[6] * SC_ACT), clamp8(o[7] * SC_ACT));
                    *(u32x2*)((unsigned char*)act + (size_t)row * ldact + col0) = w; }
                else { u32x4 w; w.x = cvt_pk_bf16(o[0], o[1]); w.y = cvt_pk_bf16(o[2], o[3]); w.z = cvt_pk_bf16(o[4], o[5]); w.w = cvt_pk_bf16(o[6], o[7]);
                    *(u32x4*)((bf16_t*)act + (size_t)row * ldact + col0) = w; }
            }
    }
};
struct EpiBf16Out {
    static constexpr bool PERM = true, MID = false;
    bf16_t* o; int ld; float asc;
    __device__ __forceinline__ void operator()(const f32x4 (&acc)[2][2][4][2], const Unit& u, int wr, int wc, int fr, int fq) const {
        const int row0 = u.pm * 256 + wr * 64 + fr, col0 = u.pn * 256 + wc * 32 + 8 * fq;
#pragma unroll
        for (int ai = 0; ai < 2; ++ai)
#pragma unroll
            for (int m = 0; m < 4; ++m)
#pragma unroll
                for (int bj = 0; bj < 2; ++bj) { const f32x4 v0 = acc[ai][bj][m][0] * asc, v1 = acc[ai][bj][m][1] * asc;
                    u32x4 w; w.x = cvt_pk_bf16(v0[0], v0[1]); w.y = cvt_pk_bf16(v0[2], v0[3]); w.z = cvt_pk_bf16(v1[0], v1[1]); w.w = cvt_pk_bf16(v1[2], v1[3]);
                    *(u32x4*)(o + (size_t)(row0 + ai * 128 + m * 16) * ld + col0 + bj * 128) = w; }
    }
};
struct EpiProbe {
    static constexpr bool PERM = true, MID = false;
    float* dummy;
    __device__ __forceinline__ void operator()(const f32x4 (&acc)[2][2][4][2], const Unit& u, int wr, int wc, int fr, int fq) const {
        float s = 0.f;
#pragma unroll
        for (int ai = 0; ai < 2; ++ai)
#pragma unroll
            for (int bj = 0; bj < 2; ++bj)
#pragma unroll
                for (int m = 0; m < 4; ++m)
#pragma unroll
                    for (int n = 0; n < 2; ++n) s += (acc[ai][bj][m][n][0] + acc[ai][bj][m][n][1]) + (acc[ai][bj][m][n][2] + acc[ai][bj][m][n][3]);
        dummy[(wr * 4 + wc) * 64 + fq * 16 + fr] = s;
    }
};
template <int K_, int NN_> struct ProbMoe {
    static constexpr bool FP8 = true;
    static constexpr int K = K_, lda = K_, ldb = K_, nN = NN_; static constexpr size_t estride = (size_t)NN_ * 256 * K_;
    const unsigned char* A; const unsigned char* Bt; int tp[9]; int G, c, i0, ilim;
    __device__ __forceinline__ bool next(int i, Unit& u) const { const int ii = i + i0; if (ii >= ilim) return false; return pg8::static_unit(ii * G + c, tp[8], nN, u); }
    __device__ __forceinline__ const char* abase(const Unit& u) const { return (const char*)(A + (size_t)u.pm * 256 * lda); }
    __device__ __forceinline__ const char* bbase(const Unit& u) const { int e = 0;
#pragma unroll
        for (int j = 1; j < 8; ++j) e += (u.pm >= tp[j]) ? 1 : 0;
        return (const char*)(Bt + (size_t)e * estride + (size_t)u.pn * 256 * ldb); }
};
__device__ __forceinline__ int moe_pos(int c, int G) { return (G & 7) ? c : (c & 7) * (G >> 3) + (c >> 3); }
__device__ __forceinline__ void moe_ord_unit(int w, int nM, int nN, Unit& u) {
    const int nig = pg8::WGM * nN, gid = w / nig, fm = gid * pg8::WGM, gsz = (nM - fm) < pg8::WGM ? (nM - fm) : pg8::WGM, r = w - gid * nig;
    u.pm = fm + r % gsz; u.pn = r / gsz;
}
template <int K_, int NN_> struct ProbMoeOrd {
    static constexpr bool FP8 = true;
    static constexpr int K = K_, lda = K_, ldb = K_, nN = NN_; static constexpr size_t estride = (size_t)NN_ * 256 * K_;
    const unsigned char* A; const unsigned char* Bt; int tp[9]; int G, pos, base, lim;
    __device__ __forceinline__ bool next(int i, Unit& u) const { const int w = base + i * G + pos; if (w >= lim) return false; moe_ord_unit(w, tp[8], nN, u); return true; }
    __device__ __forceinline__ const char* abase(const Unit& u) const { return (const char*)(A + (size_t)u.pm * 256 * lda); }
    __device__ __forceinline__ const char* bbase(const Unit& u) const { int e = 0;
#pragma unroll
        for (int j = 1; j < 8; ++j) e += (u.pm >= tp[j]) ? 1 : 0;
        return (const char*)(Bt + (size_t)e * estride + (size_t)u.pn * 256 * ldb); }
};
__device__ __forceinline__ void phase_router(const Frame& F, const CAS Args& a) {
    LAS float* rt = (LAS float*)F.lds;
    LAS int* cnt = (LAS int*)(F.lds + 65536);
    const float* rw = a.in[I_ROUTER]; const float* g2 = a.in[I_N2G] + D; const unsigned long long* ssq = (const unsigned long long*)(F.ws + OFF_SS) + 3 * (size_t)T; const bf16_t* h = (const bf16_t*)(F.ws + OFF_HB);
    int* toke = (int*)(F.ws + OFF_TOKE); float* tokg = (float*)(F.ws + OFF_TOKG); int* wgcnt = (int*)(F.ws + OFF_WGCNT);
    for (int i = F.tid; i < 2048 * 8; i += NTHREADS) rt[(i & 7) * 2048 + (i >> 3)] = rw[i];
    const int lane = F.lane;
    for (int tg = F.bx; tg < 256; tg += F.G) {
        if (F.tid < 8) cnt[F.tid] = 0;
        __syncthreads();
        for (int k = 0; k < 16; ++k) {
            const int tok = tg * 128 + F.wave * 16 + k;
            const float rs = ss_rs(ssq[tok]);
            float lg[8];
#pragma unroll
            for (int e = 0; e < 8; ++e) lg[e] = 0.f;
#pragma unroll
            for (int j = 0; j < 4; ++j) {
                const int c = lane * 8 + 512 * j; const u32x4 hb = *(const u32x4*)(h + (size_t)tok * D + c); const f32x4 gv0 = *(const f32x4*)(g2 + c), gv1 = *(const f32x4*)(g2 + c + 4);
                const f32x4 hn0 = (f32x4){bflo(hb.x), bfhi(hb.x), bflo(hb.y), bfhi(hb.y)} * rs * gv0, hn1 = (f32x4){bflo(hb.z), bfhi(hb.z), bflo(hb.w), bfhi(hb.w)} * rs * gv1;
#pragma unroll
                for (int e = 0; e < 8; ++e) { const f32x4 r0 = *(const LAS f32x4*)(rt + e * 2048 + c), r1 = *(const LAS f32x4*)(rt + e * 2048 + c + 4);
                    lg[e] += ((hn0.x * r0.x + hn0.y * r0.y) + (hn0.z * r0.z + hn0.w * r0.w)) + ((hn1.x * r1.x + hn1.y * r1.y) + (hn1.z * r1.z + hn1.w * r1.w)); }
            }
#pragma unroll
            for (int e = 0; e < 8; ++e) lg[e] = wave_sum(lg[e]);
            int i0 = 0; float v0 = lg[0];
#pragma unroll
            for (int e = 1; e < 8; ++e) if (lg[e] > v0) { v0 = lg[e]; i0 = e; }
            int i1 = -1; float v1 = -INFINITY;
#pragma unroll
            for (int e = 0; e < 8; ++e) if (e != i0 && lg[e] > v1) { v1 = lg[e]; i1 = e; }
            if (lane == 0) { const float g0 = 1.0f / (1.0f + expf(v1 - v0)); toke[tok] = i0; toke[T + tok] = i1; tokg[tok] = g0; tokg[T + tok] = 1.0f - g0; __hip_atomic_fetch_add((int*)(cnt + i0), 1, __ATOMIC_RELAXED, __HIP_MEMORY_SCOPE_WORKGROUP); __hip_atomic_fetch_add((int*)(cnt + i1), 1, __ATOMIC_RELAXED, __HIP_MEMORY_SCOPE_WORKGROUP); }
        }
        __syncthreads();
        if (F.tid < 8) wgcnt[tg * 8 + F.tid] = cnt[F.tid];
        __syncthreads();
    }
}
__device__ __forceinline__ void phase_assign(const Frame& F) {
    LAS int* wc = (LAS int*)F.lds;
    LAS int* base = wc + 2048;
    LAS int* seg = base + 8;
    LAS int* le = seg + 16;
    LAS int* ls = le + 256;
    const int* wgcnt = (const int*)(F.ws + OFF_WGCNT); const int* toke = (const int*)(F.ws + OFF_TOKE);
    int* slotof = (int*)(F.ws + OFF_SLOT); int* tokof = (int*)(F.ws + OFF_TOKOF); int* tiles = (int*)(F.ws + OFF_TILES);
    float* rsslot = (float*)(F.ws + OFF_RSSLOT); const unsigned long long* ssq3 = (const unsigned long long*)(F.ws + OFF_SS) + 3 * (size_t)T;
    const unsigned char* xb = F.ws + OFF_XB; unsigned char* asort = F.ws + OFF_ASORT;
    for (int tg = F.bx; tg < 256; tg += F.G) {
        __syncthreads();
        for (int i = F.tid; i < 2048; i += NTHREADS) wc[i] = wgcnt[i];
        if (F.tid < 256) le[F.tid] = toke[(F.tid & 1) * T + tg * 128 + (F.tid >> 1)];
        __syncthreads();
        if (F.tid < 8) { const int e = F.tid; int tot = 0, bef = 0; for (int w = 0; w < 256; ++w) { const int v = wc[w * 8 + e]; tot += v; bef += (w < tg) ? v : 0; }
            seg[8 + e] = tot; base[e] = bef; }
        __syncthreads();
        if (F.tid == 0) {
            int pre = 0;
            for (int e = 0; e < 8; ++e) { const int tot = seg[8 + e]; seg[e] = pre * 256; base[e] = pre * 256 + base[e]; if (tg == 0) tiles[e] = pre; pre += (tot + 255) >> 8; }
            if (tg == 0) tiles[8] = pre;
        }
        __syncthreads();
        if (F.tid < 8) { const int e = F.tid; int bs = base[e]; for (int i = 0; i < 256; ++i) if (le[i] == e) { ls[i] = bs; ++bs; } }
        __syncthreads();
        if (F.tid < 256) { const int tok = tg * 128 + (F.tid >> 1), s = F.tid & 1; slotof[s * T + tok] = ls[F.tid]; tokof[ls[F.tid]] = tok; rsslot[ls[F.tid]] = ss_rs(ssq3[tok]); }
        for (int i0 = F.wave * 32; i0 < F.wave * 32 + 32; i0 += 8) {
            u32x4 r[8][2];
#pragma unroll
            for (int u = 0; u < 8; ++u) { const int tok = tg * 128 + ((i0 + u) >> 1); const u32x4* srcp = (const u32x4*)(xb + (size_t)tok * D) + F.lane; r[u][0] = srcp[0]; r[u][1] = srcp[64]; }
#pragma unroll
            for (int u = 0; u < 8; ++u) { u32x4* dst = (u32x4*)(asort + (size_t)ls[i0 + u] * D) + F.lane; dst[0] = r[u][0]; dst[64] = r[u][1]; }
        }
        if (tg < 8) {
            const int p0 = seg[tg] + seg[8 + tg], p1 = seg[tg] + (((seg[8 + tg] + 255) >> 8) << 8);
            for (int s = p0 + F.wave; s < p1; s += NWAVES) { if (F.lane == 0) { tokof[s] = -1; rsslot[s] = 0.f; } u32x4* dst = (u32x4*)(asort + (size_t)s * D) + F.lane;
#pragma unroll
                for (int j = 0; j < 2; ++j) dst[64 * j] = (u32x4){0u, 0u, 0u, 0u}; }
        }
    }
}
__device__ __forceinline__ void phase_combine(const Frame& F, int sel, int fr, int extra) {
    const int* slotof = (const int*)(F.ws + OFF_SLOT); const float* tokg = (const float*)(F.ws + OFF_TOKG); const bf16_t* y = (const bf16_t*)(F.ws + OFF_ASORT); const bf16_t* hb16 = (const bf16_t*)(F.ws + OFF_HB); float* out = F.out;
    LAS int* late = (LAS int*)F.lds;
    if (sel) { const int R = ((const int*)(F.ws + OFF_TILES))[8];
        __syncthreads();
        for (int i = F.tid; i < 512; i += NTHREADS) late[i] = 0;
        __syncthreads();
        if (F.tid < extra) { pg8::Unit u; moe_ord_unit(fr * F.G + F.tid, R, D / 256, u); late[u.pm] = 1; }
        __syncthreads(); }
    const int w0 = sel == 1 ? extra : 0;
    const int gw = (F.bx - w0) * NWAVES + F.wave, NGW = (F.G - w0) * NWAVES, lane = F.lane;
    for (int tok = gw; tok < T; tok += NGW) {
        const int s0 = slotof[tok], s1 = slotof[T + tok];
        if (sel) { const int lt = late[s0 >> 8] | late[s1 >> 8]; if ((sel == 1) == (lt != 0)) continue; }
        const float g0 = tokg[tok], g1 = tokg[T + tok];
#pragma unroll
        for (int j = 0; j < 4; ++j) {
            const int c = lane * 8 + 512 * j; float* op = out + (size_t)tok * D + c;
            const u32x4 a0 = __builtin_nontemporal_load((const u32x4*)(y + (size_t)s0 * D + c)), a1 = __builtin_nontemporal_load((const u32x4*)(y + (size_t)s1 * D + c));
            const u32x4 hb = __builtin_nontemporal_load((const u32x4*)(hb16 + (size_t)tok * D + c));
            f32x4 h0 = (f32x4){bflo(hb.x), bfhi(hb.x), bflo(hb.y), bfhi(hb.y)}, h1 = (f32x4){bflo(hb.z), bfhi(hb.z), bflo(hb.w), bfhi(hb.w)};
            h0.x += g0 * bflo(a0.x) + g1 * bflo(a1.x); h0.y += g0 * bfhi(a0.x) + g1 * bfhi(a1.x); h0.z += g0 * bflo(a0.y) + g1 * bflo(a1.y); h0.w += g0 * bfhi(a0.y) + g1 * bfhi(a1.y);
            h1.x += g0 * bflo(a0.z) + g1 * bflo(a1.z); h1.y += g0 * bfhi(a0.z) + g1 * bfhi(a1.z); h1.z += g0 * bflo(a0.w) + g1 * bflo(a1.w); h1.w += g0 * bfhi(a0.w) + g1 * bfhi(a1.w);
            __builtin_nontemporal_store(h0, (f32x4*)op); __builtin_nontemporal_store(h1, (f32x4*)(op + 4));
        }
    }
}

enum LPhase { LP_INPROJ = 0, LP_G1, LP_G2, LP_G3, LP_G4, LP_G5, LP_OUTPROJ, LP_F0, LP_F1, LP_F2, LP_F3, LP_F4, LP_F5, LP_N };
constexpr int PH_TOTAL = 1 + 2 * LP_N;

template <int L> __device__ __forceinline__ void layer_mixer(const Frame& F, const CAS Args& args, int lo, int hi, const XcdBarrier& bar) {
    unsigned char* ws = F.ws;
#define IN(k) (lo <= (k) && (k) < hi)
#define SEAM(k) do { if ((k) + 1 < hi) xcd_barrier(bar); } while (0)
    {
        constexpr int l = L; constexpr int layer = L; const int pb = 1 + LP_N * l;
        unsigned long long* ssq = (unsigned long long*)(ws + OFF_SS);
        if (IN(pb + LP_INPROJ)) {
            ProbPlain P{(const bf16_t*)(ws + (l == 0 ? OFF_XB : OFF_HB)), (const bf16_t*)(ws + OFF_WIN + l * SZ_WIN), D, D, D, T / 256, IN_COLS / 256, F.G, F.bx};
            EpiInProj E{ssq + (size_t)(2 * l) * T, (bf16_t*)(ws + MO(B_ZATT)), (bf16_t*)(ws + MO(B_ZRW)), (bf16_t*)(ws + MO(B_UEXT))};
            pg8::gemm_phase(F.lds, P, E, F.wave);
            if (!S5_BUILD_PRO && S5_BUILD_TAIL && F.G == 256) { __syncthreads(); phase_s5_build(fresh(F), args, l, 128, 128); }
            SEAM(pb + LP_INPROJ);
        }
        if (IN(pb + LP_G1)) {
            if (!S5_BUILD_PRO && !(S5_BUILD_TAIL && F.G == 256 && IN(pb + LP_INPROJ))) { phase_s5_build(fresh(F), args, l, 0, F.G); __syncthreads(); }
            phase_attention(fresh(F), args, l); __syncthreads();
            phase_rw_prep1(fresh(F), args, l);
            SEAM(pb + LP_G1);
        }
        if (IN(pb + LP_G2)) {
            const bool scan_here = S5_SCAN_IN_G2 && F.G == 256;
            unsigned* s5flag = (unsigned*)(ws + OFF_CTL) + XS_S5FLAG(l);
            { ProbS5a P{(const bf16_t*)(ws + MO(B_UEXT)), (const bf16_t*)(ws + (S5_BUILD_PRO ? s5e_off(l) : OFF_S5E)), 1024, S5K, 1024, F.G, F.bx};
              EpiS5a E{(float*)(ws + MO(B_XLOC))};
              pg8::gemm_phase(F.lds, P, E, F.wave); }
            if (scan_here && F.bx < 64) {
                asm volatile("s_waitcnt vmcnt(0)" ::: "memory"); __syncthreads();
                if (F.tid == 0) { __builtin_amdgcn_fence(__ATOMIC_RELEASE, "agent"); asm volatile("s_waitcnt vmcnt(0)" ::: "memory"); (void)xb_add(s5flag, 1u); }
            }
            { ProbLora P{(const bf16_t*)(ws + MO(B_ALORA)), (const bf16_t*)(ws + OFF_BCAT + l * SZ_BCAT), 128, 256, 256, T / 256, 6, F.G, F.bx};
              EpiLora E{(bf16_t*)(ws + MO(B_DEC)), (bf16_t*)(ws + MO(B_ICLR)), (bf16_t*)(ws + MO(B_GATE))};
              pg8::gemm_phase(F.lds, P, E, F.wave); }
            if (scan_here && F.bx >= F.G - 8) {
                if (F.tid == 0) { XB_SPIN(xb_ld(s5flag) != 64u, (unsigned*)(ws + OFF_CTL)); __builtin_amdgcn_fence(__ATOMIC_ACQUIRE, "agent"); asm volatile("s_waitcnt vmcnt(0)" ::: "memory"); }
                __syncthreads();
                Frame Fs = fresh(F); Fs.bx = F.bx - (F.G - 8); phase_s5_scan(Fs, args, l);
            }
            SEAM(pb + LP_G2);
        }
        if (IN(pb + LP_G3)) {
            if (!(S5_SCAN_IN_G2 && F.G == 256)) phase_s5_scan(fresh(F), args, l);
            phase_rw_pass1(fresh(F), args, l);
            SEAM(pb + LP_G3);
        }
        if (IN(pb + LP_G4)) {
            phase_rw_scan(fresh(F), l);
            { const bool sub = F.G > 64;
              ProbS5b P{(const bf16_t*)(ws + MO(B_UEXT)), (const bf16_t*)(ws + (S5_BUILD_PRO ? s5b2_off(l) : OFF_S5B2)), S5K, S5K, S5K, sub ? F.G - 64 : F.G, sub ? F.bx - 64 : F.bx};
              EpiS5b E{(bf16_t*)(ws + MO(B_ZG))};
              pg8::gemm_phase(F.lds, P, E, F.wave);
              if (sub) moe_convert_range(fresh(F), args, l * MOE_EARLY, (l + 1) * MOE_EARLY, 64, F.G - 64); }
            SEAM(pb + LP_G4);
        }
        if (IN(pb + LP_G5)) {
            { ProbPlain P{(const bf16_t*)(ws + MO(B_ZG)), (const bf16_t*)(ws + OFF_WGLU + l * SZ_WGLU), 512, 512, 512, T / 256, 2, F.G, F.bx};
              EpiGlu E{(const bf16_t*)(ws + MO(B_ZG)), args.in[I_GLUB] + l * 512, (bf16_t*)(ws + MO(B_MIXED)), ssq + (size_t)(5 + 2 * l) * T};
              pg8::gemm_phase(F.lds, P, E, F.wave); }
            phase_rw_fix(fresh(F), args, l);
            SEAM(pb + LP_G5);
        }
        if (IN(pb + LP_OUTPROJ)) {
            ProbPlain P{(const bf16_t*)(ws + MO(B_MIXED)), (const bf16_t*)(ws + OFF_WOUT + l * SZ_WOUT), D, D, D, T / 256, D / 256, F.G, F.bx};
            EpiResid<(L == 1 || (FFN_FP8 & 1)), true, true> E{l == 0 ? (const void*)(ws + OFF_XB) : (const void*)(ws + OFF_HB), (bf16_t*)(ws + OFF_HB), ws + (l == 0 ? OFF_X8 : OFF_XB), ssq + (size_t)(2 * l + 1) * T, 1.0f, ssq + (size_t)(4 + 2 * l) * T, ssq + (size_t)(5 + 2 * l) * T};
            pg8::gemm_phase(F.lds, P, E, F.wave); SEAM(pb + LP_OUTPROJ);
        }
    }
#undef IN
#undef SEAM
}

__global__ void __launch_bounds__(NTHREADS, 2) mk_fwd(Args args_) {
    const CAS Args& args = *(const CAS Args*)__builtin_amdgcn_kernarg_segment_ptr();
    extern __shared__ __attribute__((aligned(16))) unsigned char lds_raw[];
    Frame F; F.lds = (LAS unsigned char*)lds_raw; F.wave = __builtin_amdgcn_readfirstlane((int)threadIdx.x >> 6); F.lane = lane_id(); F.tid = F.wave * 64 + F.lane; F.G = gridDim.x; F.bx = blockIdx.x;
    F.ws = args.ws; F.out = args.out;
    unsigned char* ws = args.ws;
    const int lo = args.ph_lo, hi = args.ph_hi;
    LAS unsigned* misc = (LAS unsigned*)(F.lds + MISC_OFF);
    if (F.tid < 4) misc[F.tid] = 0u;
    __syncthreads();
    XcdBarrier bar; bar.bar = (unsigned*)(ws + OFF_CTL); bar.x = 0; bar.st = (volatile LAS unsigned*)misc; bar.wave = F.wave;
    if (hi - lo > 1) bar = xcd_barrier_post((unsigned*)(ws + OFF_CTL), (volatile LAS unsigned*)misc, F.wave);
#define IN(k) (lo <= (k) && (k) < hi)
#define SEAM(k) do { if ((k) + 1 < hi) xcd_barrier(bar); } while (0)
    if (IN(0)) { phase_prologue(fresh(F), args); SEAM(0); }
    layer_mixer<0>(F, args, lo, hi, bar);
    {
        const int pb = 1; unsigned long long* ssq = (unsigned long long*)(ws + OFF_SS);
        if (IN(pb + LP_F0)) {
            ProbPlainT<(FFN_FP8 & 1) != 0> P{ws + OFF_X8, ws + OFF_W13, D, D, D, T / 256, 2 * DFF / 256, F.G, F.bx};
            EpiSwiglu<(FFN_FP8 & 1) != 0, (FFN_FP8 & 2) != 0> E{ssq + T, nullptr, ws + OFF_ACT, DFF};
            pg8::gemm_phase(F.lds, P, E, F.wave); SEAM(pb + LP_F0);
        }
        if (IN(pb + LP_F1)) {
            ProbPlainT<(FFN_FP8 & 2) != 0> P{ws + OFF_ACT, ws + OFF_W2, DFF, DFF, DFF, T / 256, D / 256, F.G, F.bx};
            EpiResid<false, false, true, false> E{ws + OFF_HB, (bf16_t*)(ws + OFF_HB), nullptr, ssq + 2 * (size_t)T, (FFN_FP8 & 2) ? 1.0f / (SC_ACT * SC_W2) : 1.0f};
            pg8::gemm_phase(F.lds, P, E, F.wave); SEAM(pb + LP_F1);
        }
    }
    layer_mixer<1>(F, args, lo, hi, bar);
    {
        const int pb = 1 + LP_N; unsigned long long* ssq = (unsigned long long*)(ws + OFF_SS);
        if (IN(pb + LP_F0)) { phase_router(fresh(F), args); SEAM(pb + LP_F0); }
        if (IN(pb + LP_F1)) {
            phase_assign(fresh(F));
            __syncthreads();
            moe_convert_range(fresh(F), args, F.G > 64 ? 2 * MOE_EARLY : 0, MOE_ITEMS, 0, F.G);
            SEAM(pb + LP_F1);
        }
        if (IN(pb + LP_F2) || IN(pb + LP_F4)) {
            const int* tl = (const int*)(ws + OFF_TILES);
            if (IN(pb + LP_F2)) {
                constexpr int NN = 2 * DFFE / 256;
                ProbMoeOrd<D, NN> P{ws + OFF_ASORT, ws + OFF_WM13, {RFL(tl[0]), RFL(tl[1]), RFL(tl[2]), RFL(tl[3]), RFL(tl[4]), RFL(tl[5]), RFL(tl[6]), RFL(tl[7]), RFL(tl[8])}, F.G, moe_pos(F.bx, F.G), 0, RFL(tl[8]) * NN};
                EpiSwiglu<true> E{ssq + 3 * (size_t)T, (const float*)(ws + OFF_RSSLOT), ws + OFF_MACT, DFFE};
                pg8::gemm_phase(F.lds, P, E, F.wave);
#if DBG_PROBE_MOE13
                { __syncthreads(); EpiProbe E2{(float*)(ws + OFF_CTL + 65536) + F.bx * 512}; pg8::gemm_phase(F.lds, P, E2, F.wave); }
#endif
                SEAM(pb + LP_F2);
            }
        }
        int csel = 0, cfr = 0, cextra = 0;
        if (IN(pb + LP_F4)) {
            const int* tl = (const int*)(ws + OFF_TILES);
            constexpr int NN2 = D / 256;
            ProbMoeOrd<DFFE, NN2> P{ws + OFF_MACT, ws + OFF_WM2, {RFL(tl[0]), RFL(tl[1]), RFL(tl[2]), RFL(tl[3]), RFL(tl[4]), RFL(tl[5]), RFL(tl[6]), RFL(tl[7]), RFL(tl[8])}, F.G, moe_pos(F.bx, F.G), 0, RFL(tl[8]) * NN2};
            EpiBf16Out E{(bf16_t*)(ws + OFF_ASORT), D, 1.0f / (SC_ACT * SC_W2)};
            const int ntile = RFL(tl[8]) * NN2, fr = ntile / F.G, extra = ntile - fr * F.G, pc = moe_pos(F.bx, F.G);
            const bool split = MK_SPLIT_COMBINE && IN(pb + LP_F5) && extra > 0 && fr > 0 && extra < F.G;
            if (split) { P.lim = fr * F.G; csel = 2; cfr = fr; cextra = extra; }
#pragma nounroll
            for (int part = 0; part < 2; ++part) {
                if (part == 1) {
                    if (!split) break;
                    split_arrive(bar);
                    if (pc >= extra) { split_wait(bar); Frame Fc = fresh(F); Fc.bx = pc; phase_combine(Fc, 1, fr, extra); break; }
                    P.base = fr * F.G; P.lim = ntile;
                }
                pg8::gemm_phase(F.lds, P, E, F.wave);
            }
            SEAM(pb + LP_F4);
        }
        if (IN(pb + LP_F5)) { phase_combine(fresh(F), csel, cfr, cextra); }
    }
#undef IN
#undef SEAM
}

extern "C" void kernel_launch(void* const* d_in, const int* in_sizes, int n_in, void* d_out, int out_size, void* d_ws, size_t ws_size, hipStream_t stream) {
    static int grid = 0;
    if (grid == 0) {
        int dev = 0, cus = 0;
        if (n_in != 39 || ws_size < WS_NEED || ws_size < OFF_MIX_END) { fprintf(stderr, "kernel_launch: unexpected shapes (n_in %d, ws %zu)\n", n_in, ws_size); grid = -1; return; }
        (void)hipGetDevice(&dev); (void)hipDeviceGetAttribute(&cus, hipDeviceAttributeMultiprocessorCount, dev);
        if (hipFuncSetAttribute((const void*)mk_fwd, hipFuncAttributeMaxDynamicSharedMemorySize, LDS_BYTES) != hipSuccess) { fprintf(stderr, "kernel_launch: hipFuncSetAttribute failed\n"); grid = -1; return; }
        grid = cus;
    }
    if (grid < 0) return;
    (void)hipMemsetAsync((char*)d_ws + OFF_CTL, 0, CTL_ZERO_BYTES, stream);
    Args a{};
    for (int i = 0; i < 39; ++i) a.in[i] = (const float*)d_in[i];
    a.out = (float*)d_out; a.ws = (unsigned char*)d_ws;
#if MK_ONE_LAUNCH
    a.ph_lo = 0; a.ph_hi = PH_TOTAL; hipLaunchKernelGGL(mk_fwd, dim3(grid), dim3(NTHREADS), LDS_BYTES, stream, a);
#else
    for (int ph = 0; ph < PH_TOTAL; ++ph) {
        if (ph >= 1 + LP_F2 && ph < 1 + LP_N) continue;
        if (ph > DBG_LAST_PHASE) break;
        a.ph_lo = ph; a.ph_hi = ph + 1;
        const int nrep = ((DBG_REP_MASK >> ph) & 1ull) ? DBG_REP_N : 1;
        for (int r = 0; r < nrep; ++r) hipLaunchKernelGGL(mk_fwd, dim3(grid), dim3(NTHREADS), LDS_BYTES, stream, a);
    }
#endif
}
```

```cpp
#include <hip/hip_runtime.h>
#include <cstdint>
#include <cstdio>

#define LAS __attribute__((address_space(3)))
#define GAS __attribute__((address_space(1)))
#define CAS __attribute__((address_space(4)))
typedef unsigned short bf16_t;
typedef short bf16x8 __attribute__((ext_vector_type(8)));
typedef short s16x4 __attribute__((ext_vector_type(4)));
typedef float f32x4 __attribute__((ext_vector_type(4)));
typedef float f32x2 __attribute__((ext_vector_type(2)));
typedef unsigned u32x4 __attribute__((ext_vector_type(4)));
typedef unsigned u32x2 __attribute__((ext_vector_type(2)));
typedef int i32x4 __attribute__((ext_vector_type(4)));
typedef int i32x8 __attribute__((ext_vector_type(8)));

constexpr int BATCH = 2, SEQ = 16384, T = BATCH * SEQ, D = 2048;
constexpr int IN_COLS = 3840, ATT_W = 1024, KV_W = 256, RW_W = 512, SS_W = 512, RW_COLS = 1792;
constexpr int ZATT_W = ATT_W + 2 * KV_W;
constexpr int DFF = 5632, DFFE = 7168, NEXP = 8;
constexpr float NORM_EPS = 1e-6f;
constexpr int NWAVES = 8, NTHREADS = 512;
#ifndef MK_ONE_LAUNCH
#define MK_ONE_LAUNCH 1
#define S5_BUILD_TAIL 1
#define S5_BUILD_PRO 1
#define S5_SCAN_IN_G2 1
#define MK_SPLIT_COMBINE 1
#endif
#ifndef FFN_FP8
#define FFN_FP8 3
#endif
#ifndef DBG_PROBE_MOE13
#define DBG_PROBE_MOE13 0
#endif
#ifndef DBG_REP_MASK
#define DBG_REP_MASK 0ull
#endif
#ifndef DBG_REP_N
#define DBG_REP_N 2
#endif
#ifndef DBG_LAST_PHASE
#define DBG_LAST_PHASE 1000
#endif
constexpr int S5C = 64;
constexpr int S5K = 1152;
constexpr int RWC = 128, RWNC = SEQ / RWC;
constexpr int MAXSLOTS = 2 * T + NEXP * 256;

constexpr size_t MiB = 1u << 20;
constexpr size_t OFF_CTL = 0;
constexpr size_t CTL_ZERO_BYTES = 1 * MiB;
constexpr size_t OFF_SS = 1 * MiB;
constexpr size_t OFF_TOKE = OFF_SS + 8 * (size_t)T * 8;
constexpr size_t OFF_TOKG = OFF_TOKE + 2 * (size_t)T * 4;
constexpr size_t OFF_SLOT = OFF_TOKG + 2 * (size_t)T * 4;
constexpr size_t OFF_TOKOF = OFF_SLOT + 2 * (size_t)T * 4;
constexpr size_t OFF_WGCNT = OFF_TOKOF + (size_t)MAXSLOTS * 4;
constexpr size_t OFF_TILES = OFF_WGCNT + 256 * 8 * 4;
constexpr size_t OFF_RSSLOT = OFF_TILES + 256;
static_assert(OFF_RSSLOT + (size_t)MAXSLOTS * 4 <= 6 * MiB, "ctl region");
constexpr size_t OFF_XB = 6 * MiB;
constexpr size_t SZ_XB = (size_t)T * D * 2;
constexpr size_t OFF_WIN = OFF_XB + SZ_XB;
constexpr size_t SZ_WIN = (size_t)IN_COLS * D * 2;
constexpr size_t OFF_WOUT = OFF_WIN + 2 * SZ_WIN;
constexpr size_t SZ_WOUT = (size_t)D * D * 2;
constexpr size_t OFF_W13 = OFF_WOUT + 2 * SZ_WOUT;
constexpr size_t OFF_W2 = OFF_W13 + (size_t)2 * DFF * D * 2;
constexpr size_t OFF_BCAT = OFF_W2 + (size_t)D * DFF * 2;
constexpr size_t SZ_BCAT = (size_t)1536 * 256 * 2;
constexpr size_t OFF_WGLU = OFF_BCAT + 2 * SZ_BCAT;
constexpr size_t SZ_WGLU = (size_t)512 * 512 * 2;
constexpr size_t OFF_S5B2 = OFF_WGLU + 2 * SZ_WGLU;
constexpr size_t SZ_S5B2 = (size_t)32 * 1024 * S5K * 2;
constexpr size_t OFF_S5E = OFF_S5B2 + SZ_S5B2;
constexpr size_t SZ_S5E = (size_t)32 * 256 * 1024 * 2;
constexpr size_t OFF_MIX = OFF_S5E + SZ_S5E;
enum MixBuf { B_ZATT = 0, B_ZRW, B_UEXT, B_XLOC, B_ZG, B_ALORA, B_DEC, B_ICLR, B_GATE, B_STREAM, B_BONUS, B_YLOC, B_PVEC, B_PMAT, B_QMAT, B_SST, B_ATTRAW, B_SSRAW, B_MIXED, B_N };
constexpr size_t mb_size(int b) {
    switch (b) {
        case B_ZATT: return (size_t)T * ZATT_W * 2;
        case B_ZRW: return (size_t)T * RW_COLS * 2;
        case B_UEXT: return (size_t)32 * 512 * S5K * 2;
        case B_XLOC: return (size_t)32 * 512 * 128 * 4;
        case B_ZG: return (size_t)T * 512 * 2;
        case B_ALORA: return (size_t)T * 256 * 2;
        case B_DEC: return (size_t)T * 512 * 4;
        case B_ICLR: return (size_t)T * 512 * 4;
        case B_GATE: return (size_t)T * 512 * 2;
        case B_STREAM: return 0;
        case B_BONUS: return (size_t)2 * T * 8 * 4;
        case B_YLOC: return (size_t)T * 512 * 4;
        case B_PVEC: return (size_t)T * 512 * 4;
        case B_PMAT: return (size_t)2048 * 4096 * 4;
        case B_QMAT: return (size_t)2048 * 4096 * 4;
        case B_SST: return (size_t)2048 * 4096 * 4;
        case B_ATTRAW: return (size_t)T * 1024 * 2;
        case B_SSRAW: return (size_t)T * 512 * 2;
        case B_MIXED: return (size_t)T * D * 2;
    }
    return 0;
}
constexpr int mb_order(int L, int i) {
    constexpr int o0[B_N] = {B_ZATT, B_ZRW, B_UEXT, B_XLOC, B_ZG, B_ALORA, B_DEC, B_ICLR, B_GATE, B_STREAM, B_BONUS, B_YLOC, B_PVEC, B_PMAT, B_QMAT, B_SST, B_ATTRAW, B_SSRAW, B_MIXED};
    constexpr int o1[B_N] = {B_STREAM, B_PVEC, B_ZATT, B_ZRW, B_UEXT, B_XLOC, B_ZG, B_ALORA, B_DEC, B_ICLR, B_GATE, B_BONUS, B_YLOC, B_PMAT, B_QMAT, B_SST, B_ATTRAW, B_SSRAW, B_MIXED};
    return L ? o1[i] : o0[i];
}
constexpr size_t moff(int L, int b) { size_t o = OFF_MIX; for (int i = 0; i < B_N; ++i) { if (mb_order(L, i) == b) return o; o += mb_size(mb_order(L, i)); } return o; }
constexpr size_t OFF_MIX_END = moff(0, B_MIXED) + mb_size(B_MIXED);
static_assert(moff(1, B_MIXED) + mb_size(B_MIXED) == OFF_MIX_END, "both layouts fill the same range");
#define MO(b) (layer ? moff(1, b) : moff(0, b))
constexpr size_t OFF_ACT = OFF_MIX;
static_assert(OFF_ACT + (size_t)T * DFF * 2 <= OFF_MIX_END, "dense act");
constexpr size_t OFF_MACT = OFF_XB;
constexpr size_t OFF_ASORT = OFF_MACT + (size_t)MAXSLOTS * DFFE;
constexpr size_t OFF_WM13 = OFF_MIX_END;
constexpr size_t OFF_WM2 = OFF_WM13 + (size_t)NEXP * 2 * DFFE * D;
__host__ __device__ constexpr size_t s5b2_off(int l) { return l == 0 ? OFF_S5B2 : OFF_WM2 - (SZ_S5B2 + SZ_S5E); }
__host__ __device__ constexpr size_t s5e_off(int l) { return l == 0 ? OFF_S5E : OFF_WM2 - SZ_S5E; }
constexpr size_t OFF_HB = OFF_WM2 + (size_t)NEXP * DFFE * D;
constexpr size_t OFF_X8 = OFF_HB + (size_t)T * D * 2;
constexpr size_t WS_NEED = OFF_X8 + (size_t)T * D;
static_assert((FFN_FP8 & 1) != 0, "OFF_X8 holds an fp8 copy");
static_assert(WS_NEED <= 1879048192ull && OFF_MIX_END <= 1879048192ull && OFF_ASORT + (size_t)MAXSLOTS * D * 2 <= OFF_WM13, "d_ws budget (4 x largest tensor)");

constexpr int RING_BYTES = 131072;
constexpr int MISC_OFF = RING_BYTES;
constexpr int LDS_BYTES = 147456;

__device__ __forceinline__ int lane_id() { int l; asm volatile("v_mbcnt_lo_u32_b32 %0, -1, 0\n\tv_mbcnt_hi_u32_b32 %0, -1, %0" : "=v"(l)); return l; }
#define RFL(x) __builtin_amdgcn_readfirstlane(x)
#define LDS_WAIT() asm volatile("s_waitcnt lgkmcnt(0)" ::: "memory")
#define VM_WAIT() asm volatile("s_waitcnt vmcnt(0)" ::: "memory")
__device__ __forceinline__ unsigned f2bf(float f) { unsigned u = __builtin_bit_cast(unsigned, f); return (u + 0x7fffu + ((u >> 16) & 1u)) >> 16; }
__device__ __forceinline__ unsigned pk2(float lo, float hi) { return f2bf(lo) | (f2bf(hi) << 16); }
__device__ __forceinline__ float bflo(unsigned w) { return __builtin_bit_cast(float, w << 16); }
__device__ __forceinline__ float bfhi(unsigned w) { return __builtin_bit_cast(float, w & 0xffff0000u); }
__device__ __forceinline__ float bf2f(bf16_t b) { return __builtin_bit_cast(float, (unsigned)b << 16); }
__device__ __forceinline__ unsigned cvt_pk_bf16(float lo, float hi) { unsigned r; asm volatile("v_cvt_pk_bf16_f32 %0, %1, %2" : "=v"(r) : "v"(lo), "v"(hi)); return r; }
__device__ __forceinline__ float clamp8(float v) { return __builtin_amdgcn_fmed3f(v, -448.0f, 448.0f); }
__device__ __forceinline__ unsigned pk8(float a, float b, float c, float d) { int w = 0; w = __builtin_amdgcn_cvt_pk_fp8_f32(a, b, w, false); w = __builtin_amdgcn_cvt_pk_fp8_f32(c, d, w, true); return (unsigned)w; }
__device__ __forceinline__ bf16x8 as_bf16(i32x4 v) { return __builtin_bit_cast(bf16x8, v); }
__device__ __forceinline__ i32x8 cat8(bf16x8 lo, bf16x8 hi) { return __builtin_shufflevector(__builtin_bit_cast(i32x4, lo), __builtin_bit_cast(i32x4, hi), 0, 1, 2, 3, 4, 5, 6, 7); }
constexpr float SC_H = 16.0f, SC_ACT = 8.0f, SC_W13 = 1024.0f, SC_W2 = 2048.0f;
__device__ __forceinline__ float wave_sum(float v) {
#pragma unroll
    for (int o = 1; o < 64; o <<= 1) v += __shfl_xor(v, o);
    return v;
}
__device__ __forceinline__ float frcp(float x) { return __builtin_amdgcn_rcpf(x); }
__device__ __forceinline__ float sigmoidf_(float x) { return frcp(1.0f + __builtin_amdgcn_exp2f(-1.4426950408889634f * x)); }
__device__ __forceinline__ unsigned long long ss_fix(float s) { return (unsigned long long)(s * 1048576.0f); }
__device__ __forceinline__ float ss_mean(unsigned long long v, float inv_n) { return (float)v * (1.0f / 1048576.0f) * inv_n + 1e-6f; }
__device__ __forceinline__ float ss_rs(unsigned long long v) { return rsqrtf((float)v * (1.0f / (1048576.0f * 2048.0f)) + 1e-6f); }

#define XB_TMO      128
#define XB_XCNT(j)  (256  + 64 * (j))
#define XB_XSUB(j)  (1280 + 64 * (j))
#define XB_XGEN(j)  (2304 + 64 * (j))
#define XB_TOP      3328
#define XB_TOPGEN   3392
#define XCD_BAR_WORDS 3456
#define XB_SPIN_CAP (1u << 18)
__device__ __forceinline__ unsigned xb_ld(unsigned* p)              { return __hip_atomic_load(p, __ATOMIC_RELAXED, __HIP_MEMORY_SCOPE_AGENT); }
__device__ __forceinline__ unsigned xb_add(unsigned* p, unsigned v) { return __hip_atomic_fetch_add(p, v, __ATOMIC_RELAXED, __HIP_MEMORY_SCOPE_AGENT); }
__device__ __forceinline__ unsigned xb_xcc_id() { return (unsigned)__builtin_amdgcn_s_getreg((3 << 11) | 20) & 0xFu; }
#define XB_SPIN(cond, bar) do { unsigned _sp = 0; while (cond) { __builtin_amdgcn_s_sleep(1); \
    if ((++_sp & 255u) == 0u) { if (xb_ld(&(bar)[XB_TMO])) break; if (_sp > XB_SPIN_CAP) { atomicAdd(&(bar)[XB_TMO], 1u); break; } } } } while (0)
struct XcdBarrier { unsigned* bar; unsigned x; volatile LAS unsigned* st; int wave; };
__device__ __forceinline__ XcdBarrier xcd_barrier_post(unsigned* bar, volatile LAS unsigned* st, int wave) {
    XcdBarrier b; b.bar = bar; b.x = xb_xcc_id(); b.st = st; b.wave = wave;
    if (wave == 0 && lane_id() == 0) (void)xb_add(&bar[XB_XCNT(b.x)], 1u);
    return b;
}
__device__ __forceinline__ void xcd_barrier_complete(unsigned* bar, unsigned x, unsigned& nloc, unsigned& nx) {
    const unsigned G = gridDim.x * gridDim.y * gridDim.z;
    unsigned sum, cnt, mine, sp = 0u;
    for (;;) {
        sum = 0u; cnt = 0u; mine = 0u;
#pragma unroll
        for (unsigned j = 0; j < 16; ++j) { const unsigned c = xb_ld(&bar[XB_XCNT(j)]); sum += c; cnt += (c > 0u) ? 1u : 0u; mine = (j == x) ? c : mine; }
        if (sum == G) break;
        __builtin_amdgcn_s_sleep(1);
        if ((++sp & 255u) == 0u) { if (xb_ld(&bar[XB_TMO])) break; if (sp > XB_SPIN_CAP) { atomicAdd(&bar[XB_TMO], 1u); break; } }
    }
    nloc = mine > 0u ? mine : 1u; nx = cnt > 0u ? cnt : 1u;
}
__device__ __forceinline__ void xcd_barrier(const XcdBarrier& b) {
    asm volatile("s_waitcnt vmcnt(0)" ::: "memory");
    __syncthreads();
    if (b.wave == 0 && lane_id() == 0) {
        unsigned* bar = b.bar;
        __builtin_amdgcn_s_waitcnt(0);
        unsigned nloc = b.st[0], nx = b.st[1];
        if (nloc == 0u) { xcd_barrier_complete(bar, b.x, nloc, nx); b.st[0] = nloc; b.st[1] = nx; }
        const unsigned old = xb_add(&bar[XB_XSUB(b.x)], 1u);
        const unsigned gen = old / nloc;
        if (old + 1u == (gen + 1u) * nloc) {
            __builtin_amdgcn_fence(__ATOMIC_RELEASE, "agent");
            asm volatile("s_waitcnt vmcnt(0)" ::: "memory");
            const unsigned og = xb_add(&bar[XB_TOP], 1u);
            const unsigned tg = og / nx;
            if (og + 1u == (tg + 1u) * nx) xb_add(&bar[XB_TOPGEN], 1u);
            else XB_SPIN(xb_ld(&bar[XB_TOPGEN]) == tg, bar);
            __builtin_amdgcn_fence(__ATOMIC_ACQUIRE, "agent");
            xb_add(&bar[XB_XGEN(b.x)], 1u);
            asm volatile("s_waitcnt vmcnt(0)" ::: "memory");
        } else {
            XB_SPIN(xb_ld(&bar[XB_XGEN(b.x)]) == gen, bar);
            __builtin_amdgcn_fence(__ATOMIC_ACQUIRE, "agent");
            asm volatile("s_waitcnt vmcnt(0)" ::: "memory");
        }
    }
    __syncthreads();
}

#define XS_SUB(j)  (8192 + 64 * (j))
#define XS_TOP     (8192 + 64 * 16)
#define XS_S5FLAG(l) (8192 + 64 * (17 + (l)))
__device__ __forceinline__ void split_arrive(const XcdBarrier& b) {
    asm volatile("s_waitcnt vmcnt(0)" ::: "memory");
    __syncthreads();
    if (b.wave == 0 && lane_id() == 0) {
        unsigned* bar = b.bar;
        __builtin_amdgcn_s_waitcnt(0);
        unsigned nloc = b.st[0], nx = b.st[1];
        if (nloc == 0u) { xcd_barrier_complete(bar, b.x, nloc, nx); b.st[0] = nloc; b.st[1] = nx; }
        const unsigned old = xb_add(&bar[XS_SUB(b.x)], 1u);
        if (old + 1u == nloc) { __builtin_amdgcn_fence(__ATOMIC_RELEASE, "agent"); asm volatile("s_waitcnt vmcnt(0)" ::: "memory"); xb_add(&bar[XS_TOP], 1u); }
    }
}
__device__ __forceinline__ void split_wait(const XcdBarrier& b) {
    if (b.wave == 0 && lane_id() == 0) {
        unsigned* bar = b.bar; const unsigned nx = b.st[1];
        XB_SPIN(xb_ld(&bar[XS_TOP]) != nx, bar);
        __builtin_amdgcn_fence(__ATOMIC_ACQUIRE, "agent");
        asm volatile("s_waitcnt vmcnt(0)" ::: "memory");
    }
    __syncthreads();
}

namespace pg8 {
constexpr int BM = 256, BK = 64, HALF = 128, HTB = HALF * BK * 2, STAGE_BYTES = 8 * HTB, NXCD = 8, WGM = 4;
__host__ __device__ __forceinline__ int lds_byte(int r, int c) { const int st = (r >> 4) * 2 + (c >> 5), rr = r & 15, cc = c & 31, ob = rr * 64 + cc * 2; return st * 1024 + (ob ^ (((ob >> 9) & 1) << 5)); }
__host__ __device__ __forceinline__ void stage_rc(int b, int& R, int& C) { const int st = b / 1024, sb = b % 1024, swz = sb ^ (((sb >> 9) & 1) << 5); R = (st >> 1) * 16 + swz / 64; C = (st & 1) * 32 + (swz % 64) / 2; }
__host__ __device__ __forceinline__ int perm32(int rho) { const int n = rho >> 4, i = rho & 15; return 8 * (i >> 2) + 4 * n + (i & 3); }
struct Unit { int pm, pn; };
__device__ __forceinline__ bool static_unit(int L, int nM, int nN, Unit& u) {
    const int nwg = nM * nN; if (L < 0 || L >= nwg) return false;
    int wgid = (int)L; { const int q = nwg / NXCD, r = nwg % NXCD, xcd = wgid % NXCD, off = wgid / NXCD; wgid = (xcd < r ? xcd * (q + 1) : r * (q + 1) + (xcd - r) * q) + off; }
    const int nig = WGM * nN, gid = wgid / nig, fm = gid * WGM, gsz = (nM - fm) < WGM ? (nM - fm) : WGM;
    u.pm = fm + ((wgid % nig) % gsz); u.pn = (wgid % nig) / gsz; return true;
}

__device__ __forceinline__ void glds_s(const char* sbase, unsigned voff, unsigned ldsdst) {
    asm volatile("s_mov_b32 m0, %2\n\ts_nop 0\n\tglobal_load_lds_dwordx4 %0, %1" : : "v"(voff), "s"(sbase), "s"(ldsdst) : "memory", "m0");
}
__device__ __forceinline__ const char* uniform_ptr(const char* p) { const unsigned long v = (unsigned long)p;
    const unsigned lo = __builtin_amdgcn_readfirstlane((unsigned)v), hi = __builtin_amdgcn_readfirstlane((unsigned)(v >> 32)); return (const char*)(((unsigned long)hi << 32) | lo); }
template <class Epi, class Prob>
__device__ __forceinline__ void gemm_phase(LAS unsigned char* lds, const Prob& P, const Epi& E, int wave) {
    int lane = lane_id(); asm volatile("" : "+v"(lane));
    const int wid = wave, tid = wave * 64 + lane, wr = wid >> 2, wc = wid & 3, fr = lane & 15, fq = lane >> 4;
    constexpr int ESZ = Prob::FP8 ? 1 : 2;
    const int K = P.K, nt = K * ESZ / 128;
    unsigned voffA, voffB;
    { int R, C; stage_rc(tid * 16, R, C); const int Rb = Epi::PERM ? ((R & ~31) + perm32(R & 31)) : R;
      voffA = (unsigned)(R * P.lda * ESZ + 2 * C); voffB = (unsigned)(Rb * P.ldb * ESZ + 2 * C); }
    const size_t r64A = (size_t)64 * P.lda * ESZ, r64B = (size_t)64 * P.ldb * ESZ;
    const unsigned ldsbase = (unsigned)(unsigned long)lds;
    const size_t kstep = (size_t)(BK * 2);
    const size_t hA = (size_t)HALF * P.lda * ESZ, hB = (size_t)HALF * P.ldb * ESZ;
    const unsigned ldsw = (unsigned)wid * 1024u;
    int aoff = lds_byte(wr * 64 + fr, fq * 8), boff = lds_byte(wc * 32 + fr, fq * 8) + 4 * HTB; asm volatile("" : "+v"(aoff), "+v"(boff));
    const LAS unsigned char* la = lds + aoff; const LAS unsigned char* lb = lds + boff;
#define PG8_SA(b, h) (((b) * 2 + (h)) * HTB)
#define PG8_SB(b, h) ((4 + (b) * 2 + (h)) * HTB)
#define PG8_STAGE(bufoff, gbase, AB) do { glds_s((const char*)(gbase), voff##AB, ldsbase + (bufoff) + ldsw); glds_s((const char*)(gbase) + r64##AB, voff##AB, ldsbase + (bufoff) + ldsw + 8192u); } while (0)
#define PG8_LDA(dst, b, h) do { _Pragma("unroll") for (int m = 0; m < 4; ++m) { dst[m].lo = *(const LAS i32x4*)(la + PG8_SA(b, h) + m * 2048); dst[m].hi = *(const LAS i32x4*)(la + PG8_SA(b, h) + m * 2048 + 1024); } } while (0)
#define PG8_LDB(dst, b, h) do { _Pragma("unroll") for (int n = 0; n < 2; ++n) { dst[n].lo = *(const LAS i32x4*)(lb + (PG8_SB(b, h) - 4 * HTB) + n * 2048); dst[n].hi = *(const LAS i32x4*)(lb + (PG8_SB(b, h) - 4 * HTB) + n * 2048 + 1024); } } while (0)
#define PG8_MMA(ai, bj, At, Bt) do { __builtin_amdgcn_s_setprio(1); _Pragma("unroll") for (int m = 0; m < 4; ++m) _Pragma("unroll") for (int n = 0; n < 2; ++n) { \
        if constexpr (Prob::FP8) acc[ai][bj][m][n] = __builtin_amdgcn_mfma_scale_f32_16x16x128_f8f6f4(Bt[n], At[m], acc[ai][bj][m][n], 0, 0, 0, 0x7f7f7f7f, 0, 0x7f7f7f7f); \
        else { acc[ai][bj][m][n] = __builtin_amdgcn_mfma_f32_16x16x32_bf16(as_bf16(Bt[n].lo), as_bf16(At[m].lo), acc[ai][bj][m][n], 0, 0, 0); \
               acc[ai][bj][m][n] = __builtin_amdgcn_mfma_f32_16x16x32_bf16(as_bf16(Bt[n].hi), as_bf16(At[m].hi), acc[ai][bj][m][n], 0, 0, 0); } } \
        __builtin_amdgcn_s_setprio(0); } while (0)
#define PG8_WAIT_V(n) asm volatile("s_waitcnt vmcnt(" #n ")" ::: "memory")
#define PG8_WAIT_L(n) asm volatile("s_waitcnt lgkmcnt(" #n ")" ::: "memory")
#define PG8_BAR __builtin_amdgcn_s_barrier()
#define PG8_SCHED __builtin_amdgcn_sched_barrier(0)
    Unit cur, nxt; int ui = 0;
    if (!P.next(0, cur)) return;
    f32x4 acc[2][2][4][2];
#pragma unroll
    for (int a = 0; a < 2; ++a)
#pragma unroll
        for (int b = 0; b < 2; ++b)
#pragma unroll
            for (int m = 0; m < 4; ++m)
#pragma unroll
                for (int n = 0; n < 2; ++n) acc[a][b][m][n] = (f32x4){0.f, 0.f, 0.f, 0.f};
    i32x8 At[4], B0[2], B1[2];
    const char* cA = uniform_ptr(P.abase(cur)); const char* cB = uniform_ptr(P.bbase(cur));
    PG8_STAGE(PG8_SB(0, 0), cB, B); PG8_STAGE(PG8_SB(0, 1), cB + hB, B); PG8_STAGE(PG8_SA(0, 0), cA, A); PG8_STAGE(PG8_SA(0, 1), cA + hA, A);
    if (wr == 1) PG8_BAR;
    PG8_WAIT_V(2); PG8_BAR;
    PG8_STAGE(PG8_SB(1, 0), cB + kstep, B); PG8_STAGE(PG8_SA(1, 0), cA + kstep, A); PG8_STAGE(PG8_SB(1, 1), cB + hB + kstep, B);
    PG8_WAIT_V(6); PG8_BAR;
    for (;;) {
        const bool has_next = P.next(ui + 1, nxt);
        const char* nA = uniform_ptr(has_next ? P.abase(nxt) : cA); const char* nB = uniform_ptr(has_next ? P.bbase(nxt) : cB);
        int tb = 0;
        for (int seg = 0; seg < (Epi::MID ? 3 : 1); ++seg) {
        int te = nt; if constexpr (Epi::MID) { te = seg == 0 ? Epi::T1 : (seg == 1 ? Epi::T2 : nt); }
        for (int t = tb; t < te; t += 2) {
            const bool last = (t == nt - 2);
            const char* a1 = cA + (size_t)(t + 1) * kstep;
            const char* a2 = last ? nA : cA + (size_t)(t + 2) * kstep; const char* b2 = last ? nB : cB + (size_t)(t + 2) * kstep;
            const char* a3 = a2 + kstep; const char* b3 = b2 + kstep;
            PG8_LDB(B0, 0, 0); PG8_LDB(B1, 0, 1); PG8_SCHED; PG8_LDA(At, 0, 0); PG8_STAGE(PG8_SA(1, 1), a1 + hA, A);
            PG8_WAIT_V(8); PG8_WAIT_L(0); PG8_BAR; PG8_MMA(0, 0, At, B0); PG8_MMA(0, 1, At, B1); PG8_BAR; PG8_SCHED;
            PG8_LDA(At, 0, 1); PG8_STAGE(PG8_SB(0, 0), b2, B); PG8_STAGE(PG8_SB(0, 1), b2 + hB, B); PG8_STAGE(PG8_SA(0, 0), a2, A);
            PG8_WAIT_V(8); PG8_WAIT_L(0); PG8_BAR; PG8_MMA(1, 0, At, B0); PG8_MMA(1, 1, At, B1); PG8_BAR; PG8_SCHED;
            PG8_LDB(B0, 1, 0); PG8_LDB(B1, 1, 1); PG8_SCHED; PG8_LDA(At, 1, 0); PG8_STAGE(PG8_SA(0, 1), a2 + hA, A);
            PG8_WAIT_V(8); PG8_WAIT_L(0); PG8_BAR; PG8_MMA(0, 0, At, B0); PG8_MMA(0, 1, At, B1); PG8_BAR; PG8_SCHED;
            PG8_LDA(At, 1, 1); PG8_STAGE(PG8_SB(1, 0), b3, B); PG8_STAGE(PG8_SB(1, 1), b3 + hB, B); PG8_STAGE(PG8_SA(1, 0), a3, A);
            PG8_WAIT_V(8); PG8_WAIT_L(0); PG8_BAR; PG8_MMA(1, 0, At, B0); PG8_MMA(1, 1, At, B1); PG8_BAR; PG8_SCHED;
        }
        if constexpr (Epi::MID) { if (seg < 2) E.mid(acc, cur, wr, fr, seg); }
        tb = te;
        }
        if (wr == 0) PG8_BAR;
        { int frx = fr, fqx = fq; asm volatile("" : "+v"(frx), "+v"(fqx));
          E(acc, cur, wr, wc, frx, fqx); }
        if (!has_next) break;
#pragma unroll
        for (int a = 0; a < 2; ++a)
#pragma unroll
            for (int b = 0; b < 2; ++b)
#pragma unroll
                for (int m = 0; m < 4; ++m)
#pragma unroll
                    for (int n = 0; n < 2; ++n) acc[a][b][m][n] = (f32x4){0.f, 0.f, 0.f, 0.f};
        cur = nxt; cA = nA; cB = nB; ++ui;
        if (wr == 1) PG8_BAR;
    }
    PG8_WAIT_V(0);
    PG8_BAR;
#undef PG8_SA
#undef PG8_SB
#undef PG8_STAGE
#undef PG8_LDA
#undef PG8_LDB
#undef PG8_MMA
#undef PG8_WAIT_V
#undef PG8_WAIT_L
#undef PG8_BAR
#undef PG8_SCHED
}
}
using pg8::Unit; using pg8::glds_s; using pg8::uniform_ptr;

template <bool FP8_ = false> struct ProbPlainT {
    static constexpr bool FP8 = FP8_;
    const void* A; const void* Bt; int K, lda, ldb, nM, nN, G, c;
    __device__ __forceinline__ bool next(int i, Unit& u) const { return pg8::static_unit(i * G + c, nM, nN, u); }
    __device__ __forceinline__ const char* abase(const Unit& u) const { return (const char*)A + (size_t)u.pm * 256 * lda * (FP8 ? 1 : 2); }
    __device__ __forceinline__ const char* bbase(const Unit& u) const { return (const char*)Bt + (size_t)u.pn * 256 * ldb * (FP8 ? 1 : 2); }
};
typedef ProbPlainT<false> ProbPlain;
typedef ProbPlainT<true> ProbPlain8;

struct Args { const float* in[39]; float* out; unsigned char* ws; int ph_lo, ph_hi; };
static_assert(sizeof(Args) == 39 * 8 + 8 + 8 + 8, "no padding in Args");
enum In { I_X = 0, I_N1G, I_WIN, I_QG, I_KG, I_SINK, I_RELB, I_MU, I_W0, I_W2, I_A0, I_A2, I_G2, I_KK, I_KA, I_RK, I_LNW, I_LNB,
          I_LRE, I_LIM, I_BRE, I_BIM, I_CRE, I_CIM, I_SD, I_DT, I_GLUW, I_GLUB, I_AOG, I_SOG, I_WOUT, I_N2G, I_F1, I_F3, I_F2, I_ROUTER, I_M1, I_M3, I_M2 };

struct Frame {
    LAS unsigned char* lds;
    int tid, lane, wave, G, bx;
    unsigned char* ws; float* out;
};

__device__ __forceinline__ Frame fresh(const Frame& F0) { Frame F = F0; int l = lane_id(); asm volatile("" : "+v"(l)); F.lane = l; F.tid = F0.wave * 64 + l; return F; }
__device__ __forceinline__ void transpose_item(const float* W, int N, bf16_t* WT, int ldt, int k0, int n0, int drow0, const float* gk, LAS float* scr, int lane, const float* gk2 = nullptr) {
#pragma unroll 8
    for (int i = 0; i < 32; ++i) { const int kk = 2 * i + (lane >> 5), k = k0 + kk; float w = W[(size_t)k * N + n0 + (lane & 31)];
        if (gk) w *= gk2 ? (k < 1024 ? gk[k] : (k < 1536 ? 1.0f : gk2[k - 1536])) : gk[k]; scr[kk * 33 + (lane & 31)] = w; }
    LDS_WAIT(); asm volatile("" ::: "memory");
    const int c = lane & 7;
#pragma unroll
    for (int j = 0; j < 4; ++j) { const int n = (lane >> 3) + 8 * j; const LAS float* s = scr + (8 * c) * 33 + n;
        u32x4 o; o.x = pk2(s[0 * 33], s[1 * 33]); o.y = pk2(s[2 * 33], s[3 * 33]); o.z = pk2(s[4 * 33], s[5 * 33]); o.w = pk2(s[6 * 33], s[7 * 33]);
        *(u32x4*)(WT + (size_t)(drow0 + n) * ldt + k0 + 8 * c) = o; }
    LDS_WAIT(); asm volatile("" ::: "memory");
}
__device__ __forceinline__ void cvt8_load(const float* W, int N, int k0, int n0, int lane, f32x4 (&v)[8]) {
    const float* p = W + (size_t)(k0 + (lane >> 3)) * N + n0 + 4 * (lane & 7);
#pragma unroll
    for (int i = 0; i < 8; ++i) v[i] = __builtin_nontemporal_load((const f32x4*)(p + (size_t)(8 * i) * N));
}
__device__ __forceinline__ void cvt8_finish(const f32x4 (&v)[8], unsigned char* WT, int ldt, int k0, int drow0, const float* gk, float wsc, LAS float* scr, int lane) {
    const int r = lane >> 3, c4 = 4 * (lane & 7);
#pragma unroll
    for (int i = 0; i < 8; ++i) { const int kk = 8 * i + r; float sc = wsc; if (gk) sc *= gk[k0 + kk];
        LAS float* d = scr + kk * 33 + c4; d[0] = v[i].x * sc; d[1] = v[i].y * sc; d[2] = v[i].z * sc; d[3] = v[i].w * sc; }
    LDS_WAIT(); asm volatile("" ::: "memory");
    const int c = lane & 3;
#pragma unroll
    for (int j = 0; j < 2; ++j) { const int n = (lane >> 2) + 16 * j; const LAS float* s = scr + (16 * c) * 33 + n;
        u32x4 o; o.x = pk8(s[0 * 33], s[1 * 33], s[2 * 33], s[3 * 33]); o.y = pk8(s[4 * 33], s[5 * 33], s[6 * 33], s[7 * 33]); o.z = pk8(s[8 * 33], s[9 * 33], s[10 * 33], s[11 * 33]); o.w = pk8(s[12 * 33], s[13 * 33], s[14 * 33], s[15 * 33]);
        *(u32x4*)(WT + (size_t)(drow0 + n) * ldt + k0 + 16 * c) = o; }
    LDS_WAIT(); asm volatile("" ::: "memory");
}
__device__ __forceinline__ void transpose_item8(const float* W, int N, unsigned char* WT, int ldt, int k0, int n0, int drow0, const float* gk, float wsc, LAS float* scr, int lane) {
    f32x4 v[8]; cvt8_load(W, N, k0, n0, lane, v); cvt8_finish(v, WT, ldt, k0, drow0, gk, wsc, scr, lane);
}
__device__ __forceinline__ void transpose_matrix8(const Frame& F, const float* W, int K, int N, unsigned char* WT, int ldt, const float* gk, float wsc, int mode) {
    LAS float* scr = (LAS float*)(F.lds + F.wave * 16384);
    const int gw = F.bx * NWAVES + F.wave, NGW = F.G * NWAVES, nblk = N / 32, nitems = (K / 64) * nblk;
    for (int it = gw; it < nitems; it += NGW) {
        const int kb = it / nblk, nb = it % nblk, n0 = 32 * nb;
        const int drow0 = mode == 0 ? n0 : (n0 >> 7) * 256 + (n0 & 127) + (mode == 2 ? 128 : 0);
        transpose_item8(W, N, WT, ldt, 64 * kb, n0, drow0, gk, wsc, scr, F.lane);
    }
}
__device__ __forceinline__ void transpose_matrix(const Frame& F, const float* W, int K, int N, bf16_t* WT, int ldt, const float* gk, int mode, const float* gk2 = nullptr) {
    LAS float* scr = (LAS float*)(F.lds + F.wave * 16384);
    const int gw = F.bx * NWAVES + F.wave, NGW = F.G * NWAVES, nblk = N / 32, nitems = (K / 64) * nblk;
    for (int it = gw; it < nitems; it += NGW) {
        const int kb = it / nblk, nb = it % nblk, n0 = 32 * nb;
        const int drow0 = mode == 0 ? n0 : (n0 >> 7) * 256 + (n0 & 127) + (mode == 2 ? 128 : 0);
        transpose_item(W, N, WT, ldt, 64 * kb, n0, drow0, gk, scr, F.lane, gk2);
    }
}

constexpr int MOE_ITEMS = NEXP * 3 * 7168;
struct MoeItem { const float* W; unsigned char* WT; const float* gk; float wsc; int N, ldt, k0, n0, drow0; };
__device__ __forceinline__ MoeItem moe_item(const CAS Args& a, unsigned char* ws, int I) {
    MoeItem m; const int e = I / 21504, r = I - e * 21504, mat = r / 7168, it = r - mat * 7168;
    if (mat < 2) { const int nblk = DFFE / 32, kb = it / nblk, n0 = 32 * (it % nblk);
        m.W = (mat == 0 ? a.in[I_M1] : a.in[I_M3]) + (size_t)e * D * DFFE; m.N = DFFE; m.WT = ws + OFF_WM13 + (size_t)e * 2 * DFFE * D; m.ldt = D; m.k0 = 64 * kb; m.n0 = n0;
        m.drow0 = (n0 >> 7) * 256 + (n0 & 127) + (mat == 1 ? 128 : 0); m.gk = a.in[I_N2G] + D; m.wsc = SC_W13; }
    else { const int nblk = D / 32, kb = it / nblk, n0 = 32 * (it % nblk);
        m.W = a.in[I_M2] + (size_t)e * DFFE * D; m.N = D; m.WT = ws + OFF_WM2 + (size_t)e * D * DFFE; m.ldt = DFFE; m.k0 = 64 * kb; m.n0 = n0; m.drow0 = n0; m.gk = nullptr; m.wsc = SC_W2; }
    return m;
}
__device__ __forceinline__ void moe_convert_range(const Frame& F, const CAS Args& a, int i0, int i1, int wg0, int nwg) {
    if (F.bx < wg0 || F.bx >= wg0 + nwg) return;
    LAS float* scr = (LAS float*)(F.lds + F.wave * 16384);
    const int step = nwg * NWAVES;
    int I = i0 + (F.bx - wg0) * NWAVES + F.wave;
    if (I >= i1) return;
    MoeItem cur = moe_item(a, F.ws, I); f32x4 v[8]; cvt8_load(cur.W, cur.N, cur.k0, cur.n0, F.lane, v);
    for (;;) {
        const int In = I + step; const bool more = In < i1;
        MoeItem nxt = cur; f32x4 w[8];
        if (more) { nxt = moe_item(a, F.ws, In); cvt8_load(nxt.W, nxt.N, nxt.k0, nxt.n0, F.lane, w); }
        cvt8_finish(v, cur.WT, cur.ldt, cur.k0, cur.drow0, cur.gk, cur.wsc, scr, F.lane);
        if (!more) break;
        cur = nxt; I = In;
#pragma unroll
        for (int i = 0; i < 8; ++i) v[i] = w[i];
    }
}
constexpr int MOE_EARLY = 30000;
constexpr int MOE_TAIL = 12288;
static_assert(!S5_BUILD_PRO || 2 * (MOE_EARLY + MOE_TAIL) <= 4 * 21504, "layer 1's S5 operators live in the w1|w3 region of experts >= 4 until the F1 phase");
__device__ __forceinline__ void phase_s5_build(const Frame& F, const CAS Args& a, int layer, int wg0, int nwg);
__device__ __forceinline__ void phase_prologue(const Frame& F, const CAS Args& a) {
    unsigned char* ws = F.ws;
    if (S5_BUILD_PRO && (F.bx & 1)) { phase_s5_build(F, a, 0, 0, F.G); phase_s5_build(F, a, 1, 0, F.G); __syncthreads(); }
    { unsigned long long* ss = (unsigned long long*)(ws + OFF_SS); for (size_t i = (size_t)F.bx * NTHREADS + F.tid; i < 8 * (size_t)T; i += (size_t)F.G * NTHREADS) if (i >= (size_t)T) ss[i] = 0ull; }
    for (int l = 0; l < 2; ++l) {
        transpose_matrix(F, a.in[I_WIN] + (size_t)l * D * IN_COLS, D, IN_COLS, (bf16_t*)(ws + OFF_WIN + l * SZ_WIN), D, a.in[I_N1G] + l * D, 0);
        transpose_matrix(F, a.in[I_WOUT] + (size_t)l * D * D, D, D, (bf16_t*)(ws + OFF_WOUT + l * SZ_WOUT), D, a.in[I_AOG] + l * ATT_W, 0, a.in[I_SOG] + l * SS_W);
        transpose_matrix(F, a.in[I_GLUW] + (size_t)l * 512 * 512, 512, 512, (bf16_t*)(ws + OFF_WGLU + l * SZ_WGLU), 512, nullptr, 0);
    }
    if constexpr (FFN_FP8 & 1) { transpose_matrix8(F, a.in[I_F1], D, DFF, ws + OFF_W13, D, a.in[I_N2G], SC_W13, 1); transpose_matrix8(F, a.in[I_F3], D, DFF, ws + OFF_W13, D, a.in[I_N2G], SC_W13, 2); }
    else { transpose_matrix(F, a.in[I_F1], D, DFF, (bf16_t*)(ws + OFF_W13), D, a.in[I_N2G], 1); transpose_matrix(F, a.in[I_F3], D, DFF, (bf16_t*)(ws + OFF_W13), D, a.in[I_N2G], 2); }
    if constexpr (FFN_FP8 & 2) transpose_matrix8(F, a.in[I_F2], DFF, D, ws + OFF_W2, DFF, nullptr, SC_W2, 0);
    else transpose_matrix(F, a.in[I_F2], DFF, D, (bf16_t*)(ws + OFF_W2), DFF, nullptr, 0);
    for (int l = 0; l < 2; ++l) {
        bf16_t* bc = (bf16_t*)(ws + OFF_BCAT + l * SZ_BCAT);
        const float* w2 = a.in[I_W2] + (size_t)l * 64 * 512; const float* a2 = a.in[I_A2] + (size_t)l * 64 * 512; const float* g2 = a.in[I_G2] + (size_t)l * 128 * 512;
        for (int i = F.bx * NTHREADS + F.tid; i < 1536 * 256; i += F.G * NTHREADS) {
            const int n = i >> 8, k = i & 255, blk = n >> 9, nn = n & 511; float v = 0.f;
            if (blk == 0 && k < 64) v = w2[k * 512 + nn];
            else if (blk == 1 && k >= 64 && k < 128) v = a2[(k - 64) * 512 + nn];
            else if (blk == 2 && k >= 128) v = g2[(k - 128) * 512 + nn];
            bc[i] = (bf16_t)f2bf(v);
        }
    }
    { const float* x = a.in[I_X]; bf16_t* xb = (bf16_t*)(ws + OFF_XB); unsigned long long* ss0 = (unsigned long long*)(ws + OFF_SS);
      const int gw = F.bx * NWAVES + F.wave, NGW = F.G * NWAVES;
      for (int m = gw; m < T; m += NGW) {
          const f32x4* xr = (const f32x4*)(x + (size_t)m * D) + F.lane; u32x2* o8 = (u32x2*)(xb + (size_t)m * D) + F.lane; float s = 0.f;
#pragma unroll
          for (int j = 0; j < 8; ++j) { const f32x4 v = __builtin_nontemporal_load(xr + 64 * j); s += (v.x * v.x + v.y * v.y) + (v.z * v.z + v.w * v.w); u32x2 w; w.x = pk2(v.x, v.y); w.y = pk2(v.z, v.w); o8[64 * j] = w; }
          s = wave_sum(s); if (F.lane == 0) ss0[m] = ss_fix(s);
      } }
    if (S5_BUILD_PRO && !(F.bx & 1)) { __syncthreads(); phase_s5_build(F, a, 0, 0, F.G); phase_s5_build(F, a, 1, 0, F.G); }
}

struct EpiInProj {
    static constexpr bool PERM = true, MID = false;
    const unsigned long long* ssq; bf16_t* zatt; bf16_t* zrw; bf16_t* uext;
    __device__ __forceinline__ void operator()(const f32x4 (&acc)[2][2][4][2], const Unit& u, int wr, int wc, int fr, int fq) const {
        const int row0 = u.pm * 256 + wr * 64 + fr, colt = wc * 32 + 8 * fq;
        float rsv[2][4];
#pragma unroll
        for (int ai = 0; ai < 2; ++ai)
#pragma unroll
            for (int m = 0; m < 4; ++m) rsv[ai][m] = ss_rs(ssq[row0 + ai * 128 + m * 16]);
#pragma unroll
        for (int ai = 0; ai < 2; ++ai)
#pragma unroll
            for (int m = 0; m < 4; ++m) {
                const int row = row0 + ai * 128 + m * 16; const float rs = rsv[ai][m];
#pragma unroll
                for (int bj = 0; bj < 2; ++bj) {
                    const f32x4 v0 = acc[ai][bj][m][0] * rs, v1 = acc[ai][bj][m][1] * rs;
                    u32x4 w; w.x = cvt_pk_bf16(v0[0], v0[1]); w.y = cvt_pk_bf16(v0[2], v0[3]); w.z = cvt_pk_bf16(v1[0], v1[1]); w.w = cvt_pk_bf16(v1[2], v1[3]);
                    const int ct = bj * 128 + colt;
                    if (u.pn < 6) *(u32x4*)(zatt + (size_t)row * ZATT_W + u.pn * 256 + ct) = w;
                    else if (u.pn < 13) *(u32x4*)(zrw + (size_t)row * RW_COLS + (u.pn - 6) * 256 + ct) = w;
                    else { const int ch = (u.pn - 13) * 256 + ct, g = ch >> 4, half = (ch >> 3) & 1;
                           *(u32x4*)(uext + ((size_t)(g * 512 + (row >> 6)) * S5K + (row & 63) * 16 + half * 8)) = w; }
                }
            }
    }
};

template <bool OUT8, bool MIX = false, bool H16IN = true, bool COPY = true> struct EpiResid {
    static constexpr bool PERM = true, MID = MIX; static constexpr int T1 = 16, T2 = 24;
    const void* hold; bf16_t* hnew; void* xb; unsigned long long* ssq; float asc; const unsigned long long* ssA; const unsigned long long* ssS;
    __device__ __forceinline__ void mid(f32x4 (&acc)[2][2][4][2], const Unit& u, int wr, int fr, int which) const {
        const int row0 = u.pm * 256 + wr * 64 + fr; float f[2][4];
#pragma unroll
        for (int ai = 0; ai < 2; ++ai)
#pragma unroll
            for (int m = 0; m < 4; ++m) { const int row = row0 + ai * 128 + m * 16; f[ai][m] = which == 0 ? rsqrtf(ss_mean(ssA[row], 1.0f / ATT_W)) : sqrtf(ss_mean(ssS[row], 1.0f / SS_W)); }
#pragma unroll
        for (int ai = 0; ai < 2; ++ai)
#pragma unroll
            for (int bj = 0; bj < 2; ++bj)
#pragma unroll
                for (int m = 0; m < 4; ++m)
#pragma unroll
                    for (int n = 0; n < 2; ++n) acc[ai][bj][m][n] *= f[ai][m];
    }
    __device__ __forceinline__ void operator()(const f32x4 (&acc)[2][2][4][2], const Unit& u, int wr, int wc, int fr, int fq) const {
        const int row0 = u.pm * 256 + wr * 64 + fr, col0 = u.pn * 256 + wc * 32 + 8 * fq;
#pragma unroll
        for (int ai = 0; ai < 2; ++ai) {
            f32x4 hv[4][2][2];
#pragma unroll
            for (int m = 0; m < 4; ++m)
#pragma unroll
                for (int bj = 0; bj < 2; ++bj) { const size_t off = (size_t)(row0 + ai * 128 + m * 16) * D + col0 + bj * 128;
                    if constexpr (H16IN) { const u32x4 hb = *(const u32x4*)((const bf16_t*)hold + off);
                        hv[m][bj][0] = (f32x4){bflo(hb.x), bfhi(hb.x), bflo(hb.y), bfhi(hb.y)}; hv[m][bj][1] = (f32x4){bflo(hb.z), bfhi(hb.z), bflo(hb.w), bfhi(hb.w)}; }
                    else { hv[m][bj][0] = *(const f32x4*)((const float*)hold + off); hv[m][bj][1] = *(const f32x4*)((const float*)hold + off + 4); } }
#pragma unroll
            for (int m = 0; m < 4; ++m) {
                const int row = row0 + ai * 128 + m * 16; float s = 0.f; const float sc = MIX ? asc * rsqrtf(ss_mean(ssS[row], 1.0f / SS_W)) : asc;
#pragma unroll
                for (int bj = 0; bj < 2; ++bj) {
                    const size_t off = (size_t)row * D + col0 + bj * 128;
                    const f32x4 v0 = acc[ai][bj][m][0] * sc + hv[m][bj][0], v1 = acc[ai][bj][m][1] * sc + hv[m][bj][1];
                    { u32x4 w; w.x = cvt_pk_bf16(v0[0], v0[1]); w.y = cvt_pk_bf16(v0[2], v0[3]); w.z = cvt_pk_bf16(v1[0], v1[1]); w.w = cvt_pk_bf16(v1[2], v1[3]);
                      *(u32x4*)(hnew + off) = w; }
                    if constexpr (COPY && OUT8) { u32x2 w; w.x = pk8(clamp8(v0[0] * SC_H), clamp8(v0[1] * SC_H), clamp8(v0[2] * SC_H), clamp8(v0[3] * SC_H)); w.y = pk8(clamp8(v1[0] * SC_H), clamp8(v1[1] * SC_H), clamp8(v1[2] * SC_H), clamp8(v1[3] * SC_H));
                        *(u32x2*)((unsigned char*)xb + off) = w; }
                    else if constexpr (COPY) { u32x4 w; w.x = cvt_pk_bf16(v0[0], v0[1]); w.y = cvt_pk_bf16(v0[2], v0[3]); w.z = cvt_pk_bf16(v1[0], v1[1]); w.w = cvt_pk_bf16(v1[2], v1[3]);
                        *(u32x4*)((bf16_t*)xb + off) = w; }
                    s += (v0[0] * v0[0] + v0[1] * v0[1]) + (v0[2] * v0[2] + v0[3] * v0[3]) + (v1[0] * v1[0] + v1[1] * v1[1]) + (v1[2] * v1[2] + v1[3] * v1[3]);
                }
                s += __shfl_xor(s, 16); s += __shfl_xor(s, 32);
                if (fq == 0) atomicAdd(ssq + row, ss_fix(s));
            }
            asm volatile("" ::: "memory");
        }
    }
};

constexpr int AT_KN = 0, AT_KROW = 72;
constexpr int AT_VT = 256 * AT_KROW * 2, AT_VROW = 264;
constexpr int AT_TB = AT_VT + 64 * AT_VROW * 2;
__device__ __forceinline__ int t5_bucket(int d) {
    if (d < 16) return d;
    int lg = 16 + (int)(logf((float)d / 16.0f) / 2.0794415416798357f * 16.0f);
    return lg < 31 ? lg : 31;
}
__device__ __forceinline__ void phase_attention(const Frame& F, const CAS Args& a, int layer) {
    const bf16_t* zatt = (const bf16_t*)(F.ws + MO(B_ZATT)); bf16_t* mixed = (bf16_t*)(F.ws + MO(B_MIXED));
    unsigned long long* ssA = (unsigned long long*)(F.ws + OFF_SS) + (size_t)(4 + 2 * layer) * T;
    const float* qg = a.in[I_QG] + layer * 64; const float* kg = a.in[I_KG] + layer * 64; const float* sinks = a.in[I_SINK] + layer * 16; const float* relb = a.in[I_RELB];
    LAS bf16_t* Kn = (LAS bf16_t*)(F.lds + AT_KN); LAS bf16_t* Vt = (LAS bf16_t*)(F.lds + AT_VT); LAS float* tb = (LAS float*)(F.lds + AT_TB);
    const int lane = F.lane, qi = lane & 15, q4 = lane >> 4;
    for (int unit = F.bx; unit < 1024; unit += F.G) {
        const int kvh = unit & 3, n = (unit >> 2) & 127, b = unit >> 9;
        __syncthreads();
        {
            const int key = F.tid >> 1, half = F.tid & 1, tk = (n - 1) * 128 + key; const bool valid = tk >= 0;
            const size_t row = (size_t)b * SEQ + (valid ? tk : 0);
            const u32x4* kp = (const u32x4*)(zatt + row * ZATT_W + ATT_W + kvh * 64 + half * 32);
            const u32x4* vp = (const u32x4*)(zatt + row * ZATT_W + ATT_W + KV_W + kvh * 64 + half * 32);
            u32x4 kr[4], vr[4];
#pragma unroll
            for (int i = 0; i < 4; ++i) { kr[i] = kp[i]; vr[i] = vp[i]; }
            float kf[32]; float ss = 0.f;
#pragma unroll
            for (int i = 0; i < 4; ++i) { const unsigned w[4] = {kr[i].x, kr[i].y, kr[i].z, kr[i].w};
#pragma unroll
                for (int j = 0; j < 4; ++j) { const float lo = bflo(w[j]), hi = bfhi(w[j]); kf[i * 8 + 2 * j] = lo; kf[i * 8 + 2 * j + 1] = hi; ss += lo * lo + hi * hi; } }
            ss += __shfl_xor(ss, 1);
            const float rs = valid ? rsqrtf(ss * (1.0f / 64.0f) + NORM_EPS) : 0.f;
#pragma unroll
            for (int i = 0; i < 4; ++i) { u32x4 o;
                o.x = pk2(kf[i * 8 + 0] * rs * kg[half * 32 + i * 8 + 0], kf[i * 8 + 1] * rs * kg[half * 32 + i * 8 + 1]);
                o.y = pk2(kf[i * 8 + 2] * rs * kg[half * 32 + i * 8 + 2], kf[i * 8 + 3] * rs * kg[half * 32 + i * 8 + 3]);
                o.z = pk2(kf[i * 8 + 4] * rs * kg[half * 32 + i * 8 + 4], kf[i * 8 + 5] * rs * kg[half * 32 + i * 8 + 5]);
                o.w = pk2(kf[i * 8 + 6] * rs * kg[half * 32 + i * 8 + 6], kf[i * 8 + 7] * rs * kg[half * 32 + i * 8 + 7]);
                *(LAS u32x4*)(Kn + key * AT_KROW + half * 32 + i * 8) = o; }
#pragma unroll
            for (int i = 0; i < 4; ++i) { const unsigned w[4] = {vr[i].x, vr[i].y, vr[i].z, vr[i].w};
#pragma unroll
                for (int j = 0; j < 4; ++j) { const int d = half * 32 + i * 8 + 2 * j;
                    Vt[d * AT_VROW + key] = valid ? (bf16_t)(w[j] & 0xffffu) : (bf16_t)0; Vt[(d + 1) * AT_VROW + key] = valid ? (bf16_t)(w[j] >> 16) : (bf16_t)0; } }
            const int g = F.tid >> 7, dist = F.tid & 127;
            tb[g * 128 + dist] = relb[t5_bucket(dist) * 16 + kvh * 4 + g];
        }
        __syncthreads();
        for (int grp = F.wave; grp < 32; grp += NWAVES) {
            const int g = grp >> 3, qb = grp & 7, h = kvh * 4 + g, i0 = qb * 16;
            const size_t rowq = (size_t)b * SEQ + n * 128 + i0 + qi;
            bf16x8 qf[2];
            {   const u32x4 q0 = *(const u32x4*)(zatt + rowq * ZATT_W + h * 64 + q4 * 8), q1 = *(const u32x4*)(zatt + rowq * ZATT_W + h * 64 + 32 + q4 * 8);
                const unsigned w[8] = {q0.x, q0.y, q0.z, q0.w, q1.x, q1.y, q1.z, q1.w}; float qv[16]; float ss = 0.f;
#pragma unroll
                for (int j = 0; j < 8; ++j) { qv[2 * j] = bflo(w[j]); qv[2 * j + 1] = bfhi(w[j]); ss += qv[2 * j] * qv[2 * j] + qv[2 * j + 1] * qv[2 * j + 1]; }
                ss += __shfl_xor(ss, 16); ss += __shfl_xor(ss, 32);
                const float rs = rsqrtf(ss * (1.0f / 64.0f) + NORM_EPS) * 0.125f;
#pragma unroll
                for (int ks = 0; ks < 2; ++ks) { u32x4 o;
                    const float* gq = qg + ks * 32 + q4 * 8; const float* qq = qv + ks * 8;
                    o.x = pk2(qq[0] * rs * gq[0], qq[1] * rs * gq[1]); o.y = pk2(qq[2] * rs * gq[2], qq[3] * rs * gq[3]);
                    o.z = pk2(qq[4] * rs * gq[4], qq[5] * rs * gq[5]); o.w = pk2(qq[6] * rs * gq[6], qq[7] * rs * gq[7]);
                    qf[ks] = __builtin_bit_cast(bf16x8, o); }
            }
            f32x4 s[9];
#pragma unroll
            for (int kbi = 0; kbi < 9; ++kbi) {
                f32x4 c = (f32x4){0.f, 0.f, 0.f, 0.f};
#pragma unroll
                for (int ks = 0; ks < 2; ++ks) {
                    const bf16x8 kfr = *(const LAS bf16x8*)(Kn + (16 * (qb + kbi) + qi) * AT_KROW + ks * 32 + q4 * 8);
                    c = __builtin_amdgcn_mfma_f32_16x16x32_bf16(kfr, qf[ks], c, 0, 0, 0);
                }
                s[kbi] = c;
            }
            const float sink = sinks[h]; float mx = sink;
#pragma unroll
            for (int kbi = 0; kbi < 9; ++kbi)
#pragma unroll
                for (int r = 0; r < 4; ++r) {
                    const int j = 16 * (qb + kbi) + 4 * q4 + r, dist = 128 + i0 + qi - j;
                    const bool valid = dist >= 0 && dist < 128 && (n > 0 || j >= 128);
                    const float v = valid ? s[kbi][r] + tb[g * 128 + (dist & 127)] : -INFINITY;
                    s[kbi][r] = v; mx = fmaxf(mx, v);
                }
            mx = fmaxf(mx, __shfl_xor(mx, 16)); mx = fmaxf(mx, __shfl_xor(mx, 32));
            float sum = 0.f;
#pragma unroll
            for (int kbi = 0; kbi < 9; ++kbi)
#pragma unroll
                for (int r = 0; r < 4; ++r) { const float p = __expf(s[kbi][r] - mx); s[kbi][r] = p; sum += p; }
            sum += __shfl_xor(sum, 16); sum += __shfl_xor(sum, 32);
            const float inv = frcp(sum + __expf(sink - mx));
            bf16x8 pf[5];
#pragma unroll
            for (int pp = 0; pp < 5; ++pp) { u32x4 o; o.x = pk2(s[2 * pp][0], s[2 * pp][1]); o.y = pk2(s[2 * pp][2], s[2 * pp][3]);
                if (pp < 4) { o.z = pk2(s[2 * pp + 1][0], s[2 * pp + 1][1]); o.w = pk2(s[2 * pp + 1][2], s[2 * pp + 1][3]); } else { o.z = 0u; o.w = 0u; }
                pf[pp] = __builtin_bit_cast(bf16x8, o); }
            float osq = 0.f;
#pragma unroll
            for (int db = 0; db < 4; ++db) {
                f32x4 o = (f32x4){0.f, 0.f, 0.f, 0.f};
#pragma unroll
                for (int pp = 0; pp < 5; ++pp) {
                    const LAS bf16_t* vrow = Vt + (16 * db + qi) * AT_VROW + 4 * q4;
                    const u32x2 va = *(const LAS u32x2*)(vrow + 16 * (qb + 2 * pp));
                    const u32x2 vb = *(const LAS u32x2*)(vrow + 16 * (qb + (pp < 4 ? 2 * pp + 1 : 2 * pp)));
                    u32x4 vv; vv.x = va.x; vv.y = va.y; vv.z = vb.x; vv.w = vb.y;
                    o = __builtin_amdgcn_mfma_f32_16x16x32_bf16(__builtin_bit_cast(bf16x8, vv), pf[pp], o, 0, 0, 0);
                }
                o = o * inv; osq += (o[0] * o[0] + o[1] * o[1]) + (o[2] * o[2] + o[3] * o[3]);
                u32x2 w; w.x = pk2(o[0], o[1]); w.y = pk2(o[2], o[3]);
                *(u32x2*)(mixed + rowq * D + h * 64 + 16 * db + 4 * q4) = w;
            }
            osq += __shfl_xor(osq, 16); osq += __shfl_xor(osq, 32);
            if (q4 == 0) atomicAdd(ssA + rowq, ss_fix(osq));
        }
    }
}

__device__ __forceinline__ void phase_finalize_mixed(const Frame& F, const CAS Args& a, int layer, int dbg_zero) {
    const bf16_t* attraw = (const bf16_t*)(F.ws + MO(B_ATTRAW)); const bf16_t* ssraw = (const bf16_t*)(F.ws + MO(B_SSRAW)); bf16_t* mixed = (bf16_t*)(F.ws + MO(B_MIXED));
    const float* aog = a.in[I_AOG] + layer * ATT_W; const float* sog = a.in[I_SOG] + layer * SS_W;
    const int gw = F.bx * NWAVES + F.wave, NGW = F.G * NWAVES, lane = F.lane;
    for (int m = gw; m < T; m += NGW) {
        {   const u32x4* p = (const u32x4*)(attraw + (size_t)m * ATT_W) + lane * 2; const u32x4 v0 = p[0], v1 = p[1];
            const unsigned w[8] = {v0.x, v0.y, v0.z, v0.w, v1.x, v1.y, v1.z, v1.w}; float f[16]; float ss = 0.f;
#pragma unroll
            for (int j = 0; j < 8; ++j) { f[2 * j] = bflo(w[j]); f[2 * j + 1] = bfhi(w[j]); ss += f[2 * j] * f[2 * j] + f[2 * j + 1] * f[2 * j + 1]; }
            ss = wave_sum(ss); const float rs = rsqrtf(ss * (1.0f / ATT_W) + NORM_EPS); const float* g = aog + lane * 16;
            u32x4 o0, o1;
            o0.x = pk2(f[0] * rs * g[0], f[1] * rs * g[1]); o0.y = pk2(f[2] * rs * g[2], f[3] * rs * g[3]); o0.z = pk2(f[4] * rs * g[4], f[5] * rs * g[5]); o0.w = pk2(f[6] * rs * g[6], f[7] * rs * g[7]);
            o1.x = pk2(f[8] * rs * g[8], f[9] * rs * g[9]); o1.y = pk2(f[10] * rs * g[10], f[11] * rs * g[11]); o1.z = pk2(f[12] * rs * g[12], f[13] * rs * g[13]); o1.w = pk2(f[14] * rs * g[14], f[15] * rs * g[15]);
            u32x4* q = (u32x4*)(mixed + (size_t)m * D) + lane * 2; q[0] = o0; q[1] = o1; }
        {   const u32x4 v0 = *((const u32x4*)(ssraw + (size_t)m * SS_W) + lane);
            const unsigned w[4] = {v0.x, v0.y, v0.z, v0.w}; float f[8]; float ss = 0.f;
#pragma unroll
            for (int j = 0; j < 4; ++j) { f[2 * j] = bflo(w[j]); f[2 * j + 1] = bfhi(w[j]); ss += f[2 * j] * f[2 * j] + f[2 * j + 1] * f[2 * j + 1]; }
            ss = wave_sum(ss); const float rs = rsqrtf(ss * (1.0f / SS_W) + NORM_EPS); const float* g = sog + lane * 8;
            u32x4 o0; o0.x = pk2(f[0] * rs * g[0], f[1] * rs * g[1]); o0.y = pk2(f[2] * rs * g[2], f[3] * rs * g[3]); o0.z = pk2(f[4] * rs * g[4], f[5] * rs * g[5]); o0.w = pk2(f[6] * rs * g[6], f[7] * rs * g[7]);
            if (dbg_zero & 2) o0 = (u32x4){0u, 0u, 0u, 0u};
            *((u32x4*)(mixed + (size_t)m * D + 1536) + lane) = o0; }
        if (dbg_zero & 1) *((u32x4*)(mixed + (size_t)m * D + 1024) + lane) = (u32x4){0u, 0u, 0u, 0u};
    }
}

constexpr int S5L_PWR = 0, S5L_PWI = 65 * 64 * 4, S5L_BBR = 2 * 65 * 64 * 4, S5L_BBI = S5L_BBR + 4096, S5L_CR = S5L_BBI + 4096, S5L_CI = S5L_CR + 4096, S5L_KT = S5L_CI + 4096;
static_assert(S5L_KT + 64 * 256 * 4 <= RING_BYTES, "S5 build LDS");
__device__ __forceinline__ void phase_s5_build(const Frame& F, const CAS Args& a, int layer, int wg0, int nwg) {
    LAS float* pwr = (LAS float*)(F.lds + S5L_PWR); LAS float* pwi = (LAS float*)(F.lds + S5L_PWI);
    LAS float* bbr = (LAS float*)(F.lds + S5L_BBR); LAS float* bbi = (LAS float*)(F.lds + S5L_BBI);
    LAS float* cr = (LAS float*)(F.lds + S5L_CR); LAS float* ci = (LAS float*)(F.lds + S5L_CI); LAS float* kt = (LAS float*)(F.lds + S5L_KT);
    const int tid = F.tid;
    if (F.bx < wg0 || F.bx >= wg0 + nwg) return;
    for (int wi = F.bx - wg0; wi < 256; wi += nwg) {
        const int g = wi >> 3, part = wi & 7;
        __syncthreads();
        const int lg = layer * 32 + g;
        const float dt = expf(a.in[I_DT][lg]);
        {   const int p = tid & 63; const float lr = a.in[I_LRE][lg * 64 + p], li = a.in[I_LIM][lg * 64 + p];
            for (int tau = tid >> 6; tau <= 64; tau += 8) { const float mag = expf(lr * dt * (float)tau); float sn, cs; sincosf(li * dt * (float)tau, &sn, &cs); pwr[tau * 64 + p] = mag * cs; pwi[tau * 64 + p] = mag * sn; } }
        __syncthreads();
        for (int i = tid; i < 1024; i += NTHREADS) {
            const int p = i >> 4;
            const float lr = a.in[I_LRE][lg * 64 + p], li = a.in[I_LIM][lg * 64 + p], den = lr * lr + li * li;
            const float are = pwr[64 + p] - 1.0f, aim = pwi[64 + p];
            const float fr = (are * lr + aim * li) / den, fi = (aim * lr - are * li) / den;
            const float br = a.in[I_BRE][(size_t)lg * 1024 + i], bi = a.in[I_BIM][(size_t)lg * 1024 + i];
            bbr[i] = fr * br - fi * bi; bbi[i] = fr * bi + fi * br;
            cr[i] = a.in[I_CRE][(size_t)lg * 1024 + i]; ci[i] = a.in[I_CIM][(size_t)lg * 1024 + i];
        }
        __syncthreads();
        {
            const int mp = tid & 15, ml = (tid >> 4) & 1, m = 2 * part + ml, th = tid >> 5;
            float acc[4] = {0.f, 0.f, 0.f, 0.f};
            for (int p = 0; p < 64; ++p) {
                const float c_r = cr[m * 64 + p], c_i = ci[m * 64 + p], b_r = bbr[p * 16 + mp], b_i = bbi[p * 16 + mp];
                const float cbr = c_r * b_r - c_i * b_i, cbi = c_r * b_i + c_i * b_r;
#pragma unroll
                for (int j = 0; j < 4; ++j) { const int tau = 4 * th + j; acc[j] += pwr[tau * 64 + p] * cbr - pwi[tau * 64 + p] * cbi; }
            }
            if (th == 0 && m == mp) acc[0] += a.in[I_SD][layer * 512 + g * 16 + m];
#pragma unroll
            for (int j = 0; j < 4; ++j) kt[(4 * th + j) * 32 + ml * 16 + mp] = acc[j];
        }
        __syncthreads();
        bf16_t* B2 = (bf16_t*)(F.ws + (S5_BUILD_PRO ? s5b2_off(layer) : OFF_S5B2)) + (size_t)g * 1024 * S5K;
        for (int ch = tid; ch < 128 * 144; ch += NTHREADS) {
            const int nl = ch / 144, kc = ch % 144, t = nl >> 1, ml = nl & 1, m = 2 * part + ml, n = t * 16 + m; float v[8];
            if (kc < 128) { const int s = kc >> 1, m0 = (kc & 1) * 8;
#pragma unroll
                for (int j = 0; j < 8; ++j) v[j] = (s <= t) ? kt[(t - s) * 32 + ml * 16 + m0 + j] : 0.f; }
            else { const int p0 = (kc - 128) * 4;
#pragma unroll
                for (int j = 0; j < 4; ++j) { const int p = p0 + j; const float c_r = cr[m * 64 + p], c_i = ci[m * 64 + p], w_r = pwr[(t + 1) * 64 + p], w_i = pwi[(t + 1) * 64 + p];
                    v[2 * j] = c_r * w_r - c_i * w_i; v[2 * j + 1] = -(c_r * w_i + c_i * w_r); } }
            u32x4 o; o.x = pk2(v[0], v[1]); o.y = pk2(v[2], v[3]); o.z = pk2(v[4], v[5]); o.w = pk2(v[6], v[7]);
            *(u32x4*)(B2 + (size_t)n * S5K + kc * 8) = o;
        }
        bf16_t* E = (bf16_t*)(F.ws + (S5_BUILD_PRO ? s5e_off(layer) : OFF_S5E)) + (size_t)g * 256 * 1024;
        for (int ch = part * 32 * 128 + tid; ch < (part + 1) * 32 * 128; ch += NTHREADS) {
            const int n = ch >> 7, kc = ch & 127, s = kc >> 1, m0 = (kc & 1) * 8; float v[8];
            if (n < 128) { const int p = n >> 1, ri = n & 1; const float w_r = pwr[(63 - s) * 64 + p], w_i = pwi[(63 - s) * 64 + p];
#pragma unroll
                for (int j = 0; j < 8; ++j) { const float b_r = bbr[p * 16 + m0 + j], b_i = bbi[p * 16 + m0 + j]; v[j] = ri == 0 ? (w_r * b_r - w_i * b_i) : (w_r * b_i + w_i * b_r); } }
            else {
#pragma unroll
                for (int j = 0; j < 8; ++j) v[j] = 0.f; }
            u32x4 o; o.x = pk2(v[0], v[1]); o.y = pk2(v[2], v[3]); o.z = pk2(v[4], v[5]); o.w = pk2(v[6], v[7]);
            *(u32x4*)(E + (size_t)n * 1024 + kc * 8) = o;
        }
    }
}
struct ProbS5a {
    static constexpr bool FP8 = false;
    const bf16_t* A; const bf16_t* Bt; int K, lda, ldb, G, c;
    __device__ __forceinline__ bool next(int i, Unit& u) const { const int L = i * G + c; if (L >= 64) return false; u.pm = L; u.pn = L >> 1; return true; }
    __device__ __forceinline__ const char* abase(const Unit& u) const { return (const char*)(A + (size_t)u.pm * 256 * lda); }
    __device__ __forceinline__ const char* bbase(const Unit& u) const { return (const char*)(Bt + (size_t)u.pn * 256 * ldb); }
};
struct EpiS5a {
    static constexpr bool PERM = false, MID = false;
    float* xloc;
    __device__ __forceinline__ void operator()(const f32x4 (&acc)[2][2][4][2], const Unit& u, int wr, int wc, int fr, int fq) const {
        const int row0 = u.pm * 256 + wr * 64 + fr, col0 = wc * 32 + 4 * fq;
#pragma unroll
        for (int ai = 0; ai < 2; ++ai)
#pragma unroll
            for (int m = 0; m < 4; ++m) { float* rp = xloc + (size_t)(row0 + ai * 128 + m * 16) * 128 + col0;
#pragma unroll
                for (int n = 0; n < 2; ++n) *(f32x4*)(rp + n * 16) = acc[ai][0][m][n]; }
    }
};
__device__ __forceinline__ void phase_s5_scan(const Frame& F, const CAS Args& a, int layer) {
    const int gt = F.bx * NTHREADS + F.tid; if (gt >= 4096) return;
    const int p = gt & 63, b = (gt >> 6) & 1, g = gt >> 7, lg = layer * 32 + g;
    const float dt = expf(a.in[I_DT][lg]), lr = a.in[I_LRE][lg * 64 + p], li = a.in[I_LIM][lg * 64 + p];
    const float mag = expf(lr * dt * 64.0f); float sn, cs; sincosf(li * dt * 64.0f, &sn, &cs); const float ar = mag * cs, ai = mag * sn;
    const float* xl = (const float*)(F.ws + MO(B_XLOC)) + (size_t)(g * 512 + b * 256) * 128 + 2 * p;
    unsigned* ux = (unsigned*)((bf16_t*)(F.ws + MO(B_UEXT)) + (size_t)(g * 512 + b * 256) * S5K + 1024 + 2 * p);
    float xr = 0.f, xi = 0.f;
    for (int cb = 0; cb < 256; cb += 32) {
        f32x2 l[32];
#pragma unroll
        for (int j = 0; j < 32; ++j) l[j] = *(const f32x2*)(xl + (size_t)(cb + j) * 128);
#pragma unroll
        for (int j = 0; j < 32; ++j) {
            ux[(size_t)(cb + j) * (S5K / 2)] = pk2(xr, xi);
            const float nr = ar * xr - ai * xi + l[j].x, ni = ar * xi + ai * xr + l[j].y; xr = nr; xi = ni;
        }
    }
}
struct ProbS5b {
    static constexpr bool FP8 = false;
    const bf16_t* A; const bf16_t* Bt; int K, lda, ldb, G, c;
    __device__ __forceinline__ bool next(int i, Unit& u) const { const int L = i * G + c; if (L < 0 || L >= 256) return false; u.pm = L >> 2; u.pn = (L >> 3) * 4 + (L & 3); return true; }
    __device__ __forceinline__ const char* abase(const Unit& u) const { return (const char*)(A + (size_t)u.pm * 256 * lda); }
    __device__ __forceinline__ const char* bbase(const Unit& u) const { return (const char*)(Bt + (size_t)u.pn * 256 * ldb); }
};
__device__ __forceinline__ float gelu_tanh(float x) { return x * frcp(1.0f + __builtin_amdgcn_exp2f(-2.3022082594043835f * (x + 0.044715f * x * x * x))); }
struct EpiS5b {
    static constexpr bool PERM = true, MID = false;
    bf16_t* zg;
    __device__ __forceinline__ void operator()(const f32x4 (&acc)[2][2][4][2], const Unit& u, int wr, int wc, int fr, int fq) const {
        const int row0 = u.pm * 256 + wr * 64 + fr, colt = (u.pn & 3) * 256 + wc * 32 + 8 * fq;
#pragma unroll
        for (int ai = 0; ai < 2; ++ai)
#pragma unroll
            for (int m = 0; m < 4; ++m) {
                const int rg = row0 + ai * 128 + m * 16, g = rg >> 9, bc = rg & 511;
#pragma unroll
                for (int bj = 0; bj < 2; ++bj) {
                    const int n = colt + bj * 128, t = n >> 4, m0 = n & 15; const size_t tok = (size_t)(bc >> 8) * SEQ + (bc & 255) * 64 + t;
                    const f32x4 v0 = acc[ai][bj][m][0], v1 = acc[ai][bj][m][1];
                    u32x4 w; w.x = pk2(gelu_tanh(v0[0]), gelu_tanh(v0[1])); w.y = pk2(gelu_tanh(v0[2]), gelu_tanh(v0[3])); w.z = pk2(gelu_tanh(v1[0]), gelu_tanh(v1[1])); w.w = pk2(gelu_tanh(v1[2]), gelu_tanh(v1[3]));
                    *(u32x4*)(zg + tok * 512 + g * 16 + m0) = w;
                }
            }
    }
};
struct EpiGlu {
    static constexpr bool PERM = true, MID = false;
    const bf16_t* zg; const float* glub; bf16_t* mixed; unsigned long long* ssS;
    __device__ __forceinline__ void operator()(const f32x4 (&acc)[2][2][4][2], const Unit& u, int wr, int wc, int fr, int fq) const {
        const int row0 = u.pm * 256 + wr * 64 + fr, col0 = u.pn * 256 + wc * 32 + 8 * fq;
#pragma unroll
        for (int ai = 0; ai < 2; ++ai)
#pragma unroll
            for (int m = 0; m < 4; ++m) {
                const size_t row = (size_t)(row0 + ai * 128 + m * 16); float sq = 0.f;
#pragma unroll
                for (int bj = 0; bj < 2; ++bj) {
                    const int n = col0 + bj * 128; const u32x4 z = *(const u32x4*)(zg + row * 512 + n);
                    const f32x4 b0 = *(const f32x4*)(glub + n), b1 = *(const f32x4*)(glub + n + 4);
                    const f32x4 v0 = acc[ai][bj][m][0] + b0, v1 = acc[ai][bj][m][1] + b1;
                    const float e0 = bflo(z.x) * sigmoidf_(v0[0]), e1 = bfhi(z.x) * sigmoidf_(v0[1]), e2 = bflo(z.y) * sigmoidf_(v0[2]), e3 = bfhi(z.y) * sigmoidf_(v0[3]);
                    const float e4 = bflo(z.z) * sigmoidf_(v1[0]), e5 = bfhi(z.z) * sigmoidf_(v1[1]), e6 = bflo(z.w) * sigmoidf_(v1[2]), e7 = bfhi(z.w) * sigmoidf_(v1[3]);
                    sq += (e0 * e0 + e1 * e1) + (e2 * e2 + e3 * e3) + (e4 * e4 + e5 * e5) + (e6 * e6 + e7 * e7);
                    u32x4 w; w.x = pk2(e0, e1); w.y = pk2(e2, e3); w.z = pk2(e4, e5); w.w = pk2(e6, e7);
                    *(u32x4*)(mixed + row * D + 1536 + n) = w;
                }
                sq += __shfl_xor(sq, 16); sq += __shfl_xor(sq, 32);
                if (fq == 0) atomicAdd(ssS + row, ss_fix(sq));
            }
    }
};

__device__ __forceinline__ void phase_rw_prep1(const Frame& F, const CAS Args& a, int layer) {
    const bf16_t* zrw = (const bf16_t*)(F.ws + MO(B_ZRW)); bf16_t* al = (bf16_t*)(F.ws + MO(B_ALORA)); const float* mu = a.in[I_MU] + layer * RW_COLS;
    const int lane = F.lane, gw = F.bx * NWAVES + F.wave, NGW = F.G * NWAVES;
    const int sc = lane < 16 ? 512 + 4 * lane : (lane < 32 ? 1600 + 4 * (lane - 16) : 1664 + 4 * (lane - 32));
    const f32x4 m4 = *(const f32x4*)(mu + sc);
    for (int row0 = gw; row0 < T; row0 += 4 * NGW) {
        u32x2 zc[4], zp[4];
#pragma unroll
        for (int u = 0; u < 4; ++u) { const int row = min(row0 + u * NGW, T - 1);
            zc[u] = *(const u32x2*)(zrw + (size_t)row * RW_COLS + sc);
            zp[u] = (u32x2){0u, 0u}; if ((row & (SEQ - 1)) != 0) zp[u] = *(const u32x2*)(zrw + (size_t)(row - 1) * RW_COLS + sc); }
#pragma unroll
        for (int u = 0; u < 4; ++u) { const int row = row0 + u * NGW; if (row >= T) break;
            float z[4] = {bflo(zc[u].x), bfhi(zc[u].x), bflo(zc[u].y), bfhi(zc[u].y)}; const float p[4] = {bflo(zp[u].x), bfhi(zp[u].x), bflo(zp[u].y), bfhi(zp[u].y)};
#pragma unroll
            for (int j = 0; j < 4; ++j) { float v = z[j] + m4[j] * (p[j] - z[j]); v = lane < 16 ? tanhf(v) : (lane < 32 ? v : sigmoidf_(v)); z[j] = v; }
            u32x2 o; o.x = pk2(z[0], z[1]); o.y = pk2(z[2], z[3]);
            *(u32x2*)(al + (size_t)row * 256 + 4 * lane) = o; }
    }
}
struct ProbLora {
    static constexpr bool FP8 = false;
    const bf16_t* A; const bf16_t* Bt; int K, lda, ldb, nM, nN, G, c;
    __device__ __forceinline__ bool next(int i, Unit& u) const { return pg8::static_unit(i * G + c, nM, nN, u); }
    __device__ __forceinline__ const char* abase(const Unit& u) const { return (const char*)(A + (size_t)u.pm * 256 * lda + (u.pn >= 4 ? 128 : 0)); }
    __device__ __forceinline__ const char* bbase(const Unit& u) const { return (const char*)(Bt + (size_t)u.pn * 256 * ldb + (u.pn >= 4 ? 128 : 0)); }
};
struct EpiLora {
    static constexpr bool PERM = true, MID = false;
    bf16_t* dec; bf16_t* iclr; bf16_t* gate;
    __device__ __forceinline__ void operator()(const f32x4 (&acc)[2][2][4][2], const Unit& u, int wr, int wc, int fr, int fq) const {
        const int row0 = u.pm * 256 + wr * 64 + fr, blk = u.pn >> 1, nn0 = (u.pn & 1) * 256 + wc * 32 + 8 * fq;
        if (blk == 0) store(acc, dec, row0, nn0); else if (blk == 1) store(acc, iclr, row0, nn0); else store(acc, gate, row0, nn0);
    }
    static __device__ __forceinline__ void store(const f32x4 (&acc)[2][2][4][2], bf16_t* dst, int row0, int nn0) {
#pragma unroll
        for (int ai = 0; ai < 2; ++ai)
#pragma unroll
            for (int m = 0; m < 4; ++m) {
                const size_t row = (size_t)(row0 + ai * 128 + m * 16);
#pragma unroll
                for (int bj = 0; bj < 2; ++bj) {
                    const int nn = nn0 + bj * 128; const f32x4 v0 = acc[ai][bj][m][0], v1 = acc[ai][bj][m][1];
                    u32x4 w; w.x = cvt_pk_bf16(v0[0], v0[1]); w.y = cvt_pk_bf16(v0[2], v0[3]); w.z = cvt_pk_bf16(v1[0], v1[1]); w.w = cvt_pk_bf16(v1[2], v1[3]);
                    *(u32x4*)(dst + row * 512 + nn) = w;
                }
            }
    }
};
constexpr int P1_RAW = 1280, P1_RAWRING = 8 * P1_RAW, P1_REC = 1536, P1_WAVE = P1_RAWRING + 2 * P1_REC, P1_LA = 5;
static_assert(NWAVES * P1_WAVE <= RING_BYTES, "pass-1 LDS");
__device__ __forceinline__ void glds4_s(const char* sbase, unsigned voff, unsigned ldsdst) {
    asm volatile("s_mov_b32 m0, %2\n\ts_nop 0\n\tglobal_load_lds_dword %0, %1" : : "v"(voff), "s"(sbase), "s"(ldsdst) : "memory", "m0");
}
__device__ __forceinline__ void phase_rw_pass1(const Frame& F, const CAS Args& a, int layer) {
    const bf16_t* zrw = (const bf16_t*)(F.ws + MO(B_ZRW)); const bf16_t* dec = (const bf16_t*)(F.ws + MO(B_DEC)); const bf16_t* icl = (const bf16_t*)(F.ws + MO(B_ICLR));
    float* yloc = (float*)(F.ws + MO(B_YLOC)); float* pvec = (float*)(F.ws + MO(B_PVEC)); float* bonus = (float*)(F.ws + MO(B_BONUS));
    float* pmat = (float*)(F.ws + MO(B_PMAT)); float* qmat = (float*)(F.ws + MO(B_QMAT));
    const int lane = F.lane, gw = F.bx * NWAVES + F.wave, NGW = F.G * NWAVES;
    const LAS unsigned char* wl = F.lds + F.wave * P1_WAVE; const unsigned rawbase = (unsigned)(unsigned long)wl, lane4 = (unsigned)lane * 4u;
    LAS float* recs = (LAS float*)(wl + P1_RAWRING);
#define P1_ISSUE(u) do { const size_t _row = row0 + (u); const unsigned _d = rawbase + (unsigned)(((u) & 7) * P1_RAW); \
        const char* _z = uniform_ptr((const char*)(zrw + _row * RW_COLS + h * 64)); \
        glds4_s(_z, lane4, _d); glds4_s(_z + 576 * 2, lane4, _d + 256u); glds4_s(_z + 1088 * 2, lane4, _d + 512u); \
        glds4_s(uniform_ptr((const char*)(dec + _row * 512 + h * 64)), lane4, _d + 768u); glds4_s(uniform_ptr((const char*)(icl + _row * 512 + h * 64)), lane4, _d + 1024u); } while (0)
    for (int item = gw; item < 2048; item += NGW) {
        const int bh = item >> 7, ch = item & 127, b = bh >> 3, h = bh & 7, c = h * 64 + lane;
        const size_t row0 = (size_t)b * SEQ + ch * RWC; const bool first = ch == 0;
        asm volatile("s_waitcnt vmcnt(0)" ::: "memory");
        if (!first) P1_ISSUE(-1);
#pragma unroll
        for (int u = 0; u <= P1_LA; ++u) P1_ISSUE(u);
        const float* mu = a.in[I_MU] + layer * RW_COLS;
        const float mur = mu[c], muk = mu[576 + c], muv = mu[1088 + c];
        const float cst0 = a.in[I_W0][layer * 512 + c], cst1 = a.in[I_A0][layer * 512 + c], cst2 = a.in[I_KK][layer * 512 + c], cst3 = a.in[I_KA][layer * 512 + c], cst4 = a.in[I_RK][layer * 512 + c];
#define P1_CST(i) cst##i
        f32x2 sq[32], sp[32];
        int li = lane; asm volatile("" : "+v"(li));
#pragma unroll
        for (int j = 0; j < 32; ++j) { sq[j] = (f32x2){0.f, 0.f}; sp[j] = (f32x2){li == 2 * j ? 1.f : 0.f, li == 2 * j + 1 ? 1.f : 0.f}; }
        float pzr = 0.f, pzk = 0.f, pzv = 0.f;
#define P1_BUILD(u, aout) do { const LAS unsigned char* _rs = wl + ((u) & 7) * P1_RAW; \
        const float _zr = bf2f(*(const LAS bf16_t*)(_rs + 2 * lane)), _zk = bf2f(*(const LAS bf16_t*)(_rs + 256 + 2 * lane)), _zv = bf2f(*(const LAS bf16_t*)(_rs + 512 + 2 * lane)); \
        const float _w = __expf(-0.6065306597126334f * sigmoidf_(P1_CST(0) + bf2f(*(const LAS bf16_t*)(_rs + 768 + 2 * lane)))), _ic = sigmoidf_(P1_CST(1) + bf2f(*(const LAS bf16_t*)(_rs + 1024 + 2 * lane))); \
        const float _r = _zr + mur * (pzr - _zr), _k = _zk + muk * (pzk - _zk), _v = _zv + muv * (pzv - _zv); pzr = _zr; pzk = _zk; pzv = _zv; \
        float _kk = _k * P1_CST(2); const float _n2 = wave_sum(_kk * _kk); _kk *= rsqrtf(fmaxf(_n2, 1e-12f)); \
        const float _k2 = _k * (1.0f + (_ic - 1.0f) * P1_CST(3)); const float _bs = wave_sum(_r * _k2 * P1_CST(4)); \
        LAS float* _rc = recs + ((u) & 1) * 384 + (lane >> 4) * 80 + (lane & 15); \
        _rc[0] = _w; _rc[16] = _kk * _ic; _rc[32] = _k2; _rc[48] = _r; recs[((u) & 1) * 384 + 320 + lane] = _v; \
        recs[(((u) + 1) & 1) * 384 + (lane >> 4) * 80 + 64 + (lane & 15)] = -_kk; \
        if (lane == 0) bonus[(row0 + (u)) * 8 + h] = _bs; \
        aout = -_kk; } while (0)
        float a0;
        if (!first) { asm volatile("s_waitcnt vmcnt(30)" ::: "memory");
            const LAS unsigned char* rs = wl + 7 * P1_RAW; pzr = bf2f(*(const LAS bf16_t*)(rs + 2 * lane)); pzk = bf2f(*(const LAS bf16_t*)(rs + 256 + 2 * lane)); pzv = bf2f(*(const LAS bf16_t*)(rs + 512 + 2 * lane)); }
        asm volatile("s_waitcnt vmcnt(25)" ::: "memory");
        P1_BUILD(0, a0);
        float saq = 0.f, sap = a0;
        for (int t = 0; t < RWC; ++t) {
            const size_t row = row0 + t;
            if (t + 1 + P1_LA < RWC) { P1_ISSUE(t + 1 + P1_LA); if (t >= P1_LA) asm volatile("s_waitcnt vmcnt(40)" ::: "memory"); else asm volatile("s_waitcnt vmcnt(25)" ::: "memory"); }
            else asm volatile("s_waitcnt vmcnt(15)" ::: "memory");
            if (t + 1 < RWC) { float an; P1_BUILD(t + 1, an); (void)an; }
            asm volatile("s_waitcnt lgkmcnt(0)" ::: "memory");
            const LAS f32x4* rec = (const LAS f32x4*)(recs + (t & 1) * 384);
            const float vi = ((const LAS float*)rec)[320 + lane];
            const f32x2 saq2 = (f32x2){saq, saq}, sap2 = (f32x2){sap, sap}, vi2 = (f32x2){vi, vi};
            f32x2 yq0 = (f32x2){0.f, 0.f}, yq1 = yq0, yp0 = yq0, yp1 = yq0, dq0 = yq0, dq1 = yq0, dp0 = yq0, dp1 = yq0;
            f32x4 cw, cb, ck, cr, cn, nw, nb, nk, nr, nn;
            cw = rec[0]; cb = rec[4]; ck = rec[8]; cr = rec[12]; cn = rec[16];
#pragma unroll
            for (int bt = 0; bt < 16; ++bt) {
                if (bt < 15) { const int i = ((bt + 1) >> 2) * 20 + ((bt + 1) & 3); nw = rec[i]; nb = rec[i + 4]; nk = rec[i + 8]; nr = rec[i + 12]; nn = rec[i + 16]; }
                __builtin_amdgcn_sched_barrier(0);
                {   const int j = bt * 2;
                    const f32x2 w0 = (f32x2){cw.x, cw.y}, w1 = (f32x2){cw.z, cw.w}, b0 = (f32x2){cb.x, cb.y}, b1 = (f32x2){cb.z, cb.w}, k0 = (f32x2){ck.x, ck.y}, k1 = (f32x2){ck.z, ck.w};
                    const f32x2 r0 = (f32x2){cr.x, cr.y}, r1 = (f32x2){cr.z, cr.w}, n0 = (f32x2){cn.x, cn.y}, n1 = (f32x2){cn.z, cn.w};
                    sq[j] = sq[j] * w0 + saq2 * b0 + vi2 * k0; sp[j] = sp[j] * w0 + sap2 * b0;
                    sq[j + 1] = sq[j + 1] * w1 + saq2 * b1 + vi2 * k1; sp[j + 1] = sp[j + 1] * w1 + sap2 * b1;
                    yq0 += sq[j] * r0; yp0 += sp[j] * r0; yq1 += sq[j + 1] * r1; yp1 += sp[j + 1] * r1;
                    dq0 += sq[j] * n0; dp0 += sp[j] * n0; dq1 += sq[j + 1] * n1; dp1 += sp[j + 1] * n1; }
                __builtin_amdgcn_sched_barrier(0);
                cw = nw; cb = nb; ck = nk; cr = nr; cn = nn;
            }
            ((bf16_t*)yloc)[row * 512 + h * 64 + lane] = (bf16_t)f2bf((yq0.x + yq0.y) + (yq1.x + yq1.y));
            ((bf16_t*)pvec)[row * 512 + h * 64 + lane] = (bf16_t)f2bf((yp0.x + yp0.y) + (yp1.x + yp1.y));
            saq = (dq0.x + dq0.y) + (dq1.x + dq1.y); sap = (dp0.x + dp0.y) + (dp1.x + dp1.y);
        }
        int l2 = lane; asm volatile("" : "+v"(l2));
        f32x4* po = (f32x4*)(pmat + (size_t)item * 4096 + l2 * 64); f32x4* qo = (f32x4*)(qmat + (size_t)item * 4096 + l2 * 64);
#pragma unroll
        for (int j = 0; j < 16; ++j) { po[j] = (f32x4){sp[2 * j].x, sp[2 * j].y, sp[2 * j + 1].x, sp[2 * j + 1].y}; qo[j] = (f32x4){sq[2 * j].x, sq[2 * j].y, sq[2 * j + 1].x, sq[2 * j + 1].y}; }
    }
#undef P1_ISSUE
#undef P1_BUILD
#undef P1_CST
}
__device__ __forceinline__ void phase_rw_scan(const Frame& F, int layer) {
    const float* pmat = (const float*)(F.ws + MO(B_PMAT)); const float* qmat = (const float*)(F.ws + MO(B_QMAT)); float* sst = (float*)(F.ws + MO(B_SST));
    LAS float* Sb = (LAS float*)F.lds;
    const int lane = F.lane, jt = F.wave, n = lane & 15, kq = lane >> 4;
    for (int w = F.bx; w < 64; w += F.G) {
        const int bh = w >> 2, qr = w & 3; const size_t it0 = (size_t)bh * RWNC;
        __syncthreads();
        if (jt < 4) {
            f32x4 s = (f32x4){0.f, 0.f, 0.f, 0.f};
            float pA[16], pB[16], pC[16]; f32x4 qA, qB, qC;
#define SC_LOAD(pb, qc, c) do { const int _c = (c) < RWNC ? (c) : RWNC - 1; const float* pp = pmat + (it0 + _c) * 4096 + 16 * jt + n; _Pragma("unroll") for (int kk = 0; kk < 16; ++kk) pb[kk] = pp[(4 * kk + kq) * 64]; \
                        const float* qq = qmat + (it0 + _c) * 4096 + (size_t)(qr * 16 + 4 * kq) * 64 + 16 * jt + n; qc = (f32x4){qq[0], qq[64], qq[128], qq[192]}; } while (0)
#define SC_STEP(pb, qc, c) do { \
                float* so = sst + (it0 + (c)) * 4096 + (size_t)(qr * 16 + 4 * kq) * 64 + 16 * jt + n; \
                so[0] = s[0]; so[64] = s[1]; so[128] = s[2]; so[192] = s[3]; \
                _Pragma("unroll") for (int r = 0; r < 4; ++r) Sb[(4 * kq + r) * 68 + 16 * jt + n] = s[r]; \
                asm volatile("s_waitcnt lgkmcnt(0)" ::: "memory"); __builtin_amdgcn_s_barrier(); asm volatile("" ::: "memory"); \
                f32x4 a0 = qc, a1 = (f32x4){0.f, 0.f, 0.f, 0.f}, a2 = a1, a3 = a1; \
                _Pragma("unroll") for (int kk = 0; kk < 16; kk += 4) { \
                    a0 = __builtin_amdgcn_mfma_f32_16x16x4f32(Sb[n * 68 + 4 * kk + kq], pb[kk], a0, 0, 0, 0); \
                    a1 = __builtin_amdgcn_mfma_f32_16x16x4f32(Sb[n * 68 + 4 * (kk + 1) + kq], pb[kk + 1], a1, 0, 0, 0); \
                    a2 = __builtin_amdgcn_mfma_f32_16x16x4f32(Sb[n * 68 + 4 * (kk + 2) + kq], pb[kk + 2], a2, 0, 0, 0); \
                    a3 = __builtin_amdgcn_mfma_f32_16x16x4f32(Sb[n * 68 + 4 * (kk + 3) + kq], pb[kk + 3], a3, 0, 0, 0); } \
                s = (a0 + a1) + (a2 + a3); \
                SC_LOAD(pb, qc, (c) + 3); \
                asm volatile("s_waitcnt lgkmcnt(0)" ::: "memory"); __builtin_amdgcn_s_barrier(); asm volatile("" ::: "memory"); } while (0)
            SC_LOAD(pA, qA, 0); SC_LOAD(pB, qB, 1); SC_LOAD(pC, qC, 2);
            static_assert(RWNC % 3 == 2, "scan loop tail");
            for (int c = 0; c + 2 < RWNC; c += 3) { SC_STEP(pA, qA, c); SC_STEP(pB, qB, c + 1); SC_STEP(pC, qC, c + 2); }
            SC_STEP(pA, qA, RWNC - 2); SC_STEP(pB, qB, RWNC - 1);
#undef SC_LOAD
#undef SC_STEP
        } else {
            for (int c = 0; c < RWNC; ++c) { __builtin_amdgcn_s_barrier(); __builtin_amdgcn_s_barrier(); }
        }
    }
}
__device__ __forceinline__ bf16x8 cvt8(f32x4 lo, f32x4 hi) { u32x4 o; o.x = cvt_pk_bf16(lo[0], lo[1]); o.y = cvt_pk_bf16(lo[2], lo[3]); o.z = cvt_pk_bf16(hi[0], hi[1]); o.w = cvt_pk_bf16(hi[2], hi[3]); return __builtin_bit_cast(bf16x8, o); }
__device__ __forceinline__ void phase_rw_fix(const Frame& F, const CAS Args& a, int layer) {
    const bf16_t* zrw = (const bf16_t*)(F.ws + MO(B_ZRW)); const float* muv = a.in[I_MU] + layer * RW_COLS + 1088; const float* yloc = (const float*)(F.ws + MO(B_YLOC)); const float* pvec = (const float*)(F.ws + MO(B_PVEC));
    const float* sst = (const float*)(F.ws + MO(B_SST)); const float* bonus = (const float*)(F.ws + MO(B_BONUS)); const bf16_t* gate = (const bf16_t*)(F.ws + MO(B_GATE));
    bf16_t* mixed = (bf16_t*)(F.ws + MO(B_MIXED));
    const float* lnw = a.in[I_LNW] + layer * 512; const float* lnb = a.in[I_LNB] + layer * 512;
    const int lane = F.lane, gw = F.bx * NWAVES + F.wave, NGW = F.G * NWAVES, tl = lane & 15, q4 = lane >> 4;
    for (int item = gw; item < 2048; item += NGW) {
        const int bh = item >> 7, ch = item & 127, b = bh >> 3, h = bh & 7;
        bf16x8 sa[4][2];
#pragma unroll
        for (int ib = 0; ib < 4; ++ib)
#pragma unroll
            for (int ks = 0; ks < 2; ++ks) { const float* p = sst + (size_t)item * 4096 + (16 * ib + tl) * 64 + 32 * ks + 8 * q4; sa[ib][ks] = cvt8(*(const f32x4*)p, *(const f32x4*)(p + 4)); }
        f32x4 lw[4], lb[4];
#pragma unroll
        for (int ib = 0; ib < 4; ++ib) { lw[ib] = *(const f32x4*)(lnw + h * 64 + 16 * ib + 4 * q4); lb[ib] = *(const f32x4*)(lnb + h * 64 + 16 * ib + 4 * q4); }
        for (int tb = 0; tb < RWC / 16; ++tb) {
            const size_t row = (size_t)b * SEQ + ch * RWC + tb * 16 + tl;
            bf16x8 pb[2];
#pragma unroll
            for (int ks = 0; ks < 2; ++ks) pb[ks] = *(const bf16x8*)((const bf16_t*)pvec + row * 512 + h * 64 + 32 * ks + 8 * q4);
            f32x4 y[4]; float s = 0.f;
#pragma unroll
            for (int ib = 0; ib < 4; ++ib) {
                const u32x2 yb = *(const u32x2*)((const bf16_t*)yloc + row * 512 + h * 64 + 16 * ib + 4 * q4); f32x4 d = (f32x4){bflo(yb.x), bfhi(yb.x), bflo(yb.y), bfhi(yb.y)};
                d = __builtin_amdgcn_mfma_f32_16x16x32_bf16(sa[ib][0], pb[0], d, 0, 0, 0);
                d = __builtin_amdgcn_mfma_f32_16x16x32_bf16(sa[ib][1], pb[1], d, 0, 0, 0);
                y[ib] = d; s += (d[0] + d[1]) + (d[2] + d[3]);
            }
            s += __shfl_xor(s, 16); s += __shfl_xor(s, 32);
            const float mean = s * (1.0f / 64.0f); float q = 0.f;
#pragma unroll
            for (int ib = 0; ib < 4; ++ib) { y[ib] = y[ib] - mean; q += (y[ib][0] * y[ib][0] + y[ib][1] * y[ib][1]) + (y[ib][2] * y[ib][2] + y[ib][3] * y[ib][3]); }
            q += __shfl_xor(q, 16); q += __shfl_xor(q, 32);
            const float rstd = rsqrtf(q * (1.0f / 64.0f) + 64e-5f), bon = bonus[row * 8 + h];
#pragma unroll
            for (int ib = 0; ib < 4; ++ib) {
                const int c = h * 64 + 16 * ib + 4 * q4;
                const u32x2 zc = *(const u32x2*)(zrw + row * RW_COLS + 1088 + c); u32x2 zp = (u32x2){0u, 0u}; if ((row & (SEQ - 1)) != 0) zp = *(const u32x2*)(zrw + (row - 1) * RW_COLS + 1088 + c);
                const f32x4 mv = *(const f32x4*)(muv + c), zcf = (f32x4){bflo(zc.x), bfhi(zc.x), bflo(zc.y), bfhi(zc.y)}, zpf = (f32x4){bflo(zp.x), bfhi(zp.x), bflo(zp.y), bfhi(zp.y)};
                const f32x4 vv = zcf + mv * (zpf - zcf); const u32x2 gg = *(const u32x2*)(gate + row * 512 + c);
                const f32x4 o = (y[ib] * rstd * lw[ib] + lb[ib] + vv * bon) * (f32x4){bflo(gg.x), bfhi(gg.x), bflo(gg.y), bfhi(gg.y)};
                u32x2 w; w.x = cvt_pk_bf16(o[0], o[1]); w.y = cvt_pk_bf16(o[2], o[3]);
                *(u32x2*)(mixed + row * D + 1024 + c) = w;
            }
        }
    }
}

template <bool F8, bool O8 = F8> struct EpiSwiglu {
    static constexpr bool PERM = true, MID = false;
    const unsigned long long* ssq; const float* rsslot; void* act; int ldact;
    __device__ __forceinline__ void operator()(const f32x4 (&acc)[2][2][4][2], const Unit& u, int wr, int wc, int fr, int fq) const {
        const int row0 = u.pm * 256 + wr * 64 + fr, col0 = u.pn * 128 + wc * 32 + 8 * fq;
        float rsv[2][4];
#pragma unroll
        for (int ai = 0; ai < 2; ++ai)
#pragma unroll
            for (int m = 0; m < 4; ++m) { const int row = row0 + ai * 128 + m * 16; rsv[ai][m] = (rsslot ? rsslot[row] : ss_rs(ssq[row])) * (F8 ? 1.0f / (SC_H * SC_W13) : 1.0f); }
#pragma unroll
        for (int ai = 0; ai < 2; ++ai)
#pragma unroll
            for (int m = 0; m < 4; ++m) {
                const int row = row0 + ai * 128 + m * 16; const float rs = rsv[ai][m];
                float o[8];
#pragma unroll
                for (int n = 0; n < 2; ++n)
#pragma unroll
                    for (int j = 0; j < 4; ++j) { const float g = acc[ai][0][m][n][j] * rs, up = acc[ai][1][m][n][j] * rs; o[n * 4 + j] = g * sigmoidf_(g) * up; }
                if constexpr (O8) { u32x2 w; w.x = pk8(clamp8(o[0] * SC_ACT), clamp8(o[1] * SC_ACT), clamp8(o[2] * SC_ACT), clamp8(o[3] * SC_ACT)); w.y = pk8(clamp8(o[4] * SC_ACT), clamp8(o[5] * SC_ACT), clamp8(o[6] * SC_ACT), clamp8(o[7] * SC_ACT));
                    *(u32x2*)((unsigned char*)act + (size_t)row * ldact + col0) = w; }
                else { u32x4 w; w.x = cvt_pk_bf16(o[0], o[1]); w.y = cvt_pk_bf16(o[2], o[3]); w.z = cvt_pk_bf16(o[4], o[5]); w.w = cvt_pk_bf16(o[6], o[7]);
                    *(u32x4*)((bf16_t*)act + (size_t)row * ldact + col0) = w; }
            }
    }
};
struct EpiBf16Out {
    static constexpr bool PERM = true, MID = false;
    bf16_t* o; int ld; float asc;
    __device__ __forceinline__ void operator()(const f32x4 (&acc)[2][2][4][2], const Unit& u, int wr, int wc, int fr, int fq) const {
        const int row0 = u.pm * 256 + wr * 64 + fr, col0 = u.pn * 256 + wc * 32 + 8 * fq;
#pragma unroll
        for (int ai = 0; ai < 2; ++ai)
#pragma unroll
            for (int m = 0; m < 4; ++m)
#pragma unroll
                for (int bj = 0; bj < 2; ++bj) { const f32x4 v0 = acc[ai][bj][m][0] * asc, v1 = acc[ai][bj][m][1] * asc;
                    u32x4 w; w.x = cvt_pk_bf16(v0[0], v0[1]); w.y = cvt_pk_bf16(v0[2], v0[3]); w.z = cvt_pk_bf16(v1[0], v1[1]); w.w = cvt_pk_bf16(v1[2], v1[3]);
                    *(u32x4*)(o + (size_t)(row0 + ai * 128 + m * 16) * ld + col0 + bj * 128) = w; }
    }
};
struct EpiProbe {
    static constexpr bool PERM = true, MID = false;
    float* dummy;
    __device__ __forceinline__ void operator()(const f32x4 (&acc)[2][2][4][2], const Unit& u, int wr, int wc, int fr, int fq) const {
        float s = 0.f;
#pragma unroll
        for (int ai = 0; ai < 2; ++ai)
#pragma unroll
            for (int bj = 0; bj < 2; ++bj)
#pragma unroll
                for (int m = 0; m < 4; ++m)
#pragma unroll
                    for (int n = 0; n < 2; ++n) s += (acc[ai][bj][m][n][0] + acc[ai][bj][m][n][1]) + (acc[ai][bj][m][n][2] + acc[ai][bj][m][n][3]);
        dummy[(wr * 4 + wc) * 64 + fq * 16 + fr] = s;
    }
};
template <int K_, int NN_> struct ProbMoe {
    static constexpr bool FP8 = true;
    static constexpr int K = K_, lda = K_, ldb = K_, nN = NN_; static constexpr size_t estride = (size_t)NN_ * 256 * K_;
    const unsigned char* A; const unsigned char* Bt; int tp[9]; int G, c, i0, ilim;
    __device__ __forceinline__ bool next(int i, Unit& u) const { const int ii = i + i0; if (ii >= ilim) return false; return pg8::static_unit(ii * G + c, tp[8], nN, u); }
    __device__ __forceinline__ const char* abase(const Unit& u) const { return (const char*)(A + (size_t)u.pm * 256 * lda); }
    __device__ __forceinline__ const char* bbase(const Unit& u) const { int e = 0;
#pragma unroll
        for (int j = 1; j < 8; ++j) e += (u.pm >= tp[j]) ? 1 : 0;
        return (const char*)(Bt + (size_t)e * estride + (size_t)u.pn * 256 * ldb); }
};
__device__ __forceinline__ int moe_pos(int c, int G) { return (G & 7) ? c : (c & 7) * (G >> 3) + (c >> 3); }
__device__ __forceinline__ void moe_ord_unit(int w, int nM, int nN, Unit& u) {
    const int nig = pg8::WGM * nN, gid = w / nig, fm = gid * pg8::WGM, gsz = (nM - fm) < pg8::WGM ? (nM - fm) : pg8::WGM, r = w - gid * nig;
    u.pm = fm + r % gsz; u.pn = r / gsz;
}
template <int K_, int NN_> struct ProbMoeOrd {
    static constexpr bool FP8 = true;
    static constexpr int K = K_, lda = K_, ldb = K_, nN = NN_; static constexpr size_t estride = (size_t)NN_ * 256 * K_;
    const unsigned char* A; const unsigned char* Bt; int tp[9]; int G, pos, base, lim;
    __device__ __forceinline__ bool next(int i, Unit& u) const { const int w = base + i * G + pos; if (w >= lim) return false; moe_ord_unit(w, tp[8], nN, u); return true; }
    __device__ __forceinline__ const char* abase(const Unit& u) const { return (const char*)(A + (size_t)u.pm * 256 * lda); }
    __device__ __forceinline__ const char* bbase(const Unit& u) const { int e = 0;
#pragma unroll
        for (int j = 1; j < 8; ++j) e += (u.pm >= tp[j]) ? 1 : 0;
        return (const char*)(Bt + (size_t)e * estride + (size_t)u.pn * 256 * ldb); }
};
__device__ __forceinline__ void phase_router(const Frame& F, const CAS Args& a) {
    LAS float* rt = (LAS float*)F.lds;
    LAS int* cnt = (LAS int*)(F.lds + 65536);
    const float* rw = a.in[I_ROUTER]; const float* g2 = a.in[I_N2G] + D; const unsigned long long* ssq = (const unsigned long long*)(F.ws + OFF_SS) + 3 * (size_t)T; const bf16_t* h = (const bf16_t*)(F.ws + OFF_HB);
    int* toke = (int*)(F.ws + OFF_TOKE); float* tokg = (float*)(F.ws + OFF_TOKG); int* wgcnt = (int*)(F.ws + OFF_WGCNT);
    for (int i = F.tid; i < 2048 * 8; i += NTHREADS) rt[(i & 7) * 2048 + (i >> 3)] = rw[i];
    const int lane = F.lane;
    for (int tg = F.bx; tg < 256; tg += F.G) {
        if (F.tid < 8) cnt[F.tid] = 0;
        __syncthreads();
        for (int k = 0; k < 16; ++k) {
            const int tok = tg * 128 + F.wave * 16 + k;
            const float rs = ss_rs(ssq[tok]);
            float lg[8];
#pragma unroll
            for (int e = 0; e < 8; ++e) lg[e] = 0.f;
#pragma unroll
            for (int j = 0; j < 4; ++j) {
                const int c = lane * 8 + 512 * j; const u32x4 hb = *(const u32x4*)(h + (size_t)tok * D + c); const f32x4 gv0 = *(const f32x4*)(g2 + c), gv1 = *(const f32x4*)(g2 + c + 4);
                const f32x4 hn0 = (f32x4){bflo(hb.x), bfhi(hb.x), bflo(hb.y), bfhi(hb.y)} * rs * gv0, hn1 = (f32x4){bflo(hb.z), bfhi(hb.z), bflo(hb.w), bfhi(hb.w)} * rs * gv1;
#pragma unroll
                for (int e = 0; e < 8; ++e) { const f32x4 r0 = *(const LAS f32x4*)(rt + e * 2048 + c), r1 = *(const LAS f32x4*)(rt + e * 2048 + c + 4);
                    lg[e] += ((hn0.x * r0.x + hn0.y * r0.y) + (hn0.z * r0.z + hn0.w * r0.w)) + ((hn1.x * r1.x + hn1.y * r1.y) + (hn1.z * r1.z + hn1.w * r1.w)); }
            }
#pragma unroll
            for (int e = 0; e < 8; ++e) lg[e] = wave_sum(lg[e]);
            int i0 = 0; float v0 = lg[0];
#pragma unroll
            for (int e = 1; e < 8; ++e) if (lg[e] > v0) { v0 = lg[e]; i0 = e; }
            int i1 = -1; float v1 = -INFINITY;
#pragma unroll
            for (int e = 0; e < 8; ++e) if (e != i0 && lg[e] > v1) { v1 = lg[e]; i1 = e; }
            if (lane == 0) { const float g0 = 1.0f / (1.0f + expf(v1 - v0)); toke[tok] = i0; toke[T + tok] = i1; tokg[tok] = g0; tokg[T + tok] = 1.0f - g0; __hip_atomic_fetch_add((int*)(cnt + i0), 1, __ATOMIC_RELAXED, __HIP_MEMORY_SCOPE_WORKGROUP); __hip_atomic_fetch_add((int*)(cnt + i1), 1, __ATOMIC_RELAXED, __HIP_MEMORY_SCOPE_WORKGROUP); }
        }
        __syncthreads();
        if (F.tid < 8) wgcnt[tg * 8 + F.tid] = cnt[F.tid];
        __syncthreads();
    }
}
__device__ __forceinline__ void phase_assign(const Frame& F) {
    LAS int* wc = (LAS int*)F.lds;
    LAS int* base = wc + 2048;
    LAS int* seg = base + 8;
    LAS int* le = seg + 16;
    LAS int* ls = le + 256;
    const int* wgcnt = (const int*)(F.ws + OFF_WGCNT); const int* toke = (const int*)(F.ws + OFF_TOKE);
    int* slotof = (int*)(F.ws + OFF_SLOT); int* tokof = (int*)(F.ws + OFF_TOKOF); int* tiles = (int*)(F.ws + OFF_TILES);
    float* rsslot = (float*)(F.ws + OFF_RSSLOT); const unsigned long long* ssq3 = (const unsigned long long*)(F.ws + OFF_SS) + 3 * (size_t)T;
    const unsigned char* xb = F.ws + OFF_XB; unsigned char* asort = F.ws + OFF_ASORT;
    for (int tg = F.bx; tg < 256; tg += F.G) {
        __syncthreads();
        for (int i = F.tid; i < 2048; i += NTHREADS) wc[i] = wgcnt[i];
        if (F.tid < 256) le[F.tid] = toke[(F.tid & 1) * T + tg * 128 + (F.tid >> 1)];
        __syncthreads();
        if (F.tid < 8) { const int e = F.tid; int tot = 0, bef = 0; for (int w = 0; w < 256; ++w) { const int v = wc[w * 8 + e]; tot += v; bef += (w < tg) ? v : 0; }
            seg[8 + e] = tot; base[e] = bef; }
        __syncthreads();
        if (F.tid == 0) {
            int pre = 0;
            for (int e = 0; e < 8; ++e) { const int tot = seg[8 + e]; seg[e] = pre * 256; base[e] = pre * 256 + base[e]; if (tg == 0) tiles[e] = pre; pre += (tot + 255) >> 8; }
            if (tg == 0) tiles[8] = pre;
        }
        __syncthreads();
        if (F.tid < 8) { const int e = F.tid; int bs = base[e]; for (int i = 0; i < 256; ++i) if (le[i] == e) { ls[i] = bs; ++bs; } }
        __syncthreads();
        if (F.tid < 256) { const int tok = tg * 128 + (F.tid >> 1), s = F.tid & 1; slotof[s * T + tok] = ls[F.tid]; tokof[ls[F.tid]] = tok; rsslot[ls[F.tid]] = ss_rs(ssq3[tok]); }
        for (int i0 = F.wave * 32; i0 < F.wave * 32 + 32; i0 += 8) {
            u32x4 r[8][2];
#pragma unroll
            for (int u = 0; u < 8; ++u) { const int tok = tg * 128 + ((i0 + u) >> 1); const u32x4* srcp = (const u32x4*)(xb + (size_t)tok * D) + F.lane; r[u][0] = srcp[0]; r[u][1] = srcp[64]; }
#pragma unroll
            for (int u = 0; u < 8; ++u) { u32x4* dst = (u32x4*)(asort + (size_t)ls[i0 + u] * D) + F.lane; dst[0] = r[u][0]; dst[64] = r[u][1]; }
        }
        if (tg < 8) {
            const int p0 = seg[tg] + seg[8 + tg], p1 = seg[tg] + (((seg[8 + tg] + 255) >> 8) << 8);
            for (int s = p0 + F.wave; s < p1; s += NWAVES) { if (F.lane == 0) { tokof[s] = -1; rsslot[s] = 0.f; } u32x4* dst = (u32x4*)(asort + (size_t)s * D) + F.lane;
#pragma unroll
                for (int j = 0; j < 2; ++j) dst[64 * j] = (u32x4){0u, 0u, 0u, 0u}; }
        }
    }
}
__device__ __forceinline__ void phase_combine(const Frame& F, int sel, int fr, int extra) {
    const int* slotof = (const int*)(F.ws + OFF_SLOT); const float* tokg = (const float*)(F.ws + OFF_TOKG); const bf16_t* y = (const bf16_t*)(F.ws + OFF_ASORT); const bf16_t* hb16 = (const bf16_t*)(F.ws + OFF_HB); float* out = F.out;
    LAS int* late = (LAS int*)F.lds;
    if (sel) { const int R = ((const int*)(F.ws + OFF_TILES))[8];
        __syncthreads();
        for (int i = F.tid; i < 512; i += NTHREADS) late[i] = 0;
        __syncthreads();
        if (F.tid < extra) { pg8::Unit u; moe_ord_unit(fr * F.G + F.tid, R, D / 256, u); late[u.pm] = 1; }
        __syncthreads(); }
    const int w0 = sel == 1 ? extra : 0;
    const int gw = (F.bx - w0) * NWAVES + F.wave, NGW = (F.G - w0) * NWAVES, lane = F.lane;
    for (int tok = gw; tok < T; tok += NGW) {
        const int s0 = slotof[tok], s1 = slotof[T + tok];
        if (sel) { const int lt = late[s0 >> 8] | late[s1 >> 8]; if ((sel == 1) == (lt != 0)) continue; }
        const float g0 = tokg[tok], g1 = tokg[T + tok];
#pragma unroll
        for (int j = 0; j < 4; ++j) {
            const int c = lane * 8 + 512 * j; float* op = out + (size_t)tok * D + c;
            const u32x4 a0 = __builtin_nontemporal_load((const u32x4*)(y + (size_t)s0 * D + c)), a1 = __builtin_nontemporal_load((const u32x4*)(y + (size_t)s1 * D + c));
            const u32x4 hb = __builtin_nontemporal_load((const u32x4*)(hb16 + (size_t)tok * D + c));
            f32x4 h0 = (f32x4){bflo(hb.x), bfhi(hb.x), bflo(hb.y), bfhi(hb.y)}, h1 = (f32x4){bflo(hb.z), bfhi(hb.z), bflo(hb.w), bfhi(hb.w)};
            h0.x += g0 * bflo(a0.x) + g1 * bflo(a1.x); h0.y += g0 * bfhi(a0.x) + g1 * bfhi(a1.x); h0.z += g0 * bflo(a0.y) + g1 * bflo(a1.y); h0.w += g0 * bfhi(a0.y) + g1 * bfhi(a1.y);
            h1.x += g0 * bflo(a0.z) + g1 * bflo(a1.z); h1.y += g0 * bfhi(a0.z) + g1 * bfhi(a1.z); h1.z += g0 * bflo(a0.w) + g1 * bflo(a1.w); h1.w += g0 * bfhi(a0.w) + g1 * bfhi(a1.w);
            __builtin_nontemporal_store(h0, (f32x4*)op); __builtin_nontemporal_store(h1, (f32x4*)(op + 4));
        }
    }
}

enum LPhase { LP_INPROJ = 0, LP_G1, LP_G2, LP_G3, LP_G4, LP_G5, LP_OUTPROJ, LP_F0, LP_F1, LP_F2, LP_F3, LP_F4, LP_F5, LP_N };
constexpr int PH_TOTAL = 1 + 2 * LP_N;

template <int L> __device__ __forceinline__ void layer_mixer(const Frame& F, const CAS Args& args, int lo, int hi, const XcdBarrier& bar) {
    unsigned char* ws = F.ws;
#define IN(k) (lo <= (k) && (k) < hi)
#define SEAM(k) do { if ((k) + 1 < hi) xcd_barrier(bar); } while (0)
    {
        constexpr int l = L; constexpr int layer = L; const int pb = 1 + LP_N * l;
        unsigned long long* ssq = (unsigned long long*)(ws + OFF_SS);
        if (IN(pb + LP_INPROJ)) {
            ProbPlain P{(const bf16_t*)(ws + (l == 0 ? OFF_XB : OFF_HB)), (const bf16_t*)(ws + OFF_WIN + l * SZ_WIN), D, D, D, T / 256, IN_COLS / 256, F.G, F.bx};
            EpiInProj E{ssq + (size_t)(2 * l) * T, (bf16_t*)(ws + MO(B_ZATT)), (bf16_t*)(ws + MO(B_ZRW)), (bf16_t*)(ws + MO(B_UEXT))};
            pg8::gemm_phase(F.lds, P, E, F.wave);
            if (!S5_BUILD_PRO && S5_BUILD_TAIL && F.G == 256) { __syncthreads(); phase_s5_build(fresh(F), args, l, 128, 128); }
            if (MOE_TAIL > 0 && F.G == 256) { __syncthreads(); moe_convert_range(fresh(F), args, l * (MOE_TAIL + MOE_EARLY), l * (MOE_TAIL + MOE_EARLY) + MOE_TAIL, 128, 128); }
            SEAM(pb + LP_INPROJ);
        }
        if (IN(pb + LP_G1)) {
            if (!S5_BUILD_PRO && !(S5_BUILD_TAIL && F.G == 256 && IN(pb + LP_INPROJ))) { phase_s5_build(fresh(F), args, l, 0, F.G); __syncthreads(); }
            phase_attention(fresh(F), args, l); __syncthreads();
            phase_rw_prep1(fresh(F), args, l);
            SEAM(pb + LP_G1);
        }
        if (IN(pb + LP_G2)) {
            const bool scan_here = S5_SCAN_IN_G2 && F.G == 256;
            unsigned* s5flag = (unsigned*)(ws + OFF_CTL) + XS_S5FLAG(l);
            { ProbS5a P{(const bf16_t*)(ws + MO(B_UEXT)), (const bf16_t*)(ws + (S5_BUILD_PRO ? s5e_off(l) : OFF_S5E)), 1024, S5K, 1024, F.G, F.bx};
              EpiS5a E{(float*)(ws + MO(B_XLOC))};
              pg8::gemm_phase(F.lds, P, E, F.wave); }
            if (scan_here && F.bx < 64) {
                asm volatile("s_waitcnt vmcnt(0)" ::: "memory"); __syncthreads();
                if (F.tid == 0) { __builtin_amdgcn_fence(__ATOMIC_RELEASE, "agent"); asm volatile("s_waitcnt vmcnt(0)" ::: "memory"); (void)xb_add(s5flag, 1u); }
            }
            { ProbLora P{(const bf16_t*)(ws + MO(B_ALORA)), (const bf16_t*)(ws + OFF_BCAT + l * SZ_BCAT), 128, 256, 256, T / 256, 6, F.G, F.bx};
              EpiLora E{(bf16_t*)(ws + MO(B_DEC)), (bf16_t*)(ws + MO(B_ICLR)), (bf16_t*)(ws + MO(B_GATE))};
              pg8::gemm_phase(F.lds, P, E, F.wave); }
            if (scan_here && F.bx >= F.G - 8) {
                if (F.tid == 0) { XB_SPIN(xb_ld(s5flag) != 64u, (unsigned*)(ws + OFF_CTL)); __builtin_amdgcn_fence(__ATOMIC_ACQUIRE, "agent"); asm volatile("s_waitcnt vmcnt(0)" ::: "memory"); }
                __syncthreads();
                Frame Fs = fresh(F); Fs.bx = F.bx - (F.G - 8); phase_s5_scan(Fs, args, l);
            }
            SEAM(pb + LP_G2);
        }
        if (IN(pb + LP_G3)) {
            if (!(S5_SCAN_IN_G2 && F.G == 256)) phase_s5_scan(fresh(F), args, l);
            phase_rw_pass1(fresh(F), args, l);
            SEAM(pb + LP_G3);
        }
        if (IN(pb + LP_G4)) {
            phase_rw_scan(fresh(F), l);
            { const bool sub = F.G > 64;
              ProbS5b P{(const bf16_t*)(ws + MO(B_UEXT)), (const bf16_t*)(ws + (S5_BUILD_PRO ? s5b2_off(l) : OFF_S5B2)), S5K, S5K, S5K, sub ? F.G - 64 : F.G, sub ? F.bx - 64 : F.bx};
              EpiS5b E{(bf16_t*)(ws + MO(B_ZG))};
              pg8::gemm_phase(F.lds, P, E, F.wave);
              if (sub) moe_convert_range(fresh(F), args, l * (MOE_TAIL + MOE_EARLY) + MOE_TAIL, (l + 1) * (MOE_TAIL + MOE_EARLY), 64, F.G - 64); }
            SEAM(pb + LP_G4);
        }
        if (IN(pb + LP_G5)) {
            { ProbPlain P{(const bf16_t*)(ws + MO(B_ZG)), (const bf16_t*)(ws + OFF_WGLU + l * SZ_WGLU), 512, 512, 512, T / 256, 2, F.G, F.bx};
              EpiGlu E{(const bf16_t*)(ws + MO(B_ZG)), args.in[I_GLUB] + l * 512, (bf16_t*)(ws + MO(B_MIXED)), ssq + (size_t)(5 + 2 * l) * T};
              pg8::gemm_phase(F.lds, P, E, F.wave); }
            phase_rw_fix(fresh(F), args, l);
            SEAM(pb + LP_G5);
        }
        if (IN(pb + LP_OUTPROJ)) {
            ProbPlain P{(const bf16_t*)(ws + MO(B_MIXED)), (const bf16_t*)(ws + OFF_WOUT + l * SZ_WOUT), D, D, D, T / 256, D / 256, F.G, F.bx};
            EpiResid<(L == 1 || (FFN_FP8 & 1)), true, true> E{l == 0 ? (const void*)(ws + OFF_XB) : (const void*)(ws + OFF_HB), (bf16_t*)(ws + OFF_HB), ws + (l == 0 ? OFF_X8 : OFF_XB), ssq + (size_t)(2 * l + 1) * T, 1.0f, ssq + (size_t)(4 + 2 * l) * T, ssq + (size_t)(5 + 2 * l) * T};
            pg8::gemm_phase(F.lds, P, E, F.wave); SEAM(pb + LP_OUTPROJ);
        }
    }
#undef IN
#undef SEAM
}

__global__ void __launch_bounds__(NTHREADS, 2) mk_fwd(Args args_) {
    const CAS Args& args = *(const CAS Args*)__builtin_amdgcn_kernarg_segment_ptr();
    extern __shared__ __attribute__((aligned(16))) unsigned char lds_raw[];
    Frame F; F.lds = (LAS unsigned char*)lds_raw; F.wave = __builtin_amdgcn_readfirstlane((int)threadIdx.x >> 6); F.lane = lane_id(); F.tid = F.wave * 64 + F.lane; F.G = gridDim.x; F.bx = blockIdx.x;
    F.ws = args.ws; F.out = args.out;
    unsigned char* ws = args.ws;
    const int lo = args.ph_lo, hi = args.ph_hi;
    LAS unsigned* misc = (LAS unsigned*)(F.lds + MISC_OFF);
    if (F.tid < 4) misc[F.tid] = 0u;
    __syncthreads();
    XcdBarrier bar; bar.bar = (unsigned*)(ws + OFF_CTL); bar.x = 0; bar.st = (volatile LAS unsigned*)misc; bar.wave = F.wave;
    if (hi - lo > 1) bar = xcd_barrier_post((unsigned*)(ws + OFF_CTL), (volatile LAS unsigned*)misc, F.wave);
#define IN(k) (lo <= (k) && (k) < hi)
#define SEAM(k) do { if ((k) + 1 < hi) xcd_barrier(bar); } while (0)
    if (IN(0)) { phase_prologue(fresh(F), args); SEAM(0); }
    layer_mixer<0>(F, args, lo, hi, bar);
    {
        const int pb = 1; unsigned long long* ssq = (unsigned long long*)(ws + OFF_SS);
        if (IN(pb + LP_F0)) {
            ProbPlainT<(FFN_FP8 & 1) != 0> P{ws + OFF_X8, ws + OFF_W13, D, D, D, T / 256, 2 * DFF / 256, F.G, F.bx};
            EpiSwiglu<(FFN_FP8 & 1) != 0, (FFN_FP8 & 2) != 0> E{ssq + T, nullptr, ws + OFF_ACT, DFF};
            pg8::gemm_phase(F.lds, P, E, F.wave); SEAM(pb + LP_F0);
        }
        if (IN(pb + LP_F1)) {
            ProbPlainT<(FFN_FP8 & 2) != 0> P{ws + OFF_ACT, ws + OFF_W2, DFF, DFF, DFF, T / 256, D / 256, F.G, F.bx};
            EpiResid<false, false, true, false> E{ws + OFF_HB, (bf16_t*)(ws + OFF_HB), nullptr, ssq + 2 * (size_t)T, (FFN_FP8 & 2) ? 1.0f / (SC_ACT * SC_W2) : 1.0f};
            pg8::gemm_phase(F.lds, P, E, F.wave); SEAM(pb + LP_F1);
        }
    }
    layer_mixer<1>(F, args, lo, hi, bar);
    {
        const int pb = 1 + LP_N; unsigned long long* ssq = (unsigned long long*)(ws + OFF_SS);
        if (IN(pb + LP_F0)) { phase_router(fresh(F), args); SEAM(pb + LP_F0); }
        if (IN(pb + LP_F1)) {
            phase_assign(fresh(F));
            __syncthreads();
            moe_convert_range(fresh(F), args, F.G == 256 ? 2 * (MOE_TAIL + MOE_EARLY) : 0, MOE_ITEMS, 0, F.G);
            SEAM(pb + LP_F1);
        }
        if (IN(pb + LP_F2) || IN(pb + LP_F4)) {
            const int* tl = (const int*)(ws + OFF_TILES);
            if (IN(pb + LP_F2)) {
                constexpr int NN = 2 * DFFE / 256;
                ProbMoeOrd<D, NN> P{ws + OFF_ASORT, ws + OFF_WM13, {RFL(tl[0]), RFL(tl[1]), RFL(tl[2]), RFL(tl[3]), RFL(tl[4]), RFL(tl[5]), RFL(tl[6]), RFL(tl[7]), RFL(tl[8])}, F.G, moe_pos(F.bx, F.G), 0, RFL(tl[8]) * NN};
                EpiSwiglu<true> E{ssq + 3 * (size_t)T, (const float*)(ws + OFF_RSSLOT), ws + OFF_MACT, DFFE};
                pg8::gemm_phase(F.lds, P, E, F.wave);
#if DBG_PROBE_MOE13
                { __syncthreads(); EpiProbe E2{(float*)(ws + OFF_CTL + 65536) + F.bx * 512}; pg8::gemm_phase(F.lds, P, E2, F.wave); }
#endif
                SEAM(pb + LP_F2);
            }
        }
        int csel = 0, cfr = 0, cextra = 0;
        if (IN(pb + LP_F4)) {
            const int* tl = (const int*)(ws + OFF_TILES);
            constexpr int NN2 = D / 256;
            ProbMoeOrd<DFFE, NN2> P{ws + OFF_MACT, ws + OFF_WM2, {RFL(tl[0]), RFL(tl[1]), RFL(tl[2]), RFL(tl[3]), RFL(tl[4]), RFL(tl[5]), RFL(tl[6]), RFL(tl[7]), RFL(tl[8])}, F.G, moe_pos(F.bx, F.G), 0, RFL(tl[8]) * NN2};
            EpiBf16Out E{(bf16_t*)(ws + OFF_ASORT), D, 1.0f / (SC_ACT * SC_W2)};
            const int ntile = RFL(tl[8]) * NN2, fr = ntile / F.G, extra = ntile - fr * F.G, pc = moe_pos(F.bx, F.G);
            const bool split = MK_SPLIT_COMBINE && IN(pb + LP_F5) && extra > 0 && fr > 0 && extra < F.G;
            if (split) { P.lim = fr * F.G; csel = 2; cfr = fr; cextra = extra; }
#pragma nounroll
            for (int part = 0; part < 2; ++part) {
                if (part == 1) {
                    if (!split) break;
                    split_arrive(bar);
                    if (pc >= extra) { split_wait(bar); Frame Fc = fresh(F); Fc.bx = pc; phase_combine(Fc, 1, fr, extra); break; }
                    P.base = fr * F.G; P.lim = ntile;
                }
                pg8::gemm_phase(F.lds, P, E, F.wave);
            }
            SEAM(pb + LP_F4);
        }
        if (IN(pb + LP_F5)) { phase_combine(fresh(F), csel, cfr, cextra); }
    }
#undef IN
#undef SEAM
}

extern "C" void kernel_launch(void* const* d_in, const int* in_sizes, int n_in, void* d_out, int out_size, void* d_ws, size_t ws_size, hipStream_t stream) {
    static int grid = 0;
    if (grid == 0) {
        int dev = 0, cus = 0;
        if (n_in != 39 || ws_size < WS_NEED || ws_size < OFF_MIX_END) { fprintf(stderr, "kernel_launch: unexpected shapes (n_in %d, ws %zu)\n", n_in, ws_size); grid = -1; return; }
        (void)hipGetDevice(&dev); (void)hipDeviceGetAttribute(&cus, hipDeviceAttributeMultiprocessorCount, dev);
        if (hipFuncSetAttribute((const void*)mk_fwd, hipFuncAttributeMaxDynamicSharedMemorySize, LDS_BYTES) != hipSuccess) { fprintf(stderr, "kernel_launch: hipFuncSetAttribute failed\n"); grid = -1; return; }
        grid = cus;
    }
    if (grid < 0) return;
    (void)hipMemsetAsync((char*)d_ws + OFF_CTL, 0, CTL_ZERO_BYTES, stream);
    Args a{};
    for (int i = 0; i < 39; ++i) a.in[i] = (const float*)d_in[i];
    a.out = (float*)d_out; a.ws = (unsigned char*)d_ws;
#if MK_ONE_LAUNCH
    a.ph_lo = 0; a.ph_hi = PH_TOTAL; hipLaunchKernelGGL(mk_fwd, dim3(grid), dim3(NTHREADS), LDS_BYTES, stream, a);
#else
    for (int ph = 0; ph < PH_TOTAL; ++ph) {
        if (ph >= 1 + LP_F2 && ph < 1 + LP_N) continue;
        if (ph > DBG_LAST_PHASE) break;
        a.ph_lo = ph; a.ph_hi = ph + 1;
        const int nrep = ((DBG_REP_MASK >> ph) & 1ull) ? DBG_REP_N : 1;
        for (int r = 0; r < nrep; ++r) hipLaunchKernelGGL(mk_fwd, dim3(grid), dim3(NTHREADS), LDS_BYTES, stream, a);
    }
#endif
}
```
